# Optimizing an MI355X kernel written in HIP

```python
import jax, jax.numpy as jnp
from jax import lax
import numpy as np

D_MODEL = 1024
BATCH = 8
SEQ = 2048
DEPTH = 2

CONV_CH = 512
CONV_K = 3
GLA_HEADS = 4
GLA_DK = 64
GLA_DV = 128
GLA_KW = GLA_HEADS * GLA_DK
GLA_VW = GLA_HEADS * GLA_DV
GLA_RANK = 16
GLA_TAU = 16.0
GLA_CHUNK = 64
N_BRANCH = 2
IN_SIZES = (CONV_CH, CONV_CH, CONV_CH, GLA_KW, GLA_KW, GLA_VW, GLA_VW, GLA_RANK, D_MODEL, D_MODEL)
IN_COLS = 3 * CONV_CH + 2 * GLA_KW + 2 * GLA_VW + GLA_RANK + 2 * D_MODEL
D_FF = 2816
N_EXPERTS = 8
TOP_K = 2
D_FF_EXPERT = 3584
N_DENSE = (DEPTH + 1) // 2
N_MOE = DEPTH // 2
EPS = 1e-6

kernel_name = "hybrid_conv_gla_moe_block"


def rmsnorm(x, g):
    xf = x.astype(jnp.float32)
    y = xf * lax.rsqrt(jnp.mean(xf * xf, axis=-1, keepdims=True) + EPS)
    return (y * g.astype(jnp.float32)).astype(x.dtype)


def short_conv(u, w):
    c = u.shape[-1]
    return lax.conv_general_dilated(u, w.astype(u.dtype)[:, None, :], window_strides=(1,),
                                    padding=[(CONV_K - 1, 0)],
                                    dimension_numbers=("NWC", "WIO", "NWC"),
                                    feature_group_count=c)


def gla(q, k, v, log_a):
    bn, t, h, dk = q.shape
    dv = v.shape[-1]
    L = GLA_CHUNK
    n = t // L

    def to_chunks(z):
        return z.astype(jnp.float32).reshape(bn, n, L, h, z.shape[-1]).transpose(1, 0, 3, 2, 4)

    qc, kc, vc, gc = (to_chunks(z) for z in (q * (dk ** -0.5), k, v, log_a))
    causal = jnp.tril(jnp.ones((L, L), dtype=bool))

    def step(S, inp):
        q_, k_, v_, g_ = inp
        b = jnp.cumsum(g_, axis=-2)
        o_inter = jnp.einsum("bhlk,bhkv->bhlv", q_ * jnp.exp(b), S)
        diff = b[:, :, :, None, :] - b[:, :, None, :, :]
        decay = jnp.exp(jnp.where(causal[:, :, None], diff, -jnp.inf))
        scores = jnp.einsum("bhik,bhjk,bhijk->bhij", q_, k_, decay)
        o = o_inter + jnp.einsum("bhij,bhjv->bhiv", scores, v_)
        b_last = b[:, :, -1:, :]
        S = jnp.exp(b_last[:, :, 0, :])[..., None] * S + jnp.einsum(
            "bhjk,bhjv->bhkv", k_ * jnp.exp(b_last - b), v_)
        return S, o

    S0 = jnp.zeros((bn, h, dk, dv), jnp.float32)
    _, o = lax.scan(step, S0, (qc, kc, vc, gc))
    return o.transpose(1, 0, 3, 2, 4).reshape(bn, t, h, dv)


def token_mixer(hn, w_in, w_a2, b_a, conv_w, gla_norm_g, w_branch, w_out):
    bn, t, _ = hn.shape
    p = hn @ w_in
    idx, acc = [], 0
    for s in IN_SIZES[:-1]:
        acc += s
        idx.append(acc)
    xc, gb_c, gc_c, q, k, v, g_out, a_low, gate_a, gate_b = jnp.split(p, idx, axis=-1)
    y_a = gb_c * short_conv(gc_c * xc, conv_w)
    log_a = jax.nn.log_sigmoid((a_low @ w_a2 + b_a).astype(jnp.float32)) / GLA_TAU
    o = gla(q.reshape(bn, t, GLA_HEADS, GLA_DK), k.reshape(bn, t, GLA_HEADS, GLA_DK),
            v.reshape(bn, t, GLA_HEADS, GLA_DV), log_a.reshape(bn, t, GLA_HEADS, GLA_DK))
    o = rmsnorm(o, gla_norm_g).astype(hn.dtype).reshape(bn, t, GLA_VW)
    y_b = o * jax.nn.silu(g_out)
    ya_d = y_a @ w_branch[0]
    yb_d = y_b @ w_branch[1]
    merged = jax.nn.sigmoid(gate_a) * ya_d + jax.nn.sigmoid(gate_b) * yb_d
    return merged @ w_out


def swiglu(h, w_gate, w_up, w_down):
    return (jax.nn.silu(h @ w_gate) * (h @ w_up)) @ w_down


def moe(h, w_router, w_gate, w_up, w_down):
    logits = (h @ w_router).astype(jnp.float32)
    top_l, top_i = lax.top_k(logits, TOP_K)
    top_w = jax.nn.softmax(top_l, axis=-1)
    gates = jnp.sum(jax.nn.one_hot(top_i, N_EXPERTS, dtype=jnp.float32) * top_w[..., None],
                    axis=-2).astype(h.dtype)
    y = jnp.zeros_like(h)
    for e in range(N_EXPERTS):
        y = y + gates[..., e:e + 1] * swiglu(h, w_gate[e], w_up[e], w_down[e])
    return y


def setup_inputs(seed: int = 0) -> dict:
    key = jax.random.key(seed)
    ks = jax.random.split(key, 24)
    f32 = jnp.float32

    def nrm(k, shape, fan_in):
        return jax.random.normal(k, shape, f32) * (fan_in ** -0.5)

    def gain(k, shape):
        return 1.0 + 0.02 * jax.random.normal(k, shape, f32)

    return {
        "x": jax.random.normal(ks[0], (BATCH, SEQ, D_MODEL), f32),
        "ln1_g": gain(ks[1], (DEPTH, D_MODEL)),
        "w_in": nrm(ks[2], (DEPTH, D_MODEL, IN_COLS), D_MODEL),
        "w_a2": nrm(ks[3], (DEPTH, GLA_RANK, GLA_KW), GLA_RANK),
        "b_a": 0.1 * jax.random.normal(ks[4], (DEPTH, GLA_KW), f32),
        "conv_w": nrm(ks[5], (DEPTH, CONV_K, CONV_CH), CONV_K),
        "gla_norm_g": gain(ks[6], (DEPTH, GLA_DV)),
        "w_branch": nrm(ks[7], (DEPTH, N_BRANCH, CONV_CH, D_MODEL), CONV_CH),
        "w_out": nrm(ks[8], (DEPTH, D_MODEL, D_MODEL), D_MODEL),
        "ln2_g": gain(ks[9], (DEPTH, D_MODEL)),
        "ffn_w_gate": nrm(ks[10], (N_DENSE, D_MODEL, D_FF), D_MODEL),
        "ffn_w_up": nrm(ks[11], (N_DENSE, D_MODEL, D_FF), D_MODEL),
        "ffn_w_down": nrm(ks[12], (N_DENSE, D_FF, D_MODEL), D_FF),
        "w_router": nrm(ks[13], (N_MOE, D_MODEL, N_EXPERTS), D_MODEL),
        "moe_w_gate": nrm(ks[14], (N_MOE, N_EXPERTS, D_MODEL, D_FF_EXPERT), D_MODEL),
        "moe_w_up": nrm(ks[15], (N_MOE, N_EXPERTS, D_MODEL, D_FF_EXPERT), D_MODEL),
        "moe_w_down": nrm(ks[16], (N_MOE, N_EXPERTS, D_FF_EXPERT, D_MODEL), D_FF_EXPERT),
        "final_g": gain(ks[17], (D_MODEL,)),
    }


def reference(x, ln1_g, w_in, w_a2, b_a, conv_w, gla_norm_g, w_branch, w_out, ln2_g,
              ffn_w_gate, ffn_w_up, ffn_w_down, w_router, moe_w_gate, moe_w_up, moe_w_down,
              final_g):
    for l in range(DEPTH):
        x = x + token_mixer(rmsnorm(x, ln1_g[l]), w_in[l], w_a2[l], b_a[l], conv_w[l],
                            gla_norm_g[l], w_branch[l], w_out[l])
        h = rmsnorm(x, ln2_g[l])
        j = l // 2
        if l % 2 == 0:
            x = x + swiglu(h, ffn_w_gate[j], ffn_w_up[j], ffn_w_down[j])
        else:
            x = x + moe(h, w_router[j], moe_w_gate[j], moe_w_up[j], moe_w_down[j])
    return rmsnorm(x, final_g)
```

```cpp
#include <hip/hip_runtime.h>
#include <cstdio>
#include <cstdint>
#include <cstddef>
#ifndef MK_SPLIT
#define MK_SPLIT 0
#endif
#ifndef DUP_PH
#define DUP_PH -1
#endif
#define NREP(k) (((k) == (DUP_PH)) ? 2 : 1)

typedef unsigned short bf16;
#define DEV __device__ __forceinline__

constexpr int D = 1024, BATCH = 8, SEQ = 2048, M = BATCH * SEQ;
constexpr int CC = 512, KW = 256, VW = 512, RANK = 16, NH = 4, DK = 64, DV = 128;
constexpr int IN_COLS = 5136, PLD = 5120;
constexpr int P_XC = 0, P_GB = 512, P_GC = 1024, P_Q = 1536, P_K = 1792, P_V = 2048, P_GO = 2560, P_GA = 3072, P_GBB = 4096;
constexpr int DFF = 2816, NE = 8, DFE = 3584;
constexpr float EPS = 1e-6f;
constexpr int PERM_ROWS = 2 * M + NE * 256;
constexpr int NTILE_MAX = PERM_ROWS / 256;
constexpr int CHUNK_TILES = 64;
constexpr int KSPLIT = 7, KSLICE = DFE / KSPLIT;

constexpr size_t MiB = 1ull << 20;
constexpr size_t WS_CNT = 1 * MiB;
constexpr size_t WS_TILE = 1 * MiB + 16384;
constexpr size_t WS_TOKE = 1 * MiB + 65536;
constexpr size_t WS_TOKW = WS_TOKE + 131072;
constexpr size_t WS_SLOT = WS_TOKW + 131072;
constexpr size_t WS_RSTD = WS_SLOT + 131072;
constexpr size_t WS_ALOW = 3 * MiB;
constexpr size_t WS_LOGA = 4 * MiB;
constexpr size_t WS_HB = 234 * MiB;
constexpr size_t WS_P = 266 * MiB;
constexpr size_t WS_U = 426 * MiB;
constexpr size_t WS_ACTP = 266 * MiB;
constexpr size_t WS_HBP = 385 * MiB;
constexpr size_t WS_OBUF = 419 * MiB;
constexpr size_t WS_OBX = 4 * MiB;
constexpr size_t WS_END = 489 * MiB;

DEV float bf2f(unsigned v) { return __uint_as_float(v << 16); }
DEV unsigned f2bf(float f) { unsigned u = __float_as_uint(f); return (u + 0x7fffu + ((u >> 16) & 1u)) >> 16; }
DEV unsigned pk2(float lo, float hi) { return f2bf(lo) | (f2bf(hi) << 16); }
DEV float wave_sum(float v) {
#pragma unroll
    for (int o = 1; o < 64; o <<= 1) v += __shfl_xor(v, o);
    return v;
}

DEV float row_rstd(const float* ssq, int row) { return rsqrtf(((ssq[row] + ssq[M + row]) + (ssq[2 * M + row] + ssq[3 * M + row])) * (1.0f / D) + EPS); }
#define LAS __attribute__((address_space(3)))
typedef short bf16x8 __attribute__((ext_vector_type(8)));
typedef float f32x4 __attribute__((ext_vector_type(4)));
typedef float f32x2 __attribute__((ext_vector_type(2)));
typedef unsigned u32x4 __attribute__((ext_vector_type(4)));
typedef unsigned u32x2 __attribute__((ext_vector_type(2)));
DEV unsigned cvt_pk_bf16(float lo, float hi) { unsigned r; asm volatile("v_cvt_pk_bf16_f32 %0, %1, %2" : "=v"(r) : "v"(lo), "v"(hi)); return r; }
DEV float fsig(float x) { return __builtin_amdgcn_rcpf(1.0f + __builtin_amdgcn_exp2f(-1.44269504f * x)); }
DEV float blo(unsigned w) { return __uint_as_float(w << 16); }
DEV float bhi(unsigned w) { return __uint_as_float(w & 0xffff0000u); }

typedef int i32x4 __attribute__((ext_vector_type(4)));
typedef int i32x8 __attribute__((ext_vector_type(8)));
DEV i32x8 cat8(bf16x8 lo, bf16x8 hi) { return __builtin_shufflevector(__builtin_bit_cast(i32x4, lo), __builtin_bit_cast(i32x4, hi), 0, 1, 2, 3, 4, 5, 6, 7); }
DEV unsigned pk4_fp8(float a, float b, float c, float d) { int w = 0; w = __builtin_amdgcn_cvt_pk_fp8_f32(a, b, w, false); w = __builtin_amdgcn_cvt_pk_fp8_f32(c, d, w, true); return (unsigned)w; }
constexpr float W8_SCALE = 64.0f, W8_INV = 1.0f / 64.0f;
namespace pg8 {
constexpr int BM = 256, BK = 64, HALF = 128, HTB = HALF * BK * 2, STAGE_BYTES = 8 * HTB, NXCD = 8, WGM = 8;
__host__ __device__ __forceinline__ int lds_byte(int r, int c) { const int st = (r >> 4) * 2 + (c >> 5), rr = r & 15, cc = c & 31, ob = rr * 64 + cc * 2; return st * 1024 + (ob ^ (((ob >> 9) & 1) << 5)); }
__host__ __device__ __forceinline__ void stage_rc(int b, int& R, int& C) { const int st = b / 1024, sb = b % 1024, swz = sb ^ (((sb >> 9) & 1) << 5); R = (st >> 1) * 16 + swz / 64; C = (st & 1) * 32 + (swz % 64) / 2; }
__host__ __device__ __forceinline__ int perm32(int rho) { const int n = rho >> 4, i = rho & 15; return 8 * (i >> 2) + 4 * n + (i & 3); }

struct Unit { const char* A; const char* B; int pm, pn, aux; };
DEV bool tile_of(int L, int nM, int nN, int& pm, int& pn) {
    const int nwg = nM * nN; if (L >= nwg) return false;
    int wgid = L; { const int q = nwg / NXCD, r = nwg % NXCD, xcd = wgid % NXCD, off = wgid / NXCD; wgid = (xcd < r ? xcd * (q + 1) : r * (q + 1) + (xcd - r) * q) + off; }
    const int nig = WGM * nN, gid = wgid / nig, fm = gid * WGM, gsz = (nM - fm) < WGM ? (nM - fm) : WGM;
    pm = fm + ((wgid % nig) % gsz); pn = (wgid % nig) / gsz; return true;
}

template <class Epi, class Sched, bool ALIGN_EPI, bool SP2, bool FP8 = false>
DEV void gemm_phase(LAS unsigned char* lds, const int K, const int lda, const int ldb, const Sched& S, const Epi& E) {
    int tid_ = threadIdx.x; asm volatile("" : "+v"(tid_));
    const int tid = tid_, wid = __builtin_amdgcn_readfirstlane(tid >> 6), lane = tid & 63, wr = wid >> 2, wc = wid & 3, fr = lane & 15, fq = lane >> 4;
    const int nt = K / BK;
    unsigned voffA[2], voffB[2];
#pragma unroll
    for (int i = 0; i < 2; ++i) { int R, C; stage_rc(tid * 16 + i * 8192, R, C); const int Rb = Epi::PERM ? ((R & ~31) + perm32(R & 31)) : R;
        voffA[i] = (unsigned)(R * lda + C) * 2u; voffB[i] = (unsigned)(Rb * ldb + C) * 2u; }
    const size_t kstep = (size_t)(BK * 2);
    const size_t hstepA = (size_t)HALF * lda * 2, hstepB = (size_t)HALF * ldb * 2;
    const unsigned ldsw = (unsigned)wid * 1024u;
    const int aoff = FP8 ? lds_byte(wr * 64 + fr, fq * 16) : lds_byte(wr * 64 + fr, fq * 8), boff = FP8 ? lds_byte(wc * 32 + fr, fq * 16) : lds_byte(wc * 32 + fr, fq * 8);

#define PG8_SA(b, h) (((b) * 2 + (h)) * HTB)
#define PG8_SB(b, h) ((4 + (b) * 2 + (h)) * HTB)
#define PG8_STAGE(bufoff, gbase, voff) do { _Pragma("unroll") for (int _i = 0; _i < 2; ++_i) \
        __builtin_amdgcn_global_load_lds((const unsigned*)((const char*)(gbase) + (voff)[_i]), (LAS unsigned*)(lds + (bufoff) + ldsw + _i * 8192), 16, 0, 0); } while (0)
#define PG8_RD(off) (*(const LAS bf16x8*)(lds + (off)))
#define PG8_LDA(dst, b, h) do { if constexpr (FP8) { _Pragma("unroll") for (int m = 0; m < 4; ++m) dst##8[m] = cat8(PG8_RD(PG8_SA(b, h) + aoff + m * 2048), PG8_RD(PG8_SA(b, h) + aoff + m * 2048 + 16)); } \
        else { _Pragma("unroll") for (int m = 0; m < 4; ++m) _Pragma("unroll") for (int k = 0; k < 2; ++k) dst[m][k] = PG8_RD(PG8_SA(b, h) + aoff + m * 2048 + k * 1024); } } while (0)
#define PG8_LDB(dst, b, h) do { if constexpr (FP8) { _Pragma("unroll") for (int n = 0; n < 2; ++n) dst##8[n] = cat8(PG8_RD(PG8_SB(b, h) + boff + n * 2048), PG8_RD(PG8_SB(b, h) + boff + n * 2048 + 16)); } \
        else { _Pragma("unroll") for (int n = 0; n < 2; ++n) _Pragma("unroll") for (int k = 0; k < 2; ++k) dst[n][k] = PG8_RD(PG8_SB(b, h) + boff + n * 2048 + k * 1024); } } while (0)
#define PG8_MMA(ai, bj, At, Bt) do { __builtin_amdgcn_s_setprio(1); _Pragma("unroll") for (int m = 0; m < 4; ++m) _Pragma("unroll") for (int n = 0; n < 2; ++n) { \
        if constexpr (FP8) asm volatile("v_mfma_scale_f32_16x16x128_f8f6f4 %0, %1, %2, %0, %3, %3 op_sel_hi:[0,0,0]" : "+v"(acc[ai][bj][m][n]) : "v"(Bt##8[n]), "v"(At##8[m]), "v"(one8)); \
        else { _Pragma("unroll") for (int k = 0; k < 2; ++k) acc[ai][bj][m][n] = __builtin_amdgcn_mfma_f32_16x16x32_bf16(Bt[n][k], At[m][k], acc[ai][bj][m][n], 0, 0, 0); } } __builtin_amdgcn_s_setprio(0); } while (0)
#define PG8_WAIT_V(n) asm volatile("s_waitcnt vmcnt(" #n ")" ::: "memory")
#define PG8_WAIT_L(n) asm volatile("s_waitcnt lgkmcnt(" #n ")" ::: "memory")
#define PG8_BAR __builtin_amdgcn_s_barrier()
#define PG8_SCHED __builtin_amdgcn_sched_barrier(0)
    Unit cur, nxt; int ui = 0;
    if (!S.next(0, cur)) return;
    f32x4 acc[2][2][4][2];
#pragma unroll
    for (int a = 0; a < 2; ++a)
#pragma unroll
        for (int b = 0; b < 2; ++b)
#pragma unroll
            for (int m = 0; m < 4; ++m)
#pragma unroll
                for (int n = 0; n < 2; ++n) acc[a][b][m][n] = (f32x4){0.f, 0.f, 0.f, 0.f};
    const int one8 = 0x7F7F7F7F;
    bf16x8 At[4][2], B0[2][2], B1[2][2]; i32x8 At8[4], B08[2], B18[2];
    const char* cA = cur.A; const char* cB = cur.B;
    if constexpr (SP2) {
        PG8_STAGE(PG8_SB(0, 0), cB, voffB); PG8_STAGE(PG8_SB(0, 1), cB + hstepB, voffB); PG8_STAGE(PG8_SA(0, 0), cA, voffA); PG8_STAGE(PG8_SA(0, 1), cA + hstepA, voffA);
        if (wr == 1) PG8_BAR;
        PG8_WAIT_V(2); PG8_BAR;
        PG8_STAGE(PG8_SB(1, 0), cB + kstep, voffB); PG8_STAGE(PG8_SA(1, 0), cA + kstep, voffA); PG8_STAGE(PG8_SB(1, 1), cB + hstepB + kstep, voffB);
        PG8_WAIT_V(6); PG8_BAR;
    } else {
        PG8_STAGE(PG8_SB(0, 0), cB, voffB); PG8_STAGE(PG8_SA(0, 0), cA, voffA); PG8_STAGE(PG8_SB(0, 1), cB + hstepB, voffB); PG8_STAGE(PG8_SA(0, 1), cA + hstepA, voffA);
        if (wr == 1) PG8_BAR;
        PG8_WAIT_V(4); PG8_BAR;
        PG8_STAGE(PG8_SB(1, 0), cB + kstep, voffB); PG8_STAGE(PG8_SA(1, 0), cA + kstep, voffA); PG8_STAGE(PG8_SB(1, 1), cB + hstepB + kstep, voffB);
        PG8_WAIT_V(6); PG8_BAR;
    }
    for (;;) {
        const bool has_next = S.next(ui + 1, nxt);
        const char* nA = has_next ? nxt.A : cA; const char* nB = has_next ? nxt.B : cB;
#pragma nounroll
        for (int t = 0; t < nt; t += 2) {
            const bool last = (t == nt - 2);
            const char* a1 = cA + (size_t)(t + 1) * kstep;
            const char* a2 = last ? nA : cA + (size_t)(t + 2) * kstep; const char* b2 = last ? nB : cB + (size_t)(t + 2) * kstep;
            const char* a3 = a2 + kstep; const char* b3 = b2 + kstep;
            if constexpr (SP2) {
            PG8_LDB(B0, 0, 0); PG8_LDB(B1, 0, 1); PG8_SCHED; PG8_LDA(At, 0, 0); PG8_STAGE(PG8_SA(1, 1), a1 + hstepA, voffA);
            PG8_WAIT_V(8); PG8_WAIT_L(0); PG8_BAR; PG8_MMA(0, 0, At, B0); PG8_MMA(0, 1, At, B1); PG8_BAR; PG8_SCHED;
            PG8_LDA(At, 0, 1); PG8_STAGE(PG8_SB(0, 0), b2, voffB); PG8_STAGE(PG8_SB(0, 1), b2 + hstepB, voffB); PG8_STAGE(PG8_SA(0, 0), a2, voffA);
            PG8_WAIT_V(8); PG8_WAIT_L(0); PG8_BAR; PG8_MMA(1, 0, At, B0); PG8_MMA(1, 1, At, B1); PG8_BAR; PG8_SCHED;
            PG8_LDB(B0, 1, 0); PG8_LDB(B1, 1, 1); PG8_SCHED; PG8_LDA(At, 1, 0); PG8_STAGE(PG8_SA(0, 1), a2 + hstepA, voffA);
            PG8_WAIT_V(8); PG8_WAIT_L(0); PG8_BAR; PG8_MMA(0, 0, At, B0); PG8_MMA(0, 1, At, B1); PG8_BAR; PG8_SCHED;
            PG8_LDA(At, 1, 1); PG8_STAGE(PG8_SB(1, 0), b3, voffB); PG8_STAGE(PG8_SB(1, 1), b3 + hstepB, voffB); PG8_STAGE(PG8_SA(1, 0), a3, voffA);
            PG8_WAIT_V(8); PG8_WAIT_L(0); PG8_BAR; PG8_MMA(1, 0, At, B0); PG8_MMA(1, 1, At, B1); PG8_BAR; PG8_SCHED;
            } else {
            PG8_LDB(B0, 0, 0); PG8_SCHED; PG8_LDA(At, 0, 0); PG8_STAGE(PG8_SA(1, 1), a1 + hstepA, voffA);
            PG8_WAIT_L(8); PG8_BAR; PG8_WAIT_L(0); PG8_MMA(0, 0, At, B0); PG8_BAR; PG8_SCHED;
            PG8_LDB(B1, 0, 1); PG8_STAGE(PG8_SB(0, 0), b2, voffB);
            PG8_BAR; PG8_WAIT_L(0); PG8_MMA(0, 1, At, B1); PG8_BAR;
            PG8_LDA(At, 0, 1); PG8_STAGE(PG8_SA(0, 0), a2, voffA);
            PG8_BAR; PG8_WAIT_L(0); PG8_MMA(1, 0, At, B0); PG8_BAR; PG8_SCHED;
            PG8_STAGE(PG8_SB(0, 1), b2 + hstepB, voffB);
            PG8_WAIT_V(6); PG8_BAR; PG8_MMA(1, 1, At, B1); PG8_BAR;
            PG8_LDB(B0, 1, 0); PG8_SCHED; PG8_LDA(At, 1, 0); PG8_STAGE(PG8_SA(0, 1), a2 + hstepA, voffA);
            PG8_WAIT_L(8); PG8_BAR; PG8_WAIT_L(0); PG8_MMA(0, 0, At, B0); PG8_BAR; PG8_SCHED;
            PG8_LDB(B1, 1, 1); PG8_STAGE(PG8_SB(1, 0), b3, voffB);
            PG8_BAR; PG8_WAIT_L(0); PG8_MMA(0, 1, At, B1); PG8_BAR;
            PG8_LDA(At, 1, 1); PG8_STAGE(PG8_SA(1, 0), a3, voffA);
            PG8_BAR; PG8_WAIT_L(0); PG8_MMA(1, 0, At, B0); PG8_BAR; PG8_SCHED;
            PG8_STAGE(PG8_SB(1, 1), b3 + hstepB, voffB);
            PG8_WAIT_V(6); PG8_BAR; PG8_MMA(1, 1, At, B1); PG8_BAR;
            }
        }
        if constexpr (ALIGN_EPI) { if (wr == 0) PG8_BAR; }
        if constexpr (FP8) asm volatile("s_nop 15\n\ts_nop 15" ::: "memory");
        E(acc, cur, wr, wc, fr, fq);
        if (!has_next) break;
#pragma unroll
        for (int a = 0; a < 2; ++a)
#pragma unroll
            for (int b = 0; b < 2; ++b)
#pragma unroll
                for (int m = 0; m < 4; ++m)
#pragma unroll
                    for (int n = 0; n < 2; ++n) acc[a][b][m][n] = (f32x4){0.f, 0.f, 0.f, 0.f};
        cur = nxt; cA = nA; cB = nB; ++ui;
        if constexpr (ALIGN_EPI) { if (wr == 1) PG8_BAR; }
    }
    PG8_WAIT_V(0);
    if constexpr (!ALIGN_EPI) { if (wr == 0) PG8_BAR; }
    PG8_BAR;
#undef PG8_SA
#undef PG8_SB
#undef PG8_STAGE
#undef PG8_LDA
#undef PG8_RD
#undef PG8_LDB
#undef PG8_MMA
#undef PG8_WAIT_V
#undef PG8_WAIT_L
#undef PG8_BAR
#undef PG8_SCHED
}
}
using pg8::Unit;

struct SchedGrid { const char* A; const char* B; size_t astep, bstep; int nM, nN, G, c;
    DEV bool next(int i, Unit& u) const { int pm, pn; if (!pg8::tile_of(i * G + c, nM, nN, pm, pn)) return false; u.A = A + (size_t)pm * astep; u.B = B + (size_t)pn * bstep; u.pm = pm; u.pn = pn; u.aux = i; return true; } };
struct SchedPair { const char* A0; const char* A1; const char* B0; const char* B1; size_t astep, bstep; int nM, nN, G, c;
    DEV bool next(int i, Unit& u) const { int pm, pn; if (!pg8::tile_of((i >> 1) * G + c, nM, nN, pm, pn)) return false; const int br = i & 1; u.A = (br ? A1 : A0) + (size_t)pm * astep; u.B = (br ? B1 : B0) + (size_t)pn * bstep; u.pm = pm; u.pn = pn; u.aux = br; return true; } };
struct SchedMoe { const char* A; const char* B; const int* tile_e; size_t astep, bstep, estep; int t0, nM, nN, G, c;
    DEV bool next(int i, Unit& u) const { int pm, pn; if (!pg8::tile_of(i * G + c, nM, nN, pm, pn)) return false; const int e = tile_e[t0 + pm]; u.A = A + (size_t)pm * astep; u.B = B + (size_t)e * estep + (size_t)pn * bstep; u.pm = pm; u.pn = pn; u.aux = e; return true; } };

struct SchedMoeK { const char* A; const char* B; const int* tile_e; int nL, G, c;
    DEV bool next(int i, Unit& u) const { const int L = i * G + c; if (L >= nL * 4 * KSPLIT) return false; const int ks = L % KSPLIT, pn = (L / KSPLIT) & 3, lt = L / (4 * KSPLIT); const int e = tile_e[128 + lt];
        u.A = A + ((size_t)(128 + lt) * 256 * DFE + (size_t)ks * KSLICE); u.B = B + ((size_t)e * D * DFE + (size_t)pn * 256 * DFE + (size_t)ks * KSLICE);     u.pm = lt; u.pn = pn; u.aux = ks; return true; } };
template <class Sched> DEV void fill_rstd(LAS float* R, const Sched& S, const float* ssq) {
    int t = threadIdx.x; asm volatile("" : "+v"(t)); Unit u;
    for (int i = 0; i < 8 && S.next(i, u); ++i) if (t < 256) R[i * 256 + t] = row_rstd(ssq, u.pm * 256 + t);
    __syncthreads();
}
typedef const f32x4 (&AccRef)[2][2][4][2];
template <bool RS> struct EBf16T { static constexpr bool PERM = true; bf16* O; int ldc; float sc; const LAS float* R;
    DEV void operator()(AccRef acc, const Unit& u, int wr, int wc, int fr, int fq) const {
        const int row0 = u.pm * 256 + wr * 64 + fr, col0 = u.pn * 256 + wc * 32 + 8 * fq;
        float rsv[2][4];
#pragma unroll
        for (int ai = 0; ai < 2; ++ai)
#pragma unroll
            for (int m = 0; m < 4; ++m) rsv[ai][m] = RS ? sc * R[u.aux * 256 + ai * 128 + wr * 64 + m * 16 + fr] : sc;
#pragma unroll
        for (int ai = 0; ai < 2; ++ai)
#pragma unroll
            for (int m = 0; m < 4; ++m) { const int row = row0 + ai * 128 + m * 16; bf16* rowp = O + (size_t)row * ldc + col0; const float rs = rsv[ai][m];
#pragma unroll
                for (int bj = 0; bj < 2; ++bj) { const f32x4 v0 = acc[ai][bj][m][0] * rs, v1 = acc[ai][bj][m][1] * rs; u32x4 w; w.x = cvt_pk_bf16(v0[0], v0[1]); w.y = cvt_pk_bf16(v0[2], v0[3]); w.z = cvt_pk_bf16(v1[0], v1[1]); w.w = cvt_pk_bf16(v1[2], v1[3]);
                    *(u32x4*)(rowp + bj * 128) = w; } }
    } };
typedef EBf16T<false> EBf16;
struct EMerge { static constexpr bool PERM = true; bf16* mg; const bf16* p;
    DEV void operator()(AccRef acc, const Unit& u, int wr, int wc, int fr, int fq) const {
        const int row0 = u.pm * 256 + wr * 64 + fr, col0 = u.pn * 256 + wc * 32 + 8 * fq; const int gofs = u.aux ? P_GBB : P_GA;
#pragma unroll
        for (int ai = 0; ai < 2; ++ai) {
            u32x4 gt[4][2], od[4][2];
#pragma unroll
            for (int m = 0; m < 4; ++m)
#pragma unroll
                for (int bj = 0; bj < 2; ++bj) { const size_t row = (size_t)(row0 + ai * 128 + m * 16); const int col = col0 + bj * 128;
                    gt[m][bj] = *(const u32x4*)(p + row * PLD + gofs + col); od[m][bj] = u.aux ? *(const u32x4*)(mg + row * D + col) : (u32x4){0u, 0u, 0u, 0u}; }
#pragma unroll
            for (int m = 0; m < 4; ++m)
#pragma unroll
                for (int bj = 0; bj < 2; ++bj) { const size_t row = (size_t)(row0 + ai * 128 + m * 16); const int col = col0 + bj * 128; const u32x4 g = gt[m][bj], o = od[m][bj];
                    const f32x4 v0 = acc[ai][bj][m][0], v1 = acc[ai][bj][m][1];
                    u32x4 w; w.x = cvt_pk_bf16(fsig(blo(g.x)) * v0[0] + blo(o.x), fsig(bhi(g.x)) * v0[1] + bhi(o.x)); w.y = cvt_pk_bf16(fsig(blo(g.y)) * v0[2] + blo(o.y), fsig(bhi(g.y)) * v0[3] + bhi(o.y));
                    w.z = cvt_pk_bf16(fsig(blo(g.z)) * v1[0] + blo(o.z), fsig(bhi(g.z)) * v1[1] + bhi(o.z)); w.w = cvt_pk_bf16(fsig(blo(g.w)) * v1[2] + blo(o.w), fsig(bhi(g.w)) * v1[3] + bhi(o.w));
                    *(u32x4*)(mg + row * D + col) = w; }
        }
    } };
template <bool STATS> struct EResT { static constexpr bool PERM = true; bf16* xb; float* ssq; LAS float* P;
    DEV void operator()(AccRef acc, const Unit& u, int wr, int wc, int fr, int fq) const {
        const int row0 = u.pm * 256 + wr * 64 + fr, col0 = u.pn * 256 + wc * 32 + 8 * fq;
#pragma unroll
        for (int ai = 0; ai < 2; ++ai) {
        u32x4 xo[4][2];
#pragma unroll
            for (int m = 0; m < 4; ++m)
#pragma unroll
                for (int bj = 0; bj < 2; ++bj) xo[m][bj] = *(const u32x4*)(xb + (size_t)(row0 + ai * 128 + m * 16) * D + col0 + bj * 128);
#pragma unroll
            for (int m = 0; m < 4; ++m) { bf16* rowp = xb + (size_t)(row0 + ai * 128 + m * 16) * D + col0; float sq = 0.f;
#pragma unroll
                for (int bj = 0; bj < 2; ++bj) { const u32x4 o = xo[m][bj]; const f32x4 a0 = acc[ai][bj][m][0], a1 = acc[ai][bj][m][1];
                    u32x4 w; w.x = cvt_pk_bf16(blo(o.x) + a0[0], bhi(o.x) + a0[1]); w.y = cvt_pk_bf16(blo(o.y) + a0[2], bhi(o.y) + a0[3]); w.z = cvt_pk_bf16(blo(o.z) + a1[0], bhi(o.z) + a1[1]); w.w = cvt_pk_bf16(blo(o.w) + a1[2], bhi(o.w) + a1[3]);
                    *(u32x4*)(rowp + bj * 128) = w;
                    if (STATS) sq += (blo(w.x) * blo(w.x) + bhi(w.x) * bhi(w.x)) + (blo(w.y) * blo(w.y) + bhi(w.y) * bhi(w.y)) + (blo(w.z) * blo(w.z) + bhi(w.z) * bhi(w.z)) + (blo(w.w) * blo(w.w) + bhi(w.w) * bhi(w.w)); }
                if (STATS) { sq += __shfl_xor(sq, 16); sq += __shfl_xor(sq, 32);
                    if (fq == 0) P[(ai * 128 + wr * 64 + m * 16 + fr) * 4 + wc] = sq; } } }
        if (!STATS) return;
        asm volatile("s_waitcnt lgkmcnt(0)" ::: "memory"); __builtin_amdgcn_s_barrier(); asm volatile("" ::: "memory");
        const int t = wr * 256 + wc * 64 + fq * 16 + fr;
        if (t < 256) ssq[(size_t)u.pn * M + u.pm * 256 + t] = (P[t * 4] + P[t * 4 + 1]) + (P[t * 4 + 2] + P[t * 4 + 3]);
    } };
typedef EResT<true> ERes;
struct ESlab { static constexpr bool PERM = false; float* obx; float sc;
    DEV void operator()(AccRef acc, const Unit& u, int wr, int wc, int fr, int fq) const {
        const int row0 = u.pm * 256 + wr * 64 + fr, col0 = u.pn * 256 + wc * 32 + 4 * fq; float* base = obx + (size_t)u.aux * 2048 * D;
#pragma unroll
        for (int ai = 0; ai < 2; ++ai)
#pragma unroll
            for (int m = 0; m < 4; ++m) { const size_t off = (size_t)(row0 + ai * 128 + m * 16) * D + col0;
#pragma unroll
                for (int bj = 0; bj < 2; ++bj)
#pragma unroll
                    for (int n = 0; n < 2; ++n) *(f32x4*)(base + off + bj * 128 + n * 16) = acc[ai][bj][m][n] * sc; }
    } };
struct ESwiglu8 { static constexpr bool PERM = true; unsigned char* act; int ld; float sc;
    DEV void operator()(AccRef acc, const Unit& u, int wr, int wc, int fr, int fq) const {
        const int row0 = u.pm * 256 + wr * 64 + fr, col0 = u.pn * 128 + wc * 32 + 8 * fq;
#pragma unroll
        for (int ai = 0; ai < 2; ++ai)
#pragma unroll
            for (int m = 0; m < 4; ++m) { const f32x4 g0 = acc[ai][0][m][0] * sc, g1 = acc[ai][0][m][1] * sc, u0 = acc[ai][1][m][0] * sc, u1 = acc[ai][1][m][1] * sc;
                u32x2 w; w.x = pk4_fp8(g0[0] * fsig(g0[0]) * u0[0], g0[1] * fsig(g0[1]) * u0[1], g0[2] * fsig(g0[2]) * u0[2], g0[3] * fsig(g0[3]) * u0[3]);
                w.y = pk4_fp8(g1[0] * fsig(g1[0]) * u1[0], g1[1] * fsig(g1[1]) * u1[1], g1[2] * fsig(g1[2]) * u1[2], g1[3] * fsig(g1[3]) * u1[3]);
                *(u32x2*)(act + (size_t)(row0 + ai * 128 + m * 16) * ld + col0) = w; }
    } };
struct ESwiglu { static constexpr bool PERM = true; bf16* act; int ld; const LAS float* R;
    DEV void operator()(AccRef acc, const Unit& u, int wr, int wc, int fr, int fq) const {
        const int row0 = u.pm * 256 + wr * 64 + fr, col0 = u.pn * 128 + wc * 32 + 8 * fq;
        float rsv[2][4];
#pragma unroll
        for (int ai = 0; ai < 2; ++ai)
#pragma unroll
            for (int m = 0; m < 4; ++m) rsv[ai][m] = R[u.aux * 256 + ai * 128 + wr * 64 + m * 16 + fr];
#pragma unroll
        for (int ai = 0; ai < 2; ++ai)
#pragma unroll
            for (int m = 0; m < 4; ++m) { const float rs = rsv[ai][m]; const f32x4 g0 = acc[ai][0][m][0] * rs, g1 = acc[ai][0][m][1] * rs, u0 = acc[ai][1][m][0] * rs, u1 = acc[ai][1][m][1] * rs;
                u32x4 w; w.x = cvt_pk_bf16(g0[0] * fsig(g0[0]) * u0[0], g0[1] * fsig(g0[1]) * u0[1]); w.y = cvt_pk_bf16(g0[2] * fsig(g0[2]) * u0[2], g0[3] * fsig(g0[3]) * u0[3]);
                w.z = cvt_pk_bf16(g1[0] * fsig(g1[0]) * u1[0], g1[1] * fsig(g1[1]) * u1[1]); w.w = cvt_pk_bf16(g1[2] * fsig(g1[2]) * u1[2], g1[3] * fsig(g1[3]) * u1[3]);
                *(u32x4*)(act + (size_t)(row0 + ai * 128 + m * 16) * ld + col0) = w; }
    } };

#define XB_TMO      128
#define XB_XCNT(j)  (256  + 64 * (j))
#define XB_XSUB(j)  (1280 + 64 * (j))
#define XB_XGEN(j)  (2304 + 64 * (j))
#define XB_TOP      3328
#define XB_TOPGEN   3392
#define XCD_BAR_WORDS 3456
#define XB_SPIN_CAP (1u << 18)
__device__ __forceinline__ unsigned xb_ld(unsigned* p)              { return __hip_atomic_load(p, __ATOMIC_RELAXED, __HIP_MEMORY_SCOPE_AGENT); }
__device__ __forceinline__ unsigned xb_add(unsigned* p, unsigned v) { return __hip_atomic_fetch_add(p, v, __ATOMIC_RELAXED, __HIP_MEMORY_SCOPE_AGENT); }
__device__ __forceinline__ unsigned xb_xcc_id() { return (unsigned)__builtin_amdgcn_s_getreg((3 << 11) | 20) & 0xFu; }
#define XB_SPIN(cond, bar) do { unsigned _sp = 0; while (cond) { __builtin_amdgcn_s_sleep(1); \
    if ((++_sp & 255u) == 0u) { if (xb_ld(&(bar)[XB_TMO])) break; if (_sp > XB_SPIN_CAP) { atomicAdd(&(bar)[XB_TMO], 1u); break; } } } } while (0)
struct XcdBarrier { unsigned* bar; unsigned x; volatile LAS unsigned* st; };
__device__ __forceinline__ XcdBarrier xcd_barrier_post(unsigned* bar, volatile LAS unsigned* st) {
    XcdBarrier b; b.bar = bar; b.x = xb_xcc_id(); b.st = st;
    if (threadIdx.x == 0) (void)xb_add(&bar[XB_XCNT(b.x)], 1u);
    return b;
}
__device__ __forceinline__ void xcd_barrier_complete(unsigned* bar, unsigned x, unsigned& nloc, unsigned& nx) {
    const unsigned G = gridDim.x * gridDim.y * gridDim.z;
    unsigned sum, cnt, mine, sp = 0u;
    for (;;) {
        sum = 0u; cnt = 0u; mine = 0u;
#pragma unroll
        for (unsigned j = 0; j < 16; ++j) { const unsigned c = xb_ld(&bar[XB_XCNT(j)]); sum += c; cnt += (c > 0u) ? 1u : 0u; mine = (j == x) ? c : mine; }
        if (sum == G) break;
        __builtin_amdgcn_s_sleep(1);
        if ((++sp & 255u) == 0u) { if (xb_ld(&bar[XB_TMO])) break; if (sp > XB_SPIN_CAP) { atomicAdd(&bar[XB_TMO], 1u); break; } }
    }
    nloc = mine > 0u ? mine : 1u; nx = cnt > 0u ? cnt : 1u;
}
__device__ __forceinline__ void xcd_barrier(const XcdBarrier& b) {
    asm volatile("s_waitcnt vmcnt(0)" ::: "memory");
    __syncthreads();
    if (threadIdx.x == 0) {
        unsigned* bar = b.bar;
        __builtin_amdgcn_s_waitcnt(0);
        unsigned nloc = b.st[0], nx = b.st[1];
        if (nloc == 0u) { xcd_barrier_complete(bar, b.x, nloc, nx); b.st[0] = nloc; b.st[1] = nx; }
        const unsigned old = xb_add(&bar[XB_XSUB(b.x)], 1u);
        const unsigned gen = old / nloc;
        if (old + 1u == (gen + 1u) * nloc) {
            __builtin_amdgcn_fence(__ATOMIC_RELEASE, "agent");
            asm volatile("s_waitcnt vmcnt(0)" ::: "memory");
            const unsigned og = xb_add(&bar[XB_TOP], 1u);
            const unsigned tg = og / nx;
            if (og + 1u == (tg + 1u) * nx) xb_add(&bar[XB_TOPGEN], 1u);
            else XB_SPIN(xb_ld(&bar[XB_TOPGEN]) == tg, bar);
            __builtin_amdgcn_fence(__ATOMIC_ACQUIRE, "agent");
            xb_add(&bar[XB_XGEN(b.x)], 1u);
            asm volatile("s_waitcnt vmcnt(0)" ::: "memory");
        } else {
            XB_SPIN(xb_ld(&bar[XB_XGEN(b.x)]) == gen, bar);
            __builtin_amdgcn_fence(__ATOMIC_ACQUIRE, "agent");
            asm volatile("s_waitcnt vmcnt(0)" ::: "memory");
        }
    }
    __syncthreads();
}

constexpr size_t WS_WIN = 20 * MiB;
constexpr size_t WS_WA = 40 * MiB;
constexpr size_t WS_WBR = 41 * MiB;
constexpr size_t WS_WOUT = 45 * MiB;
constexpr size_t WS_WFGU = 49 * MiB;
constexpr size_t WS_WFD = 60 * MiB;
constexpr size_t WS_WMGU = 66 * MiB;
constexpr size_t WS_WMD = 178 * MiB;
constexpr size_t WS_BAR = 4096;
constexpr int RING_BYTES = 131072, MISC_OFF = RING_BYTES + 320, PSTAT_OFF = RING_BYTES + 1024  , RSTD_OFF = RING_BYTES + 6144  , LDS_BYTES = 147456;

template <bool GAIN>
DEV void cvt_item_t(const float* W, int ldw, int k0, int n0, bf16* dst, int Kd, LAS float* scr, int lane, const float* gain) {
    const int c = lane & 7;
    f32x4 g0 = {1.f, 1.f, 1.f, 1.f}, g1 = g0;
    if (GAIN) { g0 = *(const f32x4*)(gain + k0 + 8 * c); g1 = *(const f32x4*)(gain + k0 + 8 * c + 4); }
#pragma unroll
    for (int i = 0; i < 32; ++i) { const int kk = 2 * i + (lane >> 5); scr[kk * 33 + (lane & 31)] = W[(size_t)(k0 + kk) * ldw + n0 + (lane & 31)]; }
    asm volatile("s_waitcnt lgkmcnt(0)" ::: "memory");
#pragma unroll
    for (int j = 0; j < 4; ++j) { const int n = (lane >> 3) + 8 * j; const LAS float* s = scr + (8 * c) * 33 + n;
        u32x4 o; o.x = pk2(s[0 * 33] * g0[0], s[1 * 33] * g0[1]); o.y = pk2(s[2 * 33] * g0[2], s[3 * 33] * g0[3]); o.z = pk2(s[4 * 33] * g1[0], s[5 * 33] * g1[1]); o.w = pk2(s[6 * 33] * g1[2], s[7 * 33] * g1[3]);
        *(u32x4*)(dst + (size_t)n * Kd + 8 * c) = o; }
    asm volatile("s_waitcnt lgkmcnt(0)" ::: "memory");
}
DEV void cvt_item(const float* W, int ldw, int k0, int n0, bf16* dst, int Kd, LAS float* scr, int lane) { cvt_item_t<false>(W, ldw, k0, n0, dst, Kd, scr, lane, nullptr); }
DEV void cvt_item_g(const float* W, int ldw, int k0, int n0, bf16* dst, int Kd, LAS float* scr, int lane, const float* gain) { cvt_item_t<true>(W, ldw, k0, n0, dst, Kd, scr, lane, gain); }


DEV float4 ldx4(const bf16* row, int idx) { const uint2 t = ((const uint2*)row)[idx]; return make_float4(__uint_as_float(t.x << 16), __uint_as_float(t.x & 0xffff0000u), __uint_as_float(t.y << 16), __uint_as_float(t.y & 0xffff0000u)); }
DEV int otid() { int t = threadIdx.x; asm volatile("" : "+v"(t)); return t; }
typedef float f32x16 __attribute__((ext_vector_type(16)));
typedef __bf16 bf16x2_t __attribute__((ext_vector_type(2)));
DEV unsigned pkbf(float lo, float hi) { const f32x2 v = {lo, hi}; return __builtin_bit_cast(unsigned, __builtin_convertvector(v, bf16x2_t)); }
#define MFMA32(a, b, c) __builtin_amdgcn_mfma_f32_32x32x16_bf16((a), (b), (c), 0, 0, 0)
DEV int crow(int reg, int h) { return (reg & 3) + 8 * (reg >> 2) + 4 * h; }
constexpr int VT_LD = 68;
constexpr size_t WS_DL = 2 * MiB;
constexpr size_t WS_SSQ = 2 * MiB + 262144;
constexpr size_t WS_BG = WS_LOGA;
constexpr size_t WS_SP = 458 * MiB;
constexpr size_t WS_WA2 = 40 * MiB + 131072;
#define PACK8(x, s) __builtin_bit_cast(bf16x8, (u32x4){pkbf((x)[8 * (s)], (x)[8 * (s) + 1]), pkbf((x)[8 * (s) + 2], (x)[8 * (s) + 3]), pkbf((x)[8 * (s) + 4], (x)[8 * (s) + 5]), pkbf((x)[8 * (s) + 6], (x)[8 * (s) + 7])})
DEV void stage_vt(const bf16* p, int m0, LAS bf16* vt, int tid) {
#pragma unroll
    for (int i = 0; i < 8; ++i) { const int idx = tid + 512 * i, t = idx & 63, c8 = idx >> 6;
        const u32x4 v = *(const u32x4*)(p + (size_t)(m0 + t) * PLD + P_V + c8 * 8);
        LAS bf16* dst = vt + (c8 * 8) * VT_LD + t;
        dst[0 * VT_LD] = (bf16)(v.x & 0xffffu); dst[1 * VT_LD] = (bf16)(v.x >> 16); dst[2 * VT_LD] = (bf16)(v.y & 0xffffu); dst[3 * VT_LD] = (bf16)(v.y >> 16);
        dst[4 * VT_LD] = (bf16)(v.z & 0xffffu); dst[5 * VT_LD] = (bf16)(v.z >> 16); dst[6 * VT_LD] = (bf16)(v.w & 0xffffu); dst[7 * VT_LD] = (bf16)(v.w >> 16); }
}
DEV bf16x8 vt_frag(const LAS bf16* vt, int vrow, int tbase, int hh) {
    const LAS bf16* s = vt + vrow * VT_LD + tbase + 4 * hh;
    const u32x2 lo = *(const LAS u32x2*)s, hi = *(const LAS u32x2*)(s + 8);
    return __builtin_bit_cast(bf16x8, (u32x4){lo.x, lo.y, hi.x, hi.y});
}
DEV void gla_pass1(LAS unsigned char* lds, const bf16* hb, const float* ssq, const bf16* p, const bf16* WaT, const bf16* Wa2T, const float* b_a, float* BG, float* U, float* DL, int item) {
    int tid_ = threadIdx.x; asm volatile("" : "+v"(tid_));
    const int tid = tid_, lane = tid & 63, w = __builtin_amdgcn_readfirstlane(tid >> 6), l31 = lane & 31, hh = lane >> 5, m0 = item * 64, h = w >> 1, kb = w & 1;
    LAS float* alowf = (LAS float*)lds;
    LAS bf16* alowb = (LAS bf16*)(lds + 8192);
    LAS bf16* vt = (LAS bf16*)(lds + 16384);
    const int j = 32 * w + l31;
    bf16x8 af[16], wf[16];
    {   const int tb4 = w & 3, kh = w >> 2, row = m0 + 16 * tb4 + (lane & 15), kofs = 512 * kh + 8 * (lane >> 4);
#pragma unroll
        for (int ks = 0; ks < 16; ++ks) { af[ks] = *(const bf16x8*)(hb + (size_t)row * D + kofs + 32 * ks); wf[ks] = *(const bf16x8*)(WaT + (size_t)(lane & 15) * D + kofs + 32 * ks); } }
    unsigned kraw[2][16];
#pragma unroll
    for (int tb = 0; tb < 2; ++tb)
#pragma unroll
        for (int r = 0; r < 16; ++r) kraw[tb][r] = p[(size_t)(m0 + 32 * tb + crow(r, hh)) * PLD + P_K + j];
    const bf16x8 wfrag = *(const bf16x8*)(Wa2T + j * 16 + 8 * hh);
    const float ba = b_a[j];
    {
        const int tb4 = w & 3, kh = w >> 2;
        f32x4 acc = {0.f, 0.f, 0.f, 0.f};
#pragma unroll
        for (int ks = 0; ks < 16; ++ks) acc = __builtin_amdgcn_mfma_f32_16x16x32_bf16(af[ks], wf[ks], acc, 0, 0, 0);
#pragma unroll
        for (int r = 0; r < 4; ++r) alowf[(kh * 64 + 16 * tb4 + 4 * (lane >> 4) + r) * 16 + (lane & 15)] = acc[r];
    }
    stage_vt(p, m0, vt, tid);
    __syncthreads();
    for (int i = tid; i < 1024; i += 512) alowb[i] = (bf16)f2bf((alowf[i] + alowf[1024 + i]) * row_rstd(ssq, m0 + (i >> 4)));
    __syncthreads();
    f32x16 bc[2]; float carry = 0.f;
#pragma unroll
    for (int tb = 0; tb < 2; ++tb) {
        const bf16x8 afrag = *(const LAS bf16x8*)(alowb + (32 * tb + l31) * 16 + 8 * hh);
        f32x16 z;
#pragma unroll
        for (int r = 0; r < 16; ++r) z[r] = 0.f;
        z = MFMA32(afrag, wfrag, z);
        float gs[4], other[4];
#pragma unroll
        for (int g = 0; g < 4; ++g) {
#pragma unroll
            for (int e = 0; e < 4; ++e) { const float zz = z[4 * g + e] + ba; const float la = (fminf(zz, 0.f) - __logf(1.0f + __expf(-fabsf(zz)))) * (1.0f / 16.0f); z[4 * g + e] = la + (e ? z[4 * g + e - 1] : 0.f); }
            gs[g] = z[4 * g + 3]; other[g] = __shfl_xor(gs[g], 32);
        }
        float run = carry;
#pragma unroll
        for (int g = 0; g < 4; ++g) { const float h0 = hh ? other[g] : gs[g], h1 = hh ? gs[g] : other[g]; const float off = run + (hh ? h0 : 0.f);
#pragma unroll
            for (int e = 0; e < 4; ++e) bc[tb][4 * g + e] = z[4 * g + e] + off;
            run += h0 + h1; }
        carry = run;
    }
    const float blast = carry;
#pragma unroll
    for (int tb = 0; tb < 2; ++tb)
#pragma unroll
        for (int r = 0; r < 16; ++r) BG[(size_t)(m0 + 32 * tb + crow(r, hh)) * KW + j] = bc[tb][r];
    if (hh == 0) DL[(size_t)(item * 4 + h) * 64 + 32 * kb + l31] = __expf(blast);
    f32x16 kh2[2];
#pragma unroll
    for (int tb = 0; tb < 2; ++tb)
#pragma unroll
        for (int r = 0; r < 16; ++r) kh2[tb][r] = bf2f(kraw[tb][r]) * __expf(blast - bc[tb][r]);
#pragma unroll
    for (int vb = 0; vb < 4; ++vb) {
        f32x16 acc;
#pragma unroll
        for (int r = 0; r < 16; ++r) acc[r] = 0.f;
        const int vrow = 128 * h + 32 * vb + l31;
#pragma unroll
        for (int tb = 0; tb < 2; ++tb) { acc = MFMA32(vt_frag(vt, vrow, 32 * tb, hh), PACK8(kh2[tb], 0), acc); acc = MFMA32(vt_frag(vt, vrow, 32 * tb + 16, hh), PACK8(kh2[tb], 1), acc); }
#pragma unroll
        for (int r = 0; r < 16; ++r) U[((size_t)(item * 4 + h) * 128 + 32 * vb + crow(r, hh)) * 64 + 32 * kb + l31] = acc[r];
    }
}
DEV void conv_item(bf16* p, const float* cw, int item) {
    int tid_ = threadIdx.x; asm volatile("" : "+v"(tid_));
    const int tid = tid_, c0 = (tid & 63) * 8, tr = tid >> 6, m0 = item * 64 + 8 * tr, ts0 = m0 % SEQ;
    u32x4 xv[10], gv[10], bv[8];
#pragma unroll
    for (int i = 0; i < 10; ++i) { const bool ok = i >= 2 || ts0 > 0; const size_t r = (size_t)(ok ? m0 - 2 + i : m0) * PLD;
        xv[i] = *(const u32x4*)(p + r + P_XC + c0); gv[i] = *(const u32x4*)(p + r + P_GC + c0); if (!ok) { xv[i] = (u32x4){0u, 0u, 0u, 0u}; } }
#pragma unroll
    for (int i = 0; i < 8; ++i) bv[i] = *(const u32x4*)(p + (size_t)(m0 + i) * PLD + P_GB + c0);
    float w0[8], w1[8], w2[8];
#pragma unroll
    for (int e = 0; e < 8; ++e) { w0[e] = cw[0 * CC + c0 + e]; w1[e] = cw[1 * CC + c0 + e]; w2[e] = cw[2 * CC + c0 + e]; }
    float u[10][8];
#pragma unroll
    for (int i = 0; i < 10; ++i) { u[i][0] = blo(xv[i].x) * blo(gv[i].x); u[i][1] = bhi(xv[i].x) * bhi(gv[i].x); u[i][2] = blo(xv[i].y) * blo(gv[i].y); u[i][3] = bhi(xv[i].y) * bhi(gv[i].y);
        u[i][4] = blo(xv[i].z) * blo(gv[i].z); u[i][5] = bhi(xv[i].z) * bhi(gv[i].z); u[i][6] = blo(xv[i].w) * blo(gv[i].w); u[i][7] = bhi(xv[i].w) * bhi(gv[i].w); }
#pragma unroll
    for (int tt = 0; tt < 8; ++tt) {
        const float gbv[8] = {blo(bv[tt].x), bhi(bv[tt].x), blo(bv[tt].y), bhi(bv[tt].y), blo(bv[tt].z), bhi(bv[tt].z), blo(bv[tt].w), bhi(bv[tt].w)};
        float y[8];
#pragma unroll
        for (int e = 0; e < 8; ++e) y[e] = gbv[e] * (w0[e] * u[tt][e] + w1[e] * u[tt + 1][e] + w2[e] * u[tt + 2][e]);
        u32x4 o; o.x = pkbf(y[0], y[1]); o.y = pkbf(y[2], y[3]); o.z = pkbf(y[4], y[5]); o.w = pkbf(y[6], y[7]);
        *(u32x4*)(p + (size_t)(m0 + tt) * PLD + P_GB + c0) = o;
    }
}
DEV void gla_scan(const float* U, const float* DL, bf16* Sp, int bx, int nthreads) {
    const int gtid = bx * 512 + otid();
    for (int idx = gtid; idx < BATCH * NH * 128 * 16; idx += nthreads) {
        const int bh = idx >> 11, v = (idx >> 4) & 127, k4 = idx & 15, b = bh >> 2, h = bh & 3;
        f32x4 S = {0.f, 0.f, 0.f, 0.f};
#pragma unroll 8
        for (int n = 0; n < SEQ / 64; ++n) { const int item = b * (SEQ / 64) + n; const size_t base = ((size_t)(item * 4 + h) * 128 + v) * 64 + k4 * 4;
            const f32x4 u = *(const f32x4*)(U + base), d = *(const f32x4*)(DL + (size_t)(item * 4 + h) * 64 + k4 * 4);
            u32x2 o; o.x = pkbf(S[0], S[1]); o.y = pkbf(S[2], S[3]); *(u32x2*)(Sp + base) = o;
            S = d * S + u; }
    }
}
DEV void gla_pass3(LAS unsigned char* lds, bf16* p, const float* BG, const bf16* Sp, const float* gn, int item, bf16* ydst, int yld) {
    int tid_ = threadIdx.x; asm volatile("" : "+v"(tid_));
    const int tid = tid_, lane = tid & 63, w = __builtin_amdgcn_readfirstlane(tid >> 6), l31 = lane & 31, hh = lane >> 5, m0 = item * 64, h = w >> 1, vh = w & 1;
    LAS float* ssb = (LAS float*)lds;
    LAS bf16* vt = (LAS bf16*)(lds + 16384);
    stage_vt(p, m0, vt, tid);
    bf16x8 qf[2][4], kf[2][4];
#pragma unroll
    for (int blk = 0; blk < 2; ++blk)
#pragma unroll
        for (int ks = 0; ks < 4; ++ks) { const size_t row = (size_t)(m0 + 32 * blk + l31); const int kk = 64 * h + 16 * ks + 8 * hh;
            const u32x4 qv = *(const u32x4*)(p + row * PLD + P_Q + kk), kv = *(const u32x4*)(p + row * PLD + P_K + kk);
            const f32x4 b0 = *(const f32x4*)(BG + row * KW + kk), b1 = *(const f32x4*)(BG + row * KW + kk + 4);
            float ep[8], em[8];
#pragma unroll
            for (int e = 0; e < 4; ++e) { ep[e] = 0.125f * __expf(b0[e]); ep[4 + e] = 0.125f * __expf(b1[e]); em[e] = __expf(-b0[e]); em[4 + e] = __expf(-b1[e]); }
            qf[blk][ks] = __builtin_bit_cast(bf16x8, (u32x4){pkbf(blo(qv.x) * ep[0], bhi(qv.x) * ep[1]), pkbf(blo(qv.y) * ep[2], bhi(qv.y) * ep[3]), pkbf(blo(qv.z) * ep[4], bhi(qv.z) * ep[5]), pkbf(blo(qv.w) * ep[6], bhi(qv.w) * ep[7])});
            kf[blk][ks] = __builtin_bit_cast(bf16x8, (u32x4){pkbf(blo(kv.x) * em[0], bhi(kv.x) * em[1]), pkbf(blo(kv.y) * em[2], bhi(kv.y) * em[3]), pkbf(blo(kv.z) * em[4], bhi(kv.z) * em[5]), pkbf(blo(kv.w) * em[6], bhi(kv.w) * em[7])}); }
    bf16x8 spf[2][4];
#pragma unroll
    for (int vb = 0; vb < 2; ++vb)
#pragma unroll
        for (int ks = 0; ks < 4; ++ks) spf[vb][ks] = *(const bf16x8*)(Sp + ((size_t)(item * 4 + h) * 128 + 64 * vh + 32 * vb + l31) * 64 + 16 * ks + 8 * hh);
    f32x16 X00, X01, X11;
#pragma unroll
    for (int r = 0; r < 16; ++r) { X00[r] = 0.f; X01[r] = 0.f; X11[r] = 0.f; }
#pragma unroll
    for (int ks = 0; ks < 4; ++ks) { X00 = MFMA32(kf[0][ks], qf[0][ks], X00); X01 = MFMA32(kf[0][ks], qf[1][ks], X01); X11 = MFMA32(kf[1][ks], qf[1][ks], X11); }
#pragma unroll
    for (int r = 0; r < 16; ++r) if (crow(r, hh) > l31) { X00[r] = 0.f; X11[r] = 0.f; }
    f32x4 gnv[2][4];
#pragma unroll
    for (int vb = 0; vb < 2; ++vb)
#pragma unroll
        for (int g = 0; g < 4; ++g) gnv[vb][g] = *(const f32x4*)(gn + 64 * vh + 32 * vb + 8 * g + 4 * hh);
    u32x2 gvv[2][2][4];
#pragma unroll
    for (int vb = 0; vb < 2; ++vb)
#pragma unroll
        for (int ib = 0; ib < 2; ++ib)
#pragma unroll
            for (int g = 0; g < 4; ++g) gvv[vb][ib][g] = *(const u32x2*)(p + (size_t)(m0 + 32 * ib + l31) * PLD + P_GO + 128 * h + 64 * vh + 32 * vb + 8 * g + 4 * hh);
    __syncthreads();
    f32x16 O[2][2];
#pragma unroll
    for (int vb = 0; vb < 2; ++vb) {
        f32x16 O0, O1;
#pragma unroll
        for (int r = 0; r < 16; ++r) { O0[r] = 0.f; O1[r] = 0.f; }
        const int vloc = 64 * vh + 32 * vb + l31, vrow = 128 * h + vloc;
#pragma unroll
        for (int ks = 0; ks < 4; ++ks) { const bf16x8 sf = spf[vb][ks]; O0 = MFMA32(sf, qf[0][ks], O0); O1 = MFMA32(sf, qf[1][ks], O1); }
        { const bf16x8 a0 = vt_frag(vt, vrow, 0, hh), a1 = vt_frag(vt, vrow, 16, hh), a2 = vt_frag(vt, vrow, 32, hh), a3 = vt_frag(vt, vrow, 48, hh);
          O0 = MFMA32(a0, PACK8(X00, 0), O0); O0 = MFMA32(a1, PACK8(X00, 1), O0);
          O1 = MFMA32(a0, PACK8(X01, 0), O1); O1 = MFMA32(a1, PACK8(X01, 1), O1);
          O1 = MFMA32(a2, PACK8(X11, 0), O1); O1 = MFMA32(a3, PACK8(X11, 1), O1); }
        O[vb][0] = O0; O[vb][1] = O1;
    }
    float ss0 = 0.f, ss1 = 0.f;
#pragma unroll
    for (int vb = 0; vb < 2; ++vb)
#pragma unroll
        for (int r = 0; r < 16; ++r) { ss0 += O[vb][0][r] * O[vb][0][r]; ss1 += O[vb][1][r] * O[vb][1][r]; }
    ss0 += __shfl_xor(ss0, 32); ss1 += __shfl_xor(ss1, 32);
    if (hh == 0) { ssb[w * 64 + l31] = ss0; ssb[w * 64 + 32 + l31] = ss1; }
    __syncthreads();
    float rstd[2];
#pragma unroll
    for (int ib = 0; ib < 2; ++ib) rstd[ib] = rsqrtf((ssb[(2 * h) * 64 + 32 * ib + l31] + ssb[(2 * h + 1) * 64 + 32 * ib + l31]) * (1.0f / 128.0f) + EPS);
#pragma unroll
    for (int vb = 0; vb < 2; ++vb)
#pragma unroll
        for (int ib = 0; ib < 2; ++ib)
#pragma unroll
            for (int g = 0; g < 4; ++g) { const int v0 = 64 * vh + 32 * vb + 8 * g + 4 * hh; bf16* dst = ydst + (size_t)(m0 + 32 * ib + l31) * yld + 128 * h + v0;
                const u32x2 gv = gvv[vb][ib][g]; const f32x4 gg = gnv[vb][g];
                const float g0 = blo(gv.x), g1 = bhi(gv.x), g2 = blo(gv.y), g3 = bhi(gv.y);
                u32x2 o; o.x = pkbf(O[vb][ib][4 * g] * rstd[ib] * gg[0] * g0 * fsig(g0), O[vb][ib][4 * g + 1] * rstd[ib] * gg[1] * g1 * fsig(g1));
                o.y = pkbf(O[vb][ib][4 * g + 2] * rstd[ib] * gg[2] * g2 * fsig(g2), O[vb][ib][4 * g + 3] * rstd[ib] * gg[3] * g3 * fsig(g3));
                *(u32x2*)dst = o; }
}

DEV void xb_rows(const float* x, bf16* xb, float* ssq, int gw, int ngw) {
    const int lane = otid() & 63;
    for (int m0 = gw; m0 < M; m0 += 2 * ngw) {
        const int m1 = m0 + ngw < M ? m0 + ngw : m0;
        const float4* xr0 = (const float4*)(x + (size_t)m0 * D); const float4* xr1 = (const float4*)(x + (size_t)m1 * D);
        float4 v0[4], v1[4];
#pragma unroll
        for (int j = 0; j < 4; ++j) { v0[j] = xr0[lane + 64 * j]; v1[j] = xr1[lane + 64 * j]; }
        uint2* o0 = (uint2*)(xb + (size_t)m0 * D); uint2* o1 = (uint2*)(xb + (size_t)m1 * D); float s0 = 0.f, s1 = 0.f;
#pragma unroll
        for (int j = 0; j < 4; ++j) { s0 += v0[j].x * v0[j].x + v0[j].y * v0[j].y + v0[j].z * v0[j].z + v0[j].w * v0[j].w; s1 += v1[j].x * v1[j].x + v1[j].y * v1[j].y + v1[j].z * v1[j].z + v1[j].w * v1[j].w;
            uint2 w; w.x = pk2(v0[j].x, v0[j].y); w.y = pk2(v0[j].z, v0[j].w); o0[lane + 64 * j] = w; w.x = pk2(v1[j].x, v1[j].y); w.y = pk2(v1[j].z, v1[j].w); o1[lane + 64 * j] = w; }
        s0 = wave_sum(s0); s1 = wave_sum(s1);
        if (lane < 4) { ssq[(size_t)lane * M + m0] = lane == 0 ? s0 : 0.f; ssq[(size_t)lane * M + m1] = lane == 0 ? s1 : 0.f; }
    }
}
DEV void rms_rows(const float* x, const float* g, bf16* hb, int gw, int ngw) {
    const int lane = otid() & 63;
    for (int m = gw; m < M; m += ngw) {
        const float4* xr = (const float4*)(x + (size_t)m * D); const float4* gr = (const float4*)g;
        float4 v[4]; float ss = 0.f;
#pragma unroll
        for (int j = 0; j < 4; ++j) { v[j] = xr[lane + 64 * j]; ss += v[j].x * v[j].x + v[j].y * v[j].y + v[j].z * v[j].z + v[j].w * v[j].w; }
        const float rstd = rsqrtf(wave_sum(ss) * (1.0f / D) + EPS);
        uint2* o = (uint2*)(hb + (size_t)m * D);
#pragma unroll
        for (int j = 0; j < 4; ++j) { const float4 gg = gr[lane + 64 * j]; uint2 w; w.x = pk2(v[j].x * rstd * gg.x, v[j].y * rstd * gg.y); w.y = pk2(v[j].z * rstd * gg.z, v[j].w * rstd * gg.w); o[lane + 64 * j] = w; }
    }
}
DEV void route1_stage(LAS float* wT, const float* g2, const float* wr) {
    const int tid = otid();
    for (int k = tid; k < D; k += 512) { const float g = g2[k]; const float4 w0 = *(const float4*)(wr + (size_t)k * 8), w1 = *(const float4*)(wr + (size_t)k * 8 + 4);
        wT[0 * D + k] = w0.x * g; wT[1 * D + k] = w0.y * g; wT[2 * D + k] = w0.z * g; wT[3 * D + k] = w0.w * g; wT[4 * D + k] = w1.x * g; wT[5 * D + k] = w1.y * g; wT[6 * D + k] = w1.z * g; wT[7 * D + k] = w1.w * g; }
    __syncthreads();
}
DEV void route1_grp(const LAS float* wT, LAS int* lcnt, const bf16* x, float* rstd_o, int* tok_e, float* tok_w, int* counts, int grp) {
    const int tid = otid(), lane = tid & 63, wave = tid >> 6;
    if (tid < 8) lcnt[tid] = 0;
    __syncthreads();
    const int hh = lane >> 5, b4 = (lane >> 4) & 1, b3 = (lane >> 3) & 1;
    uint2 xraw[8][4];
#pragma unroll
    for (int i = 0; i < 8; ++i)
#pragma unroll
        for (int j = 0; j < 4; ++j) xraw[i][j] = ((const uint2*)(x + (size_t)(grp * 64 + wave * 8 + i) * D))[lane + 64 * j];
#pragma unroll
    for (int i = 0; i < 8; ++i) {
        const int m = grp * 64 + wave * 8 + i;
        float4 v[4]; float ss = 0.f; float a[8];
#pragma unroll
        for (int e = 0; e < 8; ++e) a[e] = 0.f;
#pragma unroll
        for (int j = 0; j < 4; ++j) { const uint2 t = xraw[i][j]; v[j] = make_float4(blo(t.x), bhi(t.x), blo(t.y), bhi(t.y)); ss += v[j].x * v[j].x + v[j].y * v[j].y + v[j].z * v[j].z + v[j].w * v[j].w; }
#pragma unroll
        for (int j = 0; j < 4; ++j)
#pragma unroll
            for (int e = 0; e < 8; ++e) { const f32x4 w = *(const LAS f32x4*)(wT + e * D + 4 * (lane + 64 * j)); a[e] += v[j].x * w[0] + v[j].y * w[1] + v[j].z * w[2] + v[j].w * w[3]; }
        ss = wave_sum(ss);
        float c4[4], c2[2];
#pragma unroll
        for (int e = 0; e < 4; ++e) { const float keep = hh ? a[e + 4] : a[e], send = hh ? a[e] : a[e + 4]; c4[e] = keep + __shfl_xor(send, 32); }
#pragma unroll
        for (int e = 0; e < 2; ++e) { const float keep = b4 ? c4[e + 2] : c4[e], send = b4 ? c4[e] : c4[e + 2]; c2[e] = keep + __shfl_xor(send, 16); }
        float c1 = (b3 ? c2[1] : c2[0]) + __shfl_xor(b3 ? c2[0] : c2[1], 8);
        c1 += __shfl_xor(c1, 4); c1 += __shfl_xor(c1, 2); c1 += __shfl_xor(c1, 1);
        const float rstd = rsqrtf(ss * (1.0f / D) + EPS);
        float lg[8];
#pragma unroll
        for (int e = 0; e < 8; ++e) lg[e] = __uint_as_float(__builtin_amdgcn_readlane((int)__float_as_uint(c1), 32 * (e >> 2) + 16 * ((e >> 1) & 1) + 8 * (e & 1))) * rstd;
        int i1 = 0; float l1 = lg[0];
#pragma unroll
        for (int e = 1; e < 8; ++e) if (lg[e] > l1) { l1 = lg[e]; i1 = e; }
        int i2 = -1; float l2 = -3.0e38f;
#pragma unroll
        for (int e = 0; e < 8; ++e) if (e != i1 && lg[e] > l2) { l2 = lg[e]; i2 = e; }
        const float ex = expf(l2 - l1), w1v = 1.0f / (1.0f + ex), w2v = ex / (1.0f + ex);
        if (lane == 0) { rstd_o[m] = rstd; tok_e[m * 2] = i1; tok_e[m * 2 + 1] = i2; tok_w[m * 2] = w1v; tok_w[m * 2 + 1] = w2v;
            __hip_atomic_fetch_add(&lcnt[i1], 1, __ATOMIC_RELAXED, __HIP_MEMORY_SCOPE_WORKGROUP); __hip_atomic_fetch_add(&lcnt[i2], 1, __ATOMIC_RELAXED, __HIP_MEMORY_SCOPE_WORKGROUP); }
    }
    __syncthreads();
    if (tid < 8) counts[grp * 8 + tid] = lcnt[tid];
    __syncthreads();
}
DEV void route2_grp(LAS int* L, const bf16* x, const float* g2, const float* rstd_i, const int* counts, const int* tok_e, int* slot, unsigned char* hbp, int* tilet, int grp, int wgi, int nwg) {
    LAS int* ltot = L; LAS int* lpre = L + 8; LAS int* lseg = L + 16; LAS int* lslot = L + 32; LAS int* lte = L + 160;
    const int tid = otid(), lane = tid & 63, wave = tid >> 6;
    if (tid < 128) lte[tid] = tok_e[(grp * 64) * 2 + tid];
    { int tot = 0, pre = 0;
#pragma unroll
        for (int q = 0; q < 4; ++q) { const int w = lane + 64 * q; const int c = counts[w * 8 + wave]; tot += c; pre += (w < grp) ? c : 0; }
#pragma unroll
        for (int o = 1; o < 64; o <<= 1) { tot += __shfl_xor(tot, o); pre += __shfl_xor(pre, o); }
        if (lane == 0) { ltot[wave] = tot; lpre[wave] = pre; } }
    __syncthreads();
    if (tid == 0) { int off = 0; for (int e = 0; e < 8; ++e) { lseg[e] = off; off += ((ltot[e] + 255) / 256) * 256; } lseg[8] = off; }
    __syncthreads();
    { const int base = lseg[wave] + lpre[wave]; const bool m0 = lte[2 * lane] == wave, m1 = lte[2 * lane + 1] == wave;
        const unsigned long long b0 = __ballot(m0), b1 = __ballot(m1), lt = (1ull << lane) - 1ull;
        const int r0 = __popcll(b0 & lt) + __popcll(b1 & lt);
        if (m0) lslot[2 * lane] = base + r0;
        if (m1) lslot[2 * lane + 1] = base + r0 + (m0 ? 1 : 0); }
    __syncthreads();
    if (tid < 128) slot[(grp * 64) * 2 + tid] = lslot[tid];
    {   const float4* gr = (const float4*)g2; float4 gq[4];
#pragma unroll
        for (int j = 0; j < 4; ++j) gq[j] = gr[lane + 64 * j];
        uint2 xraw[8][4]; float rs[8];
#pragma unroll
        for (int q = 0; q < 8; ++q) { const int m = grp * 64 + wave + 8 * q; rs[q] = rstd_i[m];
#pragma unroll
            for (int j = 0; j < 4; ++j) xraw[q][j] = ((const uint2*)(x + (size_t)m * D))[lane + 64 * j]; }
#pragma unroll
        for (int q = 0; q < 8; ++q) { const int i = wave + 8 * q; const float rstd = rs[q];
            unsigned* o1 = (unsigned*)(hbp + (size_t)lslot[2 * i] * D); unsigned* o2 = (unsigned*)(hbp + (size_t)lslot[2 * i + 1] * D);
#pragma unroll
            for (int j = 0; j < 4; ++j) { const uint2 t = xraw[q][j]; const float4 gg = gq[j]; const unsigned w = pk4_fp8(blo(t.x) * rstd * gg.x, bhi(t.x) * rstd * gg.y, blo(t.y) * rstd * gg.z, bhi(t.y) * rstd * gg.w); o1[lane + 64 * j] = w; o2[lane + 64 * j] = w; } }
    }
    if (grp == 0) {
        if (tid < NTILE_MAX) { const int r = tid * 256; int e = -1; for (int q = 0; q < 8; ++q) if (r >= lseg[q] && r < lseg[q + 1]) e = q; tilet[tid] = e; }
        if (tid == 0) tilet[NTILE_MAX] = lseg[8] / 256;
    }
    if (grp == wgi) {
        for (int e = 0; e < 8; ++e) { const int r0 = lseg[e] + ltot[e], r1 = lseg[e + 1];
            for (int r = r0 + wgi; r < r1; r += nwg) if (tid < 256) ((unsigned*)(hbp + (size_t)r * D))[tid] = 0u; }
    }
    __syncthreads();
}
DEV void combine_rows(const bf16* x, const bf16* obuf, const float* obx, const int* slot, const float* tok_w, const float* gf, float* out, int gw, int ngw) {
    const int lane = otid() & 63;
    const float4* gr = (const float4*)gf; float4 gq[4];
#pragma unroll
    for (int j = 0; j < 4; ++j) gq[j] = gr[lane + 64 * j];
    for (int m0 = gw; m0 < M; m0 += 2 * ngw) {
        const int mm[2] = {m0, m0 + ngw < M ? m0 + ngw : m0};
        int s1[2], s2[2]; float w1[2], w2[2];
#pragma unroll
        for (int q = 0; q < 2; ++q) { const int2 sl = *(const int2*)(slot + mm[q] * 2); const float2 tw = *(const float2*)(tok_w + mm[q] * 2); s1[q] = sl.x; s2[q] = sl.y; w1[q] = tw.x; w2[q] = tw.y; }
        float4 v[2][4], ea[2][4], ec[2][4];
        if (s1[0] < 128 * 256 && s2[0] < 128 * 256 && s1[1] < 128 * 256 && s2[1] < 128 * 256) {
            uint2 xa[2][4], oa[2][4], oc[2][4];
#pragma unroll
            for (int q = 0; q < 2; ++q)
#pragma unroll
                for (int j = 0; j < 4; ++j) { xa[q][j] = ((const uint2*)(x + (size_t)mm[q] * D))[lane + 64 * j]; oa[q][j] = ((const uint2*)(obuf + (size_t)s1[q] * D))[lane + 64 * j]; oc[q][j] = ((const uint2*)(obuf + (size_t)s2[q] * D))[lane + 64 * j]; }
#pragma unroll
            for (int q = 0; q < 2; ++q)
#pragma unroll
                for (int j = 0; j < 4; ++j) { v[q][j] = make_float4(blo(xa[q][j].x), bhi(xa[q][j].x), blo(xa[q][j].y), bhi(xa[q][j].y)); ea[q][j] = make_float4(blo(oa[q][j].x), bhi(oa[q][j].x), blo(oa[q][j].y), bhi(oa[q][j].y)); ec[q][j] = make_float4(blo(oc[q][j].x), bhi(oc[q][j].x), blo(oc[q][j].y), bhi(oc[q][j].y)); }
        } else
#pragma unroll
        for (int q = 0; q < 2; ++q) {
            const bf16* xr = x + (size_t)mm[q] * D; const uint2* o1 = (const uint2*)(obuf + (size_t)s1[q] * D); const uint2* o2 = (const uint2*)(obuf + (size_t)s2[q] * D);
#pragma unroll
            for (int j = 0; j < 4; ++j) { v[q][j] = ldx4(xr, lane + 64 * j);
                if (s1[q] < 128 * 256) { const uint2 a = o1[lane + 64 * j]; ea[q][j] = make_float4(blo(a.x), bhi(a.x), blo(a.y), bhi(a.y)); }
                else { float4 e = make_float4(0.f, 0.f, 0.f, 0.f); for (int ks = 0; ks < KSPLIT; ++ks) { const float4 t = ((const float4*)(obx + ((size_t)ks * 2048 + (s1[q] - 128 * 256)) * D))[lane + 64 * j]; e.x += t.x; e.y += t.y; e.z += t.z; e.w += t.w; } ea[q][j] = e; }
                if (s2[q] < 128 * 256) { const uint2 c = o2[lane + 64 * j]; ec[q][j] = make_float4(blo(c.x), bhi(c.x), blo(c.y), bhi(c.y)); }
                else { float4 e = make_float4(0.f, 0.f, 0.f, 0.f); for (int ks = 0; ks < KSPLIT; ++ks) { const float4 t = ((const float4*)(obx + ((size_t)ks * 2048 + (s2[q] - 128 * 256)) * D))[lane + 64 * j]; e.x += t.x; e.y += t.y; e.z += t.z; e.w += t.w; } ec[q][j] = e; } }
        }
#pragma unroll
        for (int q = 0; q < 2; ++q) { float ss = 0.f;
#pragma unroll
            for (int j = 0; j < 4; ++j) { v[q][j].x += w1[q] * ea[q][j].x + w2[q] * ec[q][j].x; v[q][j].y += w1[q] * ea[q][j].y + w2[q] * ec[q][j].y; v[q][j].z += w1[q] * ea[q][j].z + w2[q] * ec[q][j].z; v[q][j].w += w1[q] * ea[q][j].w + w2[q] * ec[q][j].w;
                ss += v[q][j].x * v[q][j].x + v[q][j].y * v[q][j].y + v[q][j].z * v[q][j].z + v[q][j].w * v[q][j].w; }
            const float rstd = rsqrtf(wave_sum(ss) * (1.0f / D) + EPS);
            float4* orow = (float4*)(out + (size_t)mm[q] * D);
#pragma unroll
            for (int j = 0; j < 4; ++j) orow[lane + 64 * j] = make_float4(v[q][j].x * rstd * gq[j].x, v[q][j].y * rstd * gq[j].y, v[q][j].z * rstd * gq[j].z, v[q][j].w * rstd * gq[j].w); }
    }
}

DEV void cvt_item8(const float* W, int ldw, int k0, int n0, unsigned char* dst, int Kd, LAS float* scr, int lane) {
#pragma unroll
    for (int i = 0; i < 32; ++i) { const int kk = 2 * i + (lane >> 5); scr[kk * 33 + (lane & 31)] = W[(size_t)(k0 + kk) * ldw + n0 + (lane & 31)]; }
    asm volatile("s_waitcnt lgkmcnt(0)" ::: "memory");
    const int c = lane & 3;
#pragma unroll
    for (int j = 0; j < 2; ++j) { const int n = (lane >> 2) + 16 * j; const LAS float* sp = scr + (16 * c) * 33 + n;
        u32x4 o; o.x = pk4_fp8(sp[0 * 33] * W8_SCALE, sp[1 * 33] * W8_SCALE, sp[2 * 33] * W8_SCALE, sp[3 * 33] * W8_SCALE); o.y = pk4_fp8(sp[4 * 33] * W8_SCALE, sp[5 * 33] * W8_SCALE, sp[6 * 33] * W8_SCALE, sp[7 * 33] * W8_SCALE);
        o.z = pk4_fp8(sp[8 * 33] * W8_SCALE, sp[9 * 33] * W8_SCALE, sp[10 * 33] * W8_SCALE, sp[11 * 33] * W8_SCALE); o.w = pk4_fp8(sp[12 * 33] * W8_SCALE, sp[13 * 33] * W8_SCALE, sp[14 * 33] * W8_SCALE, sp[15 * 33] * W8_SCALE);
        *(u32x4*)(dst + (size_t)n * Kd + 16 * c) = o; }
    asm volatile("s_waitcnt lgkmcnt(0)" ::: "memory");
}
struct CvtD { const float* W; const float* gain; unsigned char* dst; int ldw, k0, n0, Kd, kind; };
DEV void cvt_load(const CvtD& d, int lane, float (&r)[32]) {
#pragma unroll
    for (int i = 0; i < 8; ++i) { const f32x4 t = *(const f32x4*)(d.W + (size_t)(d.k0 + 8 * i + (lane >> 3)) * d.ldw + d.n0 + 4 * (lane & 7)); r[4 * i] = t[0]; r[4 * i + 1] = t[1]; r[4 * i + 2] = t[2]; r[4 * i + 3] = t[3]; }
}
DEV void cvt_finish(const CvtD& d, const float (&r)[32], LAS float* scr, int lane) {
#pragma unroll
    for (int i = 0; i < 8; ++i)
#pragma unroll
        for (int e = 0; e < 4; ++e) scr[(8 * i + (lane >> 3)) * 33 + 4 * (lane & 7) + e] = r[4 * i + e];
    asm volatile("s_waitcnt lgkmcnt(0)" ::: "memory");
    if (d.kind == 2) {
        const int c = lane & 3;
#pragma unroll
        for (int j = 0; j < 2; ++j) { const int n = (lane >> 2) + 16 * j; const LAS float* sp = scr + (16 * c) * 33 + n;
            u32x4 o; o.x = pk4_fp8(sp[0 * 33] * W8_SCALE, sp[1 * 33] * W8_SCALE, sp[2 * 33] * W8_SCALE, sp[3 * 33] * W8_SCALE); o.y = pk4_fp8(sp[4 * 33] * W8_SCALE, sp[5 * 33] * W8_SCALE, sp[6 * 33] * W8_SCALE, sp[7 * 33] * W8_SCALE);
            o.z = pk4_fp8(sp[8 * 33] * W8_SCALE, sp[9 * 33] * W8_SCALE, sp[10 * 33] * W8_SCALE, sp[11 * 33] * W8_SCALE); o.w = pk4_fp8(sp[12 * 33] * W8_SCALE, sp[13 * 33] * W8_SCALE, sp[14 * 33] * W8_SCALE, sp[15 * 33] * W8_SCALE);
            *(u32x4*)(d.dst + (size_t)n * d.Kd + 16 * c) = o; }
    } else {
        const int c = lane & 7;
        f32x4 g0 = {1.f, 1.f, 1.f, 1.f}, g1 = g0;
        if (d.kind == 1) { g0 = *(const f32x4*)(d.gain + d.k0 + 8 * c); g1 = *(const f32x4*)(d.gain + d.k0 + 8 * c + 4); }
#pragma unroll
        for (int j = 0; j < 4; ++j) { const int n = (lane >> 3) + 8 * j; const LAS float* sp = scr + (8 * c) * 33 + n;
            u32x4 o; o.x = pk2(sp[0 * 33] * g0[0], sp[1 * 33] * g0[1]); o.y = pk2(sp[2 * 33] * g0[2], sp[3 * 33] * g0[3]); o.z = pk2(sp[4 * 33] * g1[0], sp[5 * 33] * g1[1]); o.w = pk2(sp[6 * 33] * g1[2], sp[7 * 33] * g1[3]);
            *(u32x4*)(d.dst + ((size_t)n * d.Kd + 8 * c) * 2) = o; }
    }
    asm volatile("s_waitcnt lgkmcnt(0)" ::: "memory");
}
struct Args { const float* in[18]; float* out; unsigned char* ws; int ph_lo, ph_hi; };
enum { PH_CVT = 0, PH_G1 = 1, PH_GLA1 = 2, PH_SCAN = 3, PH_GLA3 = 4, PH_G2 = 5, PH_G3 = 6, PH_RMS2 = 7, PH_UP = 8, PH_DOWN = 9, PH_RMS1 = 10, PH_LAYER = 16, PH_ROUTE1 = 23, PH_ROUTE2 = 24, PH_MUPA = 25, PH_MDOWNA = 26, PH_MUPB = 27, PH_MDOWNB = 28, PH_COMBINE = 29, PH_END = 30 };

__global__ void __launch_bounds__(512, 2) mega(Args args) {
    extern __shared__ __attribute__((aligned(16))) unsigned char lds_raw[];
    LAS unsigned char* lds = (LAS unsigned char*)lds_raw;
    const int wave = __builtin_amdgcn_readfirstlane((int)threadIdx.x >> 6);
    const int G = gridDim.x, bx = blockIdx.x;
    unsigned char* ws = args.ws;
    const int lo = args.ph_lo, hi = args.ph_hi;
#define IN(k) (lo <= (k) && (k) < hi)
#define SEAM(k) do { if ((k) + 1 < hi) { xcd_barrier(bar); if (DUP_PH == 99) xcd_barrier(bar); } } while (0)
    volatile LAS unsigned* MISC = (volatile LAS unsigned*)(lds + MISC_OFF);
    if (threadIdx.x < 16) MISC[threadIdx.x] = 0u;
    __syncthreads();
    XcdBarrier bar = xcd_barrier_post((unsigned*)(ws + WS_BAR), MISC + 8);
    const int gw = bx * 8 + wave, ngw = G * 8;
    if (IN(PH_CVT)) {
        const int tid = otid(), lane = tid & 63;
        LAS float* scr = (LAS float*)(lds + wave * 16384);
        const int NGW = ngw;
        constexpr int I_IN = 16 * 160, I_BR = 8 * 32, I_OUT = 16 * 32, I_FGU = 16 * 88, I_FD = 44 * 32, I_MGU = 16 * 112, I_MD = 56 * 32;
        constexpr int I_LAYER = I_IN + 2 * I_BR + I_OUT, I_FFN = 2 * I_FGU + I_FD, I_EXP = 2 * I_MGU + I_MD, NITEMS = 2 * I_LAYER + I_FFN + 8 * I_EXP;
        auto decode = [&](int it) -> CvtD {
            CvtD d; int r = it;
            if (r < 2 * I_LAYER) { const int l = r / I_LAYER; r -= l * I_LAYER;
                if (r < I_IN) { const int kb = r / 160, nb = r % 160, n0d = nb * 32, n0s = n0d < 3072 ? n0d : n0d + 16;
                    d.W = args.in[2] + (size_t)l * D * IN_COLS; d.ldw = IN_COLS; d.k0 = kb * 64; d.n0 = n0s; d.dst = ws + WS_WIN + (((size_t)l * PLD + n0d) * D + kb * 64) * 2; d.Kd = D; d.gain = args.in[1] + l * D; d.kind = 1; return d; }
                r -= I_IN;
                if (r < 2 * I_BR) { const int br = r / I_BR; r -= br * I_BR; const int kb = r / 32, nb = r % 32;
                    d.W = args.in[7] + (size_t)(l * 2 + br) * CC * D; d.ldw = D; d.k0 = kb * 64; d.n0 = nb * 32; d.dst = ws + WS_WBR + (((size_t)(l * 2 + br) * D + nb * 32) * CC + kb * 64) * 2; d.Kd = CC; d.gain = nullptr; d.kind = 0; return d; }
                r -= 2 * I_BR;
                { const int kb = r / 32, nb = r % 32; d.W = args.in[8] + (size_t)l * D * D; d.ldw = D; d.k0 = kb * 64; d.n0 = nb * 32; d.dst = ws + WS_WOUT + (((size_t)l * D + nb * 32) * D + kb * 64) * 2; d.Kd = D; d.gain = nullptr; d.kind = 0; return d; }
            }
            r -= 2 * I_LAYER;
            if (r < I_FFN) {
                if (r < 2 * I_FGU) { const int up = r / I_FGU; r -= up * I_FGU; const int kb = r / 88, nb = r % 88, n0 = nb * 32, drow = (n0 >> 7) * 256 + up * 128 + (n0 & 127);
                    d.W = args.in[10 + up]; d.ldw = DFF; d.k0 = kb * 64; d.n0 = n0; d.dst = ws + WS_WFGU + ((size_t)drow * D + kb * 64) * 2; d.Kd = D; d.gain = args.in[9]; d.kind = 1; return d; }
                r -= 2 * I_FGU;
                { const int kb = r / 32, nb = r % 32; d.W = args.in[12]; d.ldw = D; d.k0 = kb * 64; d.n0 = nb * 32; d.dst = ws + WS_WFD + ((size_t)(nb * 32) * DFF + kb * 64) * 2; d.Kd = DFF; d.gain = nullptr; d.kind = 0; return d; }
            }
            r -= I_FFN;
            { const int e = r / I_EXP; r -= e * I_EXP;
                if (r < 2 * I_MGU) { const int up = r / I_MGU; r -= up * I_MGU; const int kb = r / 112, nb = r % 112, n0 = nb * 32, drow = (n0 >> 7) * 256 + up * 128 + (n0 & 127);
                    d.W = args.in[14 + up] + (size_t)e * D * DFE; d.ldw = DFE; d.k0 = kb * 64; d.n0 = n0; d.dst = ws + WS_WMGU + ((size_t)e * 2 * DFE + drow) * D + kb * 64; d.Kd = D; d.gain = nullptr; d.kind = 2; return d; }
                r -= 2 * I_MGU;
                { const int kb = r / 32, nb = r % 32; d.W = args.in[16] + (size_t)e * DFE * D; d.ldw = D; d.k0 = kb * 64; d.n0 = nb * 32; d.dst = ws + WS_WMD + ((size_t)e * D + nb * 32) * DFE + kb * 64; d.Kd = DFE; d.gain = nullptr; d.kind = 2; return d; } }
        };
        if (gw < NITEMS) {
            int it = gw; CvtD d = decode(it); float r[32]; cvt_load(d, lane, r);
            for (;;) {
                const int nx = it + NGW;
                if (nx < NITEMS) { const CvtD dn = decode(nx); float rn[32]; cvt_load(dn, lane, rn); cvt_finish(d, r, scr, lane); d = dn;
#pragma unroll
                    for (int i = 0; i < 32; ++i) r[i] = rn[i];
                    it = nx; }
                else { cvt_finish(d, r, scr, lane); break; }
            }
        }
        for (int i = bx * 512 + tid; i < 2 * RANK * D; i += G * 512) { const int l = i / (RANK * D), n = (i / D) % RANK, k = i % D; ((bf16*)(ws + WS_WA))[i] = (bf16)f2bf(args.in[2][(size_t)l * D * IN_COLS + (size_t)k * IN_COLS + 3072 + n] * args.in[1][l * D + k]); }
        for (int i = bx * 512 + tid; i < 2 * KW * RANK; i += G * 512) { const int l = i / (KW * RANK), j = (i / RANK) % KW, r = i % RANK; ((bf16*)(ws + WS_WA2))[i] = (bf16)f2bf(args.in[3][(size_t)l * RANK * KW + r * KW + j]); }
        xb_rows(args.in[0], (bf16*)(ws + WS_HB), (float*)(ws + WS_SSQ), gw, ngw);
        __syncthreads();
        SEAM(PH_CVT);
    }
    for (int l = 0; l < 2; ++l) {
        const int pb = l * PH_LAYER;
        bf16* p = (bf16*)(ws + WS_P); bf16* hb = (bf16*)(ws + WS_HB); bf16* merged = (bf16*)(ws + WS_U);
        if (IN(pb + PH_G1)) {
            SchedGrid S{(const char*)hb, (const char*)((bf16*)(ws + WS_WIN) + (size_t)l * PLD * D), (size_t)256 * D * 2, (size_t)256 * D * 2, M / 256, PLD / 256, G, bx};
            fill_rstd((LAS float*)(lds + RSTD_OFF), S, (const float*)(ws + WS_SSQ));
            for (int rep_ = 0; rep_ < NREP(pb + PH_G1); ++rep_) pg8::gemm_phase<EBf16T<true>, SchedGrid, true, true>(lds, D, D, D, S, EBf16T<true>{p, PLD, 1.0f, (const LAS float*)(lds + RSTD_OFF)});
            SEAM(pb + PH_G1);
        }
        if (IN(pb + PH_GLA1)) {
            for (int rep_ = 0; rep_ < NREP(pb + PH_GLA1); ++rep_)
            for (int item = bx; item < M / 64; item += G) {
                gla_pass1(lds, hb, (const float*)(ws + WS_SSQ), p, (const bf16*)(ws + WS_WA) + (size_t)l * RANK * D, (const bf16*)(ws + WS_WA2) + (size_t)l * KW * RANK, args.in[4] + l * KW, (float*)(ws + WS_BG), (float*)(ws + WS_U), (float*)(ws + WS_DL), item);
                __syncthreads();
            }
            SEAM(pb + PH_GLA1);
        }
        if (IN(pb + PH_SCAN)) { for (int rep_ = 0; rep_ < NREP(pb + PH_SCAN); ++rep_) gla_scan((const float*)(ws + WS_U), (const float*)(ws + WS_DL), (bf16*)(ws + WS_SP), bx, G * 512); SEAM(pb + PH_SCAN); }
        if (IN(pb + PH_GLA3)) {
            for (int rep_ = 0; rep_ < NREP(pb + PH_GLA3); ++rep_)
            for (int item = bx; item < M / 64; item += G) { const bool lastrep = rep_ == NREP(pb + PH_GLA3) - 1;
                if (lastrep) conv_item(p, args.in[5] + l * 3 * CC, item);
                gla_pass3(lds, p, (const float*)(ws + WS_BG), (const bf16*)(ws + WS_SP), args.in[6] + l * DV, item, lastrep ? p + P_GO : (bf16*)(ws + WS_ACTP), lastrep ? PLD : VW); __syncthreads(); }
            SEAM(pb + PH_GLA3);
        }
        if (IN(pb + PH_G2)) {
            const bf16* wb = (const bf16*)(ws + WS_WBR) + (size_t)l * 2 * D * CC;
            SchedPair S{(const char*)(p + P_GB), (const char*)(p + P_GO), (const char*)wb, (const char*)(wb + (size_t)D * CC), (size_t)256 * PLD * 2, (size_t)256 * CC * 2, M / 256, D / 256, G, bx};
            for (int rep_ = 0; rep_ < NREP(pb + PH_G2); ++rep_) pg8::gemm_phase<EMerge, SchedPair, true, true>(lds, CC, PLD, CC, S, EMerge{merged, p});
            SEAM(pb + PH_G2);
        }
        if (IN(pb + PH_G3)) {
            SchedGrid S{(const char*)merged, (const char*)((bf16*)(ws + WS_WOUT) + (size_t)l * D * D), (size_t)256 * D * 2, (size_t)256 * D * 2, M / 256, D / 256, G, bx};
            if (l == 0) { for (int rep_ = 0; rep_ < NREP(pb + PH_G3); ++rep_) pg8::gemm_phase<ERes, SchedGrid, true, true>(lds, D, D, D, S, ERes{hb, (float*)(ws + WS_SSQ), (LAS float*)(lds + PSTAT_OFF)}); }
            else pg8::gemm_phase<EResT<false>, SchedGrid, true, true>(lds, D, D, D, S, EResT<false>{hb, nullptr, nullptr});
            SEAM(pb + PH_G3);
        }
        if (l == 0) {
            bf16* act = (bf16*)(ws + WS_P);
            if (IN(PH_UP)) {
                SchedGrid S{(const char*)hb, (const char*)(ws + WS_WFGU), (size_t)256 * D * 2, (size_t)256 * D * 2, M / 256, 2 * DFF / 256, G, bx};
                fill_rstd((LAS float*)(lds + RSTD_OFF), S, (const float*)(ws + WS_SSQ));
                for (int rep_ = 0; rep_ < NREP(PH_UP); ++rep_) pg8::gemm_phase<ESwiglu, SchedGrid, true, true>(lds, D, D, D, S, ESwiglu{act, DFF, (const LAS float*)(lds + RSTD_OFF)});
                SEAM(PH_UP);
            }
            if (IN(PH_DOWN)) {
                SchedGrid S{(const char*)act, (const char*)(ws + WS_WFD), (size_t)256 * DFF * 2, (size_t)256 * DFF * 2, M / 256, D / 256, G, bx};
                pg8::gemm_phase<ERes, SchedGrid, true, true>(lds, DFF, DFF, DFF, S, ERes{hb, (float*)(ws + WS_SSQ), (LAS float*)(lds + PSTAT_OFF)});
                SEAM(PH_DOWN);
            }
        } else {
            int* tilet = (int*)(ws + WS_TILE); unsigned char* hbp = ws + WS_HBP; unsigned char* actp = ws + WS_ACTP; bf16* obuf = (bf16*)(ws + WS_OBUF);
            int* counts = (int*)(ws + WS_CNT); int* tok_e = (int*)(ws + WS_TOKE); float* tok_w = (float*)(ws + WS_TOKW); int* slot = (int*)(ws + WS_SLOT); float* rstd = (float*)(ws + WS_RSTD);
            if (IN(PH_ROUTE1)) { route1_stage((LAS float*)lds, args.in[9] + D, args.in[13]);
                for (int rep_ = 0; rep_ < NREP(PH_ROUTE1); ++rep_) for (int grp = bx; grp < M / 64; grp += G) route1_grp((const LAS float*)lds, (LAS int*)(lds + 32768), hb, rstd, tok_e, tok_w, counts, grp); SEAM(PH_ROUTE1); }
            if (IN(PH_ROUTE2)) { for (int rep_ = 0; rep_ < NREP(PH_ROUTE2); ++rep_) for (int grp = bx; grp < M / 64; grp += G) route2_grp((LAS int*)lds, hb, args.in[9] + D, rstd, counts, tok_e, slot, hbp, tilet, grp, bx, G); SEAM(PH_ROUTE2); }
            {
                int nT = 0; if (IN(PH_MUPA) || IN(PH_MDOWNA)) nT = tilet[NTILE_MAX];
                const int nFull = nT < 128 ? nT : 128, nL = nT > 128 ? nT - 128 : 0;
                if (IN(PH_MUPA)) {
                    SchedMoe S{(const char*)hbp, (const char*)(ws + WS_WMGU), tilet, (size_t)256 * D, (size_t)256 * D, (size_t)2 * DFE * D, 0, nT, 2 * DFE / 256, G, bx};
                    for (int rep_ = 0; rep_ < NREP(PH_MUPA); ++rep_) pg8::gemm_phase<ESwiglu8, SchedMoe, true, true, true>(lds, D / 2, D / 2, D / 2, S, ESwiglu8{actp, DFE, W8_INV});
                    SEAM(PH_MUPA);
                }
                if (IN(PH_MDOWNA)) {
                    SchedMoe S{(const char*)actp, (const char*)(ws + WS_WMD), tilet, (size_t)256 * DFE, (size_t)256 * DFE, (size_t)D * DFE, 0, nFull, D / 256, G, bx};
                    for (int rep_ = 0; rep_ < NREP(PH_MDOWNA); ++rep_) pg8::gemm_phase<EBf16, SchedMoe, true, true, true>(lds, DFE / 2, DFE / 2, DFE / 2, S, EBf16{obuf, D, W8_INV, nullptr});
                    SchedMoeK SK{(const char*)actp, (const char*)(ws + WS_WMD), tilet, nL, G, bx};
                    pg8::gemm_phase<ESlab, SchedMoeK, true, true, true>(lds, KSLICE / 2, DFE / 2, DFE / 2, SK, ESlab{(float*)(ws + WS_OBX), W8_INV});
                    SEAM(PH_MDOWNA);
                }
            }
            if (IN(PH_COMBINE)) combine_rows(hb, obuf, (const float*)(ws + WS_OBX), slot, tok_w, args.in[17], args.out, gw, ngw);
        }
    }
#undef IN
}

extern "C" void kernel_launch(void* const* d_in, const int* in_sizes, int n_in, void* d_out, int out_size, void* d_ws, size_t ws_size, hipStream_t stream) {
    (void)in_sizes;
    if (n_in != 18 || out_size != M * D || ws_size < WS_END) { fprintf(stderr, "kernel_launch: unexpected arguments (n_in %d out %d ws %zu)\n", n_in, out_size, ws_size); return; }
    static int grid = 0;
    if (grid == 0) {
        int dev = 0, cus = 0;
        if (hipGetDevice(&dev) != hipSuccess || hipDeviceGetAttribute(&cus, hipDeviceAttributeMultiprocessorCount, dev) != hipSuccess) { fprintf(stderr, "kernel_launch: device query failed\n"); grid = -1; return; }
        if (hipFuncSetAttribute((const void*)mega, hipFuncAttributeMaxDynamicSharedMemorySize, LDS_BYTES) != hipSuccess) { fprintf(stderr, "kernel_launch: hipFuncSetAttribute failed\n"); grid = -1; return; }
        grid = cus;
    }
    if (grid < 0) return;
    Args a{};
    for (int i = 0; i < 18; ++i) a.in[i] = (const float*)d_in[i];
    a.out = (float*)d_out; a.ws = (unsigned char*)d_ws;
#define MEGA(lo_, hi_) do { a.ph_lo = (lo_); a.ph_hi = (hi_); hipLaunchKernelGGL(mega, dim3(grid), dim3(512), LDS_BYTES, stream, a); } while (0)
    if (hipMemsetAsync(d_ws, 0, 65536, stream) != hipSuccess) { fprintf(stderr, "kernel_launch: memset failed\n"); return; }
#if MK_SPLIT
    { const int ph[] = {0, 1, 2, 3, 4, 5, 6, 7, 8, 9, 10, 17, 18, 19, 20, 21, 22, 23, 24, 25, 26, 27, 28, 29}; for (int i = 0; i < 24; ++i) MEGA(ph[i], ph[i] + 1); }
#else
    MEGA(0, PH_END);
#endif
}
```

```cpp
#include <hip/hip_runtime.h>
#include <cstdio>
#include <cstdint>
#include <cstddef>
#ifndef MK_SPLIT
#define MK_SPLIT 0
#endif
#ifndef DUP_PH
#define DUP_PH -1
#endif
#define NREP(k) (((k) == (DUP_PH)) ? 2 : 1)

typedef unsigned short bf16;
#define DEV __device__ __forceinline__

constexpr int D = 1024, BATCH = 8, SEQ = 2048, M = BATCH * SEQ;
constexpr int CC = 512, KW = 256, VW = 512, RANK = 16, NH = 4, DK = 64, DV = 128;
constexpr int IN_COLS = 5136, PLD = 5120;
constexpr int P_XC = 0, P_GB = 512, P_GC = 1024, P_Q = 1536, P_K = 1792, P_V = 2048, P_GO = 2560, P_GA = 3072, P_GBB = 4096;
constexpr int DFF = 2816, NE = 8, DFE = 3584;
constexpr float EPS = 1e-6f;
constexpr int PERM_ROWS = 2 * M + NE * 256;
constexpr int NTILE_MAX = PERM_ROWS / 256;
constexpr int CHUNK_TILES = 64;
constexpr int KSPLIT = 7, KSLICE = DFE / KSPLIT;

constexpr size_t MiB = 1ull << 20;
constexpr size_t WS_CNT = 1 * MiB;
constexpr size_t WS_TILE = 1 * MiB + 16384;
constexpr size_t WS_TOKE = 1 * MiB + 65536;
constexpr size_t WS_TOKW = WS_TOKE + 131072;
constexpr size_t WS_SLOT = WS_TOKW + 131072;
constexpr size_t WS_RSTD = WS_SLOT + 131072;
constexpr size_t WS_ALOW = 3 * MiB;
constexpr size_t WS_LOGA = 4 * MiB;
constexpr size_t WS_HB = 234 * MiB;
constexpr size_t WS_P = 266 * MiB;
constexpr size_t WS_U = 426 * MiB;
constexpr size_t WS_ACTP = 266 * MiB;
constexpr size_t WS_HBP = 385 * MiB;
constexpr size_t WS_OBUF = 419 * MiB;
constexpr size_t WS_OBX = 4 * MiB;
constexpr size_t WS_END = 489 * MiB;

DEV float bf2f(unsigned v) { return __uint_as_float(v << 16); }
DEV unsigned f2bf(float f) { unsigned u = __float_as_uint(f); return (u + 0x7fffu + ((u >> 16) & 1u)) >> 16; }
DEV unsigned pk2(float lo, float hi) { return f2bf(lo) | (f2bf(hi) << 16); }
DEV float wave_sum(float v) {
#pragma unroll
    for (int o = 1; o < 64; o <<= 1) v += __shfl_xor(v, o);
    return v;
}

DEV float row_rstd(const float* ssq, int row) { return rsqrtf(((ssq[row] + ssq[M + row]) + (ssq[2 * M + row] + ssq[3 * M + row])) * (1.0f / D) + EPS); }
#define LAS __attribute__((address_space(3)))
typedef short bf16x8 __attribute__((ext_vector_type(8)));
typedef float f32x4 __attribute__((ext_vector_type(4)));
typedef float f32x2 __attribute__((ext_vector_type(2)));
typedef unsigned u32x4 __attribute__((ext_vector_type(4)));
typedef unsigned u32x2 __attribute__((ext_vector_type(2)));
DEV unsigned cvt_pk_bf16(float lo, float hi) { unsigned r; asm volatile("v_cvt_pk_bf16_f32 %0, %1, %2" : "=v"(r) : "v"(lo), "v"(hi)); return r; }
DEV float fsig(float x) { return __builtin_amdgcn_rcpf(1.0f + __builtin_amdgcn_exp2f(-1.44269504f * x)); }
DEV float blo(unsigned w) { return __uint_as_float(w << 16); }
DEV float bhi(unsigned w) { return __uint_as_float(w & 0xffff0000u); }

typedef int i32x4 __attribute__((ext_vector_type(4)));
typedef int i32x8 __attribute__((ext_vector_type(8)));
DEV i32x8 cat8(bf16x8 lo, bf16x8 hi) { return __builtin_shufflevector(__builtin_bit_cast(i32x4, lo), __builtin_bit_cast(i32x4, hi), 0, 1, 2, 3, 4, 5, 6, 7); }
DEV unsigned pk4_fp8(float a, float b, float c, float d) { int w = 0; w = __builtin_amdgcn_cvt_pk_fp8_f32(a, b, w, false); w = __builtin_amdgcn_cvt_pk_fp8_f32(c, d, w, true); return (unsigned)w; }
constexpr float W8_SCALE = 64.0f, W8_INV = 1.0f / 64.0f;
namespace pg8 {
constexpr int BM = 256, BK = 64, HALF = 128, HTB = HALF * BK * 2, STAGE_BYTES = 8 * HTB, NXCD = 8, WGM = 8;
__host__ __device__ __forceinline__ int lds_byte(int r, int c) { const int st = (r >> 4) * 2 + (c >> 5), rr = r & 15, cc = c & 31, ob = rr * 64 + cc * 2; return st * 1024 + (ob ^ (((ob >> 9) & 1) << 5)); }
__host__ __device__ __forceinline__ void stage_rc(int b, int& R, int& C) { const int st = b / 1024, sb = b % 1024, swz = sb ^ (((sb >> 9) & 1) << 5); R = (st >> 1) * 16 + swz / 64; C = (st & 1) * 32 + (swz % 64) / 2; }
__host__ __device__ __forceinline__ int perm32(int rho) { const int n = rho >> 4, i = rho & 15; return 8 * (i >> 2) + 4 * n + (i & 3); }

struct Unit { const char* A; const char* B; int pm, pn, aux; };
DEV bool tile_of(int L, int nM, int nN, int& pm, int& pn) {
    const int nwg = nM * nN; if (L >= nwg) return false;
    int wgid = L; { const int q = nwg / NXCD, r = nwg % NXCD, xcd = wgid % NXCD, off = wgid / NXCD; wgid = (xcd < r ? xcd * (q + 1) : r * (q + 1) + (xcd - r) * q) + off; }
    const int nig = WGM * nN, gid = wgid / nig, fm = gid * WGM, gsz = (nM - fm) < WGM ? (nM - fm) : WGM;
    pm = fm + ((wgid % nig) % gsz); pn = (wgid % nig) / gsz; return true;
}

template <class Epi, class Sched, bool ALIGN_EPI, bool SP2, bool FP8 = false>
DEV void gemm_phase(LAS unsigned char* lds, const int K, const int lda, const int ldb, const Sched& S, const Epi& E) {
    int tid_ = threadIdx.x; asm volatile("" : "+v"(tid_));
    const int tid = tid_, wid = __builtin_amdgcn_readfirstlane(tid >> 6), lane = tid & 63, wr = wid >> 2, wc = wid & 3, fr = lane & 15, fq = lane >> 4;
    const int nt = K / BK;
    unsigned voffA[2], voffB[2];
#pragma unroll
    for (int i = 0; i < 2; ++i) { int R, C; stage_rc(tid * 16 + i * 8192, R, C); const int Rb = Epi::PERM ? ((R & ~31) + perm32(R & 31)) : R;
        voffA[i] = (unsigned)(R * lda + C) * 2u; voffB[i] = (unsigned)(Rb * ldb + C) * 2u; }
    const size_t kstep = (size_t)(BK * 2);
    const size_t hstepA = (size_t)HALF * lda * 2, hstepB = (size_t)HALF * ldb * 2;
    const unsigned ldsw = (unsigned)wid * 1024u;
    const int aoff = FP8 ? lds_byte(wr * 64 + fr, fq * 16) : lds_byte(wr * 64 + fr, fq * 8), boff = FP8 ? lds_byte(wc * 32 + fr, fq * 16) : lds_byte(wc * 32 + fr, fq * 8);

#define PG8_SA(b, h) (((b) * 2 + (h)) * HTB)
#define PG8_SB(b, h) ((4 + (b) * 2 + (h)) * HTB)
#define PG8_STAGE(bufoff, gbase, voff) do { _Pragma("unroll") for (int _i = 0; _i < 2; ++_i) \
        __builtin_amdgcn_global_load_lds((const unsigned*)((const char*)(gbase) + (voff)[_i]), (LAS unsigned*)(lds + (bufoff) + ldsw + _i * 8192), 16, 0, 0); } while (0)
#define PG8_RD(off) (*(const LAS bf16x8*)(lds + (off)))
#define PG8_LDA(dst, b, h) do { if constexpr (FP8) { _Pragma("unroll") for (int m = 0; m < 4; ++m) dst##8[m] = cat8(PG8_RD(PG8_SA(b, h) + aoff + m * 2048), PG8_RD(PG8_SA(b, h) + aoff + m * 2048 + 16)); } \
        else { _Pragma("unroll") for (int m = 0; m < 4; ++m) _Pragma("unroll") for (int k = 0; k < 2; ++k) dst[m][k] = PG8_RD(PG8_SA(b, h) + aoff + m * 2048 + k * 1024); } } while (0)
#define PG8_LDB(dst, b, h) do { if constexpr (FP8) { _Pragma("unroll") for (int n = 0; n < 2; ++n) dst##8[n] = cat8(PG8_RD(PG8_SB(b, h) + boff + n * 2048), PG8_RD(PG8_SB(b, h) + boff + n * 2048 + 16)); } \
        else { _Pragma("unroll") for (int n = 0; n < 2; ++n) _Pragma("unroll") for (int k = 0; k < 2; ++k) dst[n][k] = PG8_RD(PG8_SB(b, h) + boff + n * 2048 + k * 1024); } } while (0)
#define PG8_MMA(ai, bj, At, Bt) do { __builtin_amdgcn_s_setprio(3); _Pragma("unroll") for (int m = 0; m < 4; ++m) _Pragma("unroll") for (int n = 0; n < 2; ++n) { \
        if constexpr (FP8) asm volatile("v_mfma_scale_f32_16x16x128_f8f6f4 %0, %1, %2, %0, %3, %3 op_sel_hi:[0,0,0]" : "+v"(acc[ai][bj][m][n]) : "v"(Bt##8[n]), "v"(At##8[m]), "v"(one8)); \
        else { _Pragma("unroll") for (int k = 0; k < 2; ++k) acc[ai][bj][m][n] = __builtin_amdgcn_mfma_f32_16x16x32_bf16(Bt[n][k], At[m][k], acc[ai][bj][m][n], 0, 0, 0); } } __builtin_amdgcn_s_setprio(0); } while (0)
#define PG8_WAIT_V(n) asm volatile("s_waitcnt vmcnt(" #n ")" ::: "memory")
#define PG8_WAIT_L(n) asm volatile("s_waitcnt lgkmcnt(" #n ")" ::: "memory")
#define PG8_BAR __builtin_amdgcn_s_barrier()
#define PG8_SCHED __builtin_amdgcn_sched_barrier(0)
    Unit cur, nxt; int ui = 0;
    if (!S.next(0, cur)) return;
    f32x4 acc[2][2][4][2];
#pragma unroll
    for (int a = 0; a < 2; ++a)
#pragma unroll
        for (int b = 0; b < 2; ++b)
#pragma unroll
            for (int m = 0; m < 4; ++m)
#pragma unroll
                for (int n = 0; n < 2; ++n) acc[a][b][m][n] = (f32x4){0.f, 0.f, 0.f, 0.f};
    const int one8 = 0x7F7F7F7F;
    bf16x8 At[4][2], B0[2][2], B1[2][2]; i32x8 At8[4], B08[2], B18[2];
    const char* cA = cur.A; const char* cB = cur.B;
    if constexpr (SP2) {
        PG8_STAGE(PG8_SB(0, 0), cB, voffB); PG8_STAGE(PG8_SB(0, 1), cB + hstepB, voffB); PG8_STAGE(PG8_SA(0, 0), cA, voffA); PG8_STAGE(PG8_SA(0, 1), cA + hstepA, voffA);
        if (wr == 1) PG8_BAR;
        PG8_WAIT_V(2); PG8_BAR;
        PG8_STAGE(PG8_SB(1, 0), cB + kstep, voffB); PG8_STAGE(PG8_SA(1, 0), cA + kstep, voffA); PG8_STAGE(PG8_SB(1, 1), cB + hstepB + kstep, voffB);
        PG8_WAIT_V(6); PG8_BAR;
    } else {
        PG8_STAGE(PG8_SB(0, 0), cB, voffB); PG8_STAGE(PG8_SA(0, 0), cA, voffA); PG8_STAGE(PG8_SB(0, 1), cB + hstepB, voffB); PG8_STAGE(PG8_SA(0, 1), cA + hstepA, voffA);
        if (wr == 1) PG8_BAR;
        PG8_WAIT_V(4); PG8_BAR;
        PG8_STAGE(PG8_SB(1, 0), cB + kstep, voffB); PG8_STAGE(PG8_SA(1, 0), cA + kstep, voffA); PG8_STAGE(PG8_SB(1, 1), cB + hstepB + kstep, voffB);
        PG8_WAIT_V(6); PG8_BAR;
    }
    for (;;) {
        const bool has_next = S.next(ui + 1, nxt);
        const char* nA = has_next ? nxt.A : cA; const char* nB = has_next ? nxt.B : cB;
#pragma nounroll
        for (int t = 0; t < nt; t += 2) {
            const bool last = (t == nt - 2);
            const char* a1 = cA + (size_t)(t + 1) * kstep;
            const char* a2 = last ? nA : cA + (size_t)(t + 2) * kstep; const char* b2 = last ? nB : cB + (size_t)(t + 2) * kstep;
            const char* a3 = a2 + kstep; const char* b3 = b2 + kstep;
            if constexpr (SP2) {
            PG8_LDB(B0, 0, 0); PG8_LDB(B1, 0, 1); PG8_SCHED; PG8_LDA(At, 0, 0); PG8_STAGE(PG8_SA(1, 1), a1 + hstepA, voffA);
            PG8_WAIT_V(8); PG8_WAIT_L(0); PG8_BAR; PG8_MMA(0, 0, At, B0); PG8_MMA(0, 1, At, B1); PG8_BAR; PG8_SCHED;
            PG8_LDA(At, 0, 1); PG8_STAGE(PG8_SB(0, 0), b2, voffB); PG8_STAGE(PG8_SB(0, 1), b2 + hstepB, voffB); PG8_STAGE(PG8_SA(0, 0), a2, voffA);
            PG8_WAIT_V(8); PG8_WAIT_L(0); PG8_BAR; PG8_MMA(1, 0, At, B0); PG8_MMA(1, 1, At, B1); PG8_BAR; PG8_SCHED;
            PG8_LDB(B0, 1, 0); PG8_LDB(B1, 1, 1); PG8_SCHED; PG8_LDA(At, 1, 0); PG8_STAGE(PG8_SA(0, 1), a2 + hstepA, voffA);
            PG8_WAIT_V(8); PG8_WAIT_L(0); PG8_BAR; PG8_MMA(0, 0, At, B0); PG8_MMA(0, 1, At, B1); PG8_BAR; PG8_SCHED;
            PG8_LDA(At, 1, 1); PG8_STAGE(PG8_SB(1, 0), b3, voffB); PG8_STAGE(PG8_SB(1, 1), b3 + hstepB, voffB); PG8_STAGE(PG8_SA(1, 0), a3, voffA);
            PG8_WAIT_V(8); PG8_WAIT_L(0); PG8_BAR; PG8_MMA(1, 0, At, B0); PG8_MMA(1, 1, At, B1); PG8_BAR; PG8_SCHED;
            } else {
            PG8_LDB(B0, 0, 0); PG8_SCHED; PG8_LDA(At, 0, 0); PG8_STAGE(PG8_SA(1, 1), a1 + hstepA, voffA);
            PG8_WAIT_L(8); PG8_BAR; PG8_WAIT_L(0); PG8_MMA(0, 0, At, B0); PG8_BAR; PG8_SCHED;
            PG8_LDB(B1, 0, 1); PG8_STAGE(PG8_SB(0, 0), b2, voffB);
            PG8_BAR; PG8_WAIT_L(0); PG8_MMA(0, 1, At, B1); PG8_BAR;
            PG8_LDA(At, 0, 1); PG8_STAGE(PG8_SA(0, 0), a2, voffA);
            PG8_BAR; PG8_WAIT_L(0); PG8_MMA(1, 0, At, B0); PG8_BAR; PG8_SCHED;
            PG8_STAGE(PG8_SB(0, 1), b2 + hstepB, voffB);
            PG8_WAIT_V(6); PG8_BAR; PG8_MMA(1, 1, At, B1); PG8_BAR;
            PG8_LDB(B0, 1, 0); PG8_SCHED; PG8_LDA(At, 1, 0); PG8_STAGE(PG8_SA(0, 1), a2 + hstepA, voffA);
            PG8_WAIT_L(8); PG8_BAR; PG8_WAIT_L(0); PG8_MMA(0, 0, At, B0); PG8_BAR; PG8_SCHED;
            PG8_LDB(B1, 1, 1); PG8_STAGE(PG8_SB(1, 0), b3, voffB);
            PG8_BAR; PG8_WAIT_L(0); PG8_MMA(0, 1, At, B1); PG8_BAR;
            PG8_LDA(At, 1, 1); PG8_STAGE(PG8_SA(1, 0), a3, voffA);
            PG8_BAR; PG8_WAIT_L(0); PG8_MMA(1, 0, At, B0); PG8_BAR; PG8_SCHED;
            PG8_STAGE(PG8_SB(1, 1), b3 + hstepB, voffB);
            PG8_WAIT_V(6); PG8_BAR; PG8_MMA(1, 1, At, B1); PG8_BAR;
            }
        }
        if constexpr (ALIGN_EPI) { if (wr == 0) PG8_BAR; }
        if constexpr (FP8) asm volatile("s_nop 15\n\ts_nop 15" ::: "memory");
        E(acc, cur, wr, wc, fr, fq);
        if (!has_next) break;
#pragma unroll
        for (int a = 0; a < 2; ++a)
#pragma unroll
            for (int b = 0; b < 2; ++b)
#pragma unroll
                for (int m = 0; m < 4; ++m)
#pragma unroll
                    for (int n = 0; n < 2; ++n) acc[a][b][m][n] = (f32x4){0.f, 0.f, 0.f, 0.f};
        cur = nxt; cA = nA; cB = nB; ++ui;
        if constexpr (ALIGN_EPI) { if (wr == 1) PG8_BAR; }
    }
    PG8_WAIT_V(0);
    if constexpr (!ALIGN_EPI) { if (wr == 0) PG8_BAR; }
    PG8_BAR;
#undef PG8_SA
#undef PG8_SB
#undef PG8_STAGE
#undef PG8_LDA
#undef PG8_RD
#undef PG8_LDB
#undef PG8_MMA
#undef PG8_WAIT_V
#undef PG8_WAIT_L
#undef PG8_BAR
#undef PG8_SCHED
}
}
using pg8::Unit;

struct SchedGrid { const char* A; const char* B; size_t astep, bstep; int nM, nN, G, c;
    DEV bool next(int i, Unit& u) const { int pm, pn; if (!pg8::tile_of(i * G + c, nM, nN, pm, pn)) return false; u.A = A + (size_t)pm * astep; u.B = B + (size_t)pn * bstep; u.pm = pm; u.pn = pn; u.aux = i; return true; } };
struct SchedPair { const char* A0; const char* A1; const char* B0; const char* B1; size_t astep, bstep; int nM, nN, G, c;
    DEV bool next(int i, Unit& u) const { int pm, pn; if (!pg8::tile_of((i >> 1) * G + c, nM, nN, pm, pn)) return false; const int br = i & 1; u.A = (br ? A1 : A0) + (size_t)pm * astep; u.B = (br ? B1 : B0) + (size_t)pn * bstep; u.pm = pm; u.pn = pn; u.aux = br; return true; } };
struct SchedMoe { const char* A; const char* B; const int* tile_e; size_t astep, bstep, estep; int t0, nM, nN, G, c;
    DEV bool next(int i, Unit& u) const { int pm, pn; if (!pg8::tile_of(i * G + c, nM, nN, pm, pn)) return false; const int e = tile_e[t0 + pm]; u.A = A + (size_t)pm * astep; u.B = B + (size_t)e * estep + (size_t)pn * bstep; u.pm = pm; u.pn = pn; u.aux = e; return true; } };

struct SchedMoeK { const char* A; const char* B; const int* tile_e; int nL, G, c;
    DEV bool next(int i, Unit& u) const { const int L = i * G + c; if (L >= nL * 4 * KSPLIT) return false; const int ks = L % KSPLIT, pn = (L / KSPLIT) & 3, lt = L / (4 * KSPLIT); const int e = tile_e[128 + lt];
        u.A = A + ((size_t)(128 + lt) * 256 * DFE + (size_t)ks * KSLICE); u.B = B + ((size_t)e * D * DFE + (size_t)pn * 256 * DFE + (size_t)ks * KSLICE);     u.pm = lt; u.pn = pn; u.aux = ks; return true; } };
template <class Sched> DEV void fill_rstd(LAS float* R, const Sched& S, const float* ssq) {
    int t = threadIdx.x; asm volatile("" : "+v"(t)); Unit u;
    for (int i = 0; i < 8 && S.next(i, u); ++i) if (t < 256) R[i * 256 + t] = row_rstd(ssq, u.pm * 256 + t);
    __syncthreads();
}
typedef const f32x4 (&AccRef)[2][2][4][2];
template <bool RS> struct EBf16T { static constexpr bool PERM = true; bf16* O; int ldc; float sc; const LAS float* R;
    DEV void operator()(AccRef acc, const Unit& u, int wr, int wc, int fr, int fq) const {
        const int row0 = u.pm * 256 + wr * 64 + fr, col0 = u.pn * 256 + wc * 32 + 8 * fq;
        float rsv[2][4];
#pragma unroll
        for (int ai = 0; ai < 2; ++ai)
#pragma unroll
            for (int m = 0; m < 4; ++m) rsv[ai][m] = RS ? sc * R[u.aux * 256 + ai * 128 + wr * 64 + m * 16 + fr] : sc;
#pragma unroll
        for (int ai = 0; ai < 2; ++ai)
#pragma unroll
            for (int m = 0; m < 4; ++m) { const int row = row0 + ai * 128 + m * 16; bf16* rowp = O + (size_t)row * ldc + col0; const float rs = rsv[ai][m];
#pragma unroll
                for (int bj = 0; bj < 2; ++bj) { const f32x4 v0 = acc[ai][bj][m][0] * rs, v1 = acc[ai][bj][m][1] * rs; u32x4 w; w.x = cvt_pk_bf16(v0[0], v0[1]); w.y = cvt_pk_bf16(v0[2], v0[3]); w.z = cvt_pk_bf16(v1[0], v1[1]); w.w = cvt_pk_bf16(v1[2], v1[3]);
                    *(u32x4*)(rowp + bj * 128) = w; } }
    } };
typedef EBf16T<false> EBf16;
struct EMerge { static constexpr bool PERM = true; bf16* mg; const bf16* p;
    DEV void operator()(AccRef acc, const Unit& u, int wr, int wc, int fr, int fq) const {
        const int row0 = u.pm * 256 + wr * 64 + fr, col0 = u.pn * 256 + wc * 32 + 8 * fq; const int gofs = u.aux ? P_GBB : P_GA;
#pragma unroll
        for (int ai = 0; ai < 2; ++ai) {
            u32x4 gt[4][2], od[4][2];
#pragma unroll
            for (int m = 0; m < 4; ++m)
#pragma unroll
                for (int bj = 0; bj < 2; ++bj) { const size_t row = (size_t)(row0 + ai * 128 + m * 16); const int col = col0 + bj * 128;
                    gt[m][bj] = *(const u32x4*)(p + row * PLD + gofs + col); od[m][bj] = u.aux ? *(const u32x4*)(mg + row * D + col) : (u32x4){0u, 0u, 0u, 0u}; }
#pragma unroll
            for (int m = 0; m < 4; ++m)
#pragma unroll
                for (int bj = 0; bj < 2; ++bj) { const size_t row = (size_t)(row0 + ai * 128 + m * 16); const int col = col0 + bj * 128; const u32x4 g = gt[m][bj], o = od[m][bj];
                    const f32x4 v0 = acc[ai][bj][m][0], v1 = acc[ai][bj][m][1];
                    u32x4 w; w.x = cvt_pk_bf16(fsig(blo(g.x)) * v0[0] + blo(o.x), fsig(bhi(g.x)) * v0[1] + bhi(o.x)); w.y = cvt_pk_bf16(fsig(blo(g.y)) * v0[2] + blo(o.y), fsig(bhi(g.y)) * v0[3] + bhi(o.y));
                    w.z = cvt_pk_bf16(fsig(blo(g.z)) * v1[0] + blo(o.z), fsig(bhi(g.z)) * v1[1] + bhi(o.z)); w.w = cvt_pk_bf16(fsig(blo(g.w)) * v1[2] + blo(o.w), fsig(bhi(g.w)) * v1[3] + bhi(o.w));
                    *(u32x4*)(mg + row * D + col) = w; }
        }
    } };
template <bool STATS> struct EResT { static constexpr bool PERM = true; bf16* xb; float* ssq; LAS float* P;
    DEV void operator()(AccRef acc, const Unit& u, int wr, int wc, int fr, int fq) const {
        const int row0 = u.pm * 256 + wr * 64 + fr, col0 = u.pn * 256 + wc * 32 + 8 * fq;
#pragma unroll
        for (int ai = 0; ai < 2; ++ai) {
        u32x4 xo[4][2];
#pragma unroll
            for (int m = 0; m < 4; ++m)
#pragma unroll
                for (int bj = 0; bj < 2; ++bj) xo[m][bj] = *(const u32x4*)(xb + (size_t)(row0 + ai * 128 + m * 16) * D + col0 + bj * 128);
#pragma unroll
            for (int m = 0; m < 4; ++m) { bf16* rowp = xb + (size_t)(row0 + ai * 128 + m * 16) * D + col0; float sq = 0.f;
#pragma unroll
                for (int bj = 0; bj < 2; ++bj) { const u32x4 o = xo[m][bj]; const f32x4 a0 = acc[ai][bj][m][0], a1 = acc[ai][bj][m][1];
                    u32x4 w; w.x = cvt_pk_bf16(blo(o.x) + a0[0], bhi(o.x) + a0[1]); w.y = cvt_pk_bf16(blo(o.y) + a0[2], bhi(o.y) + a0[3]); w.z = cvt_pk_bf16(blo(o.z) + a1[0], bhi(o.z) + a1[1]); w.w = cvt_pk_bf16(blo(o.w) + a1[2], bhi(o.w) + a1[3]);
                    *(u32x4*)(rowp + bj * 128) = w;
                    if (STATS) sq += (blo(w.x) * blo(w.x) + bhi(w.x) * bhi(w.x)) + (blo(w.y) * blo(w.y) + bhi(w.y) * bhi(w.y)) + (blo(w.z) * blo(w.z) + bhi(w.z) * bhi(w.z)) + (blo(w.w) * blo(w.w) + bhi(w.w) * bhi(w.w)); }
                if (STATS) { sq += __shfl_xor(sq, 16); sq += __shfl_xor(sq, 32);
                    if (fq == 0) P[(ai * 128 + wr * 64 + m * 16 + fr) * 4 + wc] = sq; } } }
        if (!STATS) return;
        asm volatile("s_waitcnt lgkmcnt(0)" ::: "memory"); __builtin_amdgcn_s_barrier(); asm volatile("" ::: "memory");
        const int t = wr * 256 + wc * 64 + fq * 16 + fr;
        if (t < 256) ssq[(size_t)u.pn * M + u.pm * 256 + t] = (P[t * 4] + P[t * 4 + 1]) + (P[t * 4 + 2] + P[t * 4 + 3]);
    } };
typedef EResT<true> ERes;
struct ESlab { static constexpr bool PERM = false; float* obx; float sc;
    DEV void operator()(AccRef acc, const Unit& u, int wr, int wc, int fr, int fq) const {
        const int row0 = u.pm * 256 + wr * 64 + fr, col0 = u.pn * 256 + wc * 32 + 4 * fq; float* base = obx + (size_t)u.aux * 2048 * D;
#pragma unroll
        for (int ai = 0; ai < 2; ++ai)
#pragma unroll
            for (int m = 0; m < 4; ++m) { const size_t off = (size_t)(row0 + ai * 128 + m * 16) * D + col0;
#pragma unroll
                for (int bj = 0; bj < 2; ++bj)
#pragma unroll
                    for (int n = 0; n < 2; ++n) *(f32x4*)(base + off + bj * 128 + n * 16) = acc[ai][bj][m][n] * sc; }
    } };
struct ESwiglu8 { static constexpr bool PERM = true; unsigned char* act; int ld; float sc;
    DEV void operator()(AccRef acc, const Unit& u, int wr, int wc, int fr, int fq) const {
        const int row0 = u.pm * 256 + wr * 64 + fr, col0 = u.pn * 128 + wc * 32 + 8 * fq;
#pragma unroll
        for (int ai = 0; ai < 2; ++ai)
#pragma unroll
            for (int m = 0; m < 4; ++m) { const f32x4 g0 = acc[ai][0][m][0] * sc, g1 = acc[ai][0][m][1] * sc, u0 = acc[ai][1][m][0] * sc, u1 = acc[ai][1][m][1] * sc;
                u32x2 w; w.x = pk4_fp8(g0[0] * fsig(g0[0]) * u0[0], g0[1] * fsig(g0[1]) * u0[1], g0[2] * fsig(g0[2]) * u0[2], g0[3] * fsig(g0[3]) * u0[3]);
                w.y = pk4_fp8(g1[0] * fsig(g1[0]) * u1[0], g1[1] * fsig(g1[1]) * u1[1], g1[2] * fsig(g1[2]) * u1[2], g1[3] * fsig(g1[3]) * u1[3]);
                *(u32x2*)(act + (size_t)(row0 + ai * 128 + m * 16) * ld + col0) = w; }
    } };
struct ESwiglu { static constexpr bool PERM = true; bf16* act; int ld; const LAS float* R;
    DEV void operator()(AccRef acc, const Unit& u, int wr, int wc, int fr, int fq) const {
        const int row0 = u.pm * 256 + wr * 64 + fr, col0 = u.pn * 128 + wc * 32 + 8 * fq;
        float rsv[2][4];
#pragma unroll
        for (int ai = 0; ai < 2; ++ai)
#pragma unroll
            for (int m = 0; m < 4; ++m) rsv[ai][m] = R[u.aux * 256 + ai * 128 + wr * 64 + m * 16 + fr];
#pragma unroll
        for (int ai = 0; ai < 2; ++ai)
#pragma unroll
            for (int m = 0; m < 4; ++m) { const float rs = rsv[ai][m]; const f32x4 g0 = acc[ai][0][m][0] * rs, g1 = acc[ai][0][m][1] * rs, u0 = acc[ai][1][m][0] * rs, u1 = acc[ai][1][m][1] * rs;
                u32x4 w; w.x = cvt_pk_bf16(g0[0] * fsig(g0[0]) * u0[0], g0[1] * fsig(g0[1]) * u0[1]); w.y = cvt_pk_bf16(g0[2] * fsig(g0[2]) * u0[2], g0[3] * fsig(g0[3]) * u0[3]);
                w.z = cvt_pk_bf16(g1[0] * fsig(g1[0]) * u1[0], g1[1] * fsig(g1[1]) * u1[1]); w.w = cvt_pk_bf16(g1[2] * fsig(g1[2]) * u1[2], g1[3] * fsig(g1[3]) * u1[3]);
                *(u32x4*)(act + (size_t)(row0 + ai * 128 + m * 16) * ld + col0) = w; }
    } };

#define XB_TMO      128
#define XB_XCNT(j)  (256  + 64 * (j))
#define XB_XSUB(j)  (1280 + 64 * (j))
#define XB_XGEN(j)  (2304 + 64 * (j))
#define XB_TOP      3328
#define XB_TOPGEN   3392
#define XCD_BAR_WORDS 3456
#define XB_SPIN_CAP (1u << 18)
__device__ __forceinline__ unsigned xb_ld(unsigned* p)              { return __hip_atomic_load(p, __ATOMIC_RELAXED, __HIP_MEMORY_SCOPE_AGENT); }
__device__ __forceinline__ unsigned xb_add(unsigned* p, unsigned v) { return __hip_atomic_fetch_add(p, v, __ATOMIC_RELAXED, __HIP_MEMORY_SCOPE_AGENT); }
__device__ __forceinline__ unsigned xb_xcc_id() { return (unsigned)__builtin_amdgcn_s_getreg((3 << 11) | 20) & 0xFu; }
#define XB_SPIN(cond, bar) do { unsigned _sp = 0; while (cond) { __builtin_amdgcn_s_sleep(1); \
    if ((++_sp & 255u) == 0u) { if (xb_ld(&(bar)[XB_TMO])) break; if (_sp > XB_SPIN_CAP) { atomicAdd(&(bar)[XB_TMO], 1u); break; } } } } while (0)
struct XcdBarrier { unsigned* bar; unsigned x; volatile LAS unsigned* st; };
__device__ __forceinline__ XcdBarrier xcd_barrier_post(unsigned* bar, volatile LAS unsigned* st) {
    XcdBarrier b; b.bar = bar; b.x = xb_xcc_id(); b.st = st;
    if (threadIdx.x == 0) (void)xb_add(&bar[XB_XCNT(b.x)], 1u);
    return b;
}
__device__ __forceinline__ void xcd_barrier_complete(unsigned* bar, unsigned x, unsigned& nloc, unsigned& nx) {
    const unsigned G = gridDim.x * gridDim.y * gridDim.z;
    unsigned sum, cnt, mine, sp = 0u;
    for (;;) {
        sum = 0u; cnt = 0u; mine = 0u;
#pragma unroll
        for (unsigned j = 0; j < 16; ++j) { const unsigned c = xb_ld(&bar[XB_XCNT(j)]); sum += c; cnt += (c > 0u) ? 1u : 0u; mine = (j == x) ? c : mine; }
        if (sum == G) break;
        __builtin_amdgcn_s_sleep(1);
        if ((++sp & 255u) == 0u) { if (xb_ld(&bar[XB_TMO])) break; if (sp > XB_SPIN_CAP) { atomicAdd(&bar[XB_TMO], 1u); break; } }
    }
    nloc = mine > 0u ? mine : 1u; nx = cnt > 0u ? cnt : 1u;
}
__device__ __forceinline__ void xcd_barrier(const XcdBarrier& b) {
    asm volatile("s_waitcnt vmcnt(0)" ::: "memory");
    __syncthreads();
    if (threadIdx.x == 0) {
        unsigned* bar = b.bar;
        __builtin_amdgcn_s_waitcnt(0);
        unsigned nloc = b.st[0], nx = b.st[1];
        if (nloc == 0u) { xcd_barrier_complete(bar, b.x, nloc, nx); b.st[0] = nloc; b.st[1] = nx; }
        const unsigned old = xb_add(&bar[XB_XSUB(b.x)], 1u);
        const unsigned gen = old / nloc;
        if (old + 1u == (gen + 1u) * nloc) {
            __builtin_amdgcn_fence(__ATOMIC_RELEASE, "agent");
            asm volatile("s_waitcnt vmcnt(0)" ::: "memory");
            const unsigned og = xb_add(&bar[XB_TOP], 1u);
            const unsigned tg = og / nx;
            if (og + 1u == (tg + 1u) * nx) xb_add(&bar[XB_TOPGEN], 1u);
            else XB_SPIN(xb_ld(&bar[XB_TOPGEN]) == tg, bar);
            __builtin_amdgcn_fence(__ATOMIC_ACQUIRE, "agent");
            xb_add(&bar[XB_XGEN(b.x)], 1u);
            asm volatile("s_waitcnt vmcnt(0)" ::: "memory");
        } else {
            XB_SPIN(xb_ld(&bar[XB_XGEN(b.x)]) == gen, bar);
            __builtin_amdgcn_fence(__ATOMIC_ACQUIRE, "agent");
            asm volatile("s_waitcnt vmcnt(0)" ::: "memory");
        }
    }
    __syncthreads();
}

constexpr size_t WS_WIN = 20 * MiB;
constexpr size_t WS_WA = 40 * MiB;
constexpr size_t WS_WBR = 41 * MiB;
constexpr size_t WS_WOUT = 45 * MiB;
constexpr size_t WS_WFGU = 49 * MiB;
constexpr size_t WS_WFD = 60 * MiB;
constexpr size_t WS_WMGU = 66 * MiB;
constexpr size_t WS_WMD = 178 * MiB;
constexpr size_t WS_BAR = 4096;
constexpr int RING_BYTES = 131072, MISC_OFF = RING_BYTES + 320, PSTAT_OFF = RING_BYTES + 1024  , RSTD_OFF = RING_BYTES + 6144  , LDS_BYTES = 147456;

template <bool GAIN>
DEV void cvt_item_t(const float* W, int ldw, int k0, int n0, bf16* dst, int Kd, LAS float* scr, int lane, const float* gain) {
    const int c = lane & 7;
    f32x4 g0 = {1.f, 1.f, 1.f, 1.f}, g1 = g0;
    if (GAIN) { g0 = *(const f32x4*)(gain + k0 + 8 * c); g1 = *(const f32x4*)(gain + k0 + 8 * c + 4); }
#pragma unroll
    for (int i = 0; i < 32; ++i) { const int kk = 2 * i + (lane >> 5); scr[kk * 33 + (lane & 31)] = W[(size_t)(k0 + kk) * ldw + n0 + (lane & 31)]; }
    asm volatile("s_waitcnt lgkmcnt(0)" ::: "memory");
#pragma unroll
    for (int j = 0; j < 4; ++j) { const int n = (lane >> 3) + 8 * j; const LAS float* s = scr + (8 * c) * 33 + n;
        u32x4 o; o.x = pk2(s[0 * 33] * g0[0], s[1 * 33] * g0[1]); o.y = pk2(s[2 * 33] * g0[2], s[3 * 33] * g0[3]); o.z = pk2(s[4 * 33] * g1[0], s[5 * 33] * g1[1]); o.w = pk2(s[6 * 33] * g1[2], s[7 * 33] * g1[3]);
        *(u32x4*)(dst + (size_t)n * Kd + 8 * c) = o; }
    asm volatile("s_waitcnt lgkmcnt(0)" ::: "memory");
}
DEV void cvt_item(const float* W, int ldw, int k0, int n0, bf16* dst, int Kd, LAS float* scr, int lane) { cvt_item_t<false>(W, ldw, k0, n0, dst, Kd, scr, lane, nullptr); }
DEV void cvt_item_g(const float* W, int ldw, int k0, int n0, bf16* dst, int Kd, LAS float* scr, int lane, const float* gain) { cvt_item_t<true>(W, ldw, k0, n0, dst, Kd, scr, lane, gain); }


DEV float4 ldx4(const bf16* row, int idx) { const uint2 t = ((const uint2*)row)[idx]; return make_float4(__uint_as_float(t.x << 16), __uint_as_float(t.x & 0xffff0000u), __uint_as_float(t.y << 16), __uint_as_float(t.y & 0xffff0000u)); }
DEV int otid() { int t = threadIdx.x; asm volatile("" : "+v"(t)); return t; }
typedef float f32x16 __attribute__((ext_vector_type(16)));
typedef __bf16 bf16x2_t __attribute__((ext_vector_type(2)));
DEV unsigned pkbf(float lo, float hi) { const f32x2 v = {lo, hi}; return __builtin_bit_cast(unsigned, __builtin_convertvector(v, bf16x2_t)); }
#define MFMA32(a, b, c) __builtin_amdgcn_mfma_f32_32x32x16_bf16((a), (b), (c), 0, 0, 0)
DEV int crow(int reg, int h) { return (reg & 3) + 8 * (reg >> 2) + 4 * h; }
constexpr int VT_LD = 68;
constexpr size_t WS_DL = 2 * MiB;
constexpr size_t WS_SSQ = 2 * MiB + 262144;
constexpr size_t WS_BG = WS_LOGA;
constexpr size_t WS_SP = 458 * MiB;
constexpr size_t WS_WA2 = 40 * MiB + 131072;
#define PACK8(x, s) __builtin_bit_cast(bf16x8, (u32x4){pkbf((x)[8 * (s)], (x)[8 * (s) + 1]), pkbf((x)[8 * (s) + 2], (x)[8 * (s) + 3]), pkbf((x)[8 * (s) + 4], (x)[8 * (s) + 5]), pkbf((x)[8 * (s) + 6], (x)[8 * (s) + 7])})
DEV void stage_vt(const bf16* p, int m0, LAS bf16* vt, int tid) {
#pragma unroll
    for (int i = 0; i < 8; ++i) { const int idx = tid + 512 * i, t = idx & 63, c8 = idx >> 6;
        const u32x4 v = *(const u32x4*)(p + (size_t)(m0 + t) * PLD + P_V + c8 * 8);
        LAS bf16* dst = vt + (c8 * 8) * VT_LD + t;
        dst[0 * VT_LD] = (bf16)(v.x & 0xffffu); dst[1 * VT_LD] = (bf16)(v.x >> 16); dst[2 * VT_LD] = (bf16)(v.y & 0xffffu); dst[3 * VT_LD] = (bf16)(v.y >> 16);
        dst[4 * VT_LD] = (bf16)(v.z & 0xffffu); dst[5 * VT_LD] = (bf16)(v.z >> 16); dst[6 * VT_LD] = (bf16)(v.w & 0xffffu); dst[7 * VT_LD] = (bf16)(v.w >> 16); }
}
DEV bf16x8 vt_frag(const LAS bf16* vt, int vrow, int tbase, int hh) {
    const LAS bf16* s = vt + vrow * VT_LD + tbase + 4 * hh;
    const u32x2 lo = *(const LAS u32x2*)s, hi = *(const LAS u32x2*)(s + 8);
    return __builtin_bit_cast(bf16x8, (u32x4){lo.x, lo.y, hi.x, hi.y});
}
DEV void gla_pass1(LAS unsigned char* lds, const bf16* hb, const float* ssq, const bf16* p, const bf16* WaT, const bf16* Wa2T, const float* b_a, float* BG, float* U, float* DL, int item) {
    int tid_ = threadIdx.x; asm volatile("" : "+v"(tid_));
    const int tid = tid_, lane = tid & 63, w = __builtin_amdgcn_readfirstlane(tid >> 6), l31 = lane & 31, hh = lane >> 5, m0 = item * 64, h = w >> 1, kb = w & 1;
    LAS float* alowf = (LAS float*)lds;
    LAS bf16* alowb = (LAS bf16*)(lds + 8192);
    LAS bf16* vt = (LAS bf16*)(lds + 16384);
    const int j = 32 * w + l31;
    bf16x8 af[16], wf[16];
    {   const int tb4 = w & 3, kh = w >> 2, row = m0 + 16 * tb4 + (lane & 15), kofs = 512 * kh + 8 * (lane >> 4);
#pragma unroll
        for (int ks = 0; ks < 16; ++ks) { af[ks] = *(const bf16x8*)(hb + (size_t)row * D + kofs + 32 * ks); wf[ks] = *(const bf16x8*)(WaT + (size_t)(lane & 15) * D + kofs + 32 * ks); } }
    unsigned kraw[2][16];
#pragma unroll
    for (int tb = 0; tb < 2; ++tb)
#pragma unroll
        for (int r = 0; r < 16; ++r) kraw[tb][r] = p[(size_t)(m0 + 32 * tb + crow(r, hh)) * PLD + P_K + j];
    const bf16x8 wfrag = *(const bf16x8*)(Wa2T + j * 16 + 8 * hh);
    const float ba = b_a[j];
    {
        const int tb4 = w & 3, kh = w >> 2;
        f32x4 acc = {0.f, 0.f, 0.f, 0.f};
#pragma unroll
        for (int ks = 0; ks < 16; ++ks) acc = __builtin_amdgcn_mfma_f32_16x16x32_bf16(af[ks], wf[ks], acc, 0, 0, 0);
#pragma unroll
        for (int r = 0; r < 4; ++r) alowf[(kh * 64 + 16 * tb4 + 4 * (lane >> 4) + r) * 16 + (lane & 15)] = acc[r];
    }
    stage_vt(p, m0, vt, tid);
    __syncthreads();
    for (int i = tid; i < 1024; i += 512) alowb[i] = (bf16)f2bf((alowf[i] + alowf[1024 + i]) * row_rstd(ssq, m0 + (i >> 4)));
    __syncthreads();
    f32x16 bc[2]; float carry = 0.f;
#pragma unroll
    for (int tb = 0; tb < 2; ++tb) {
        const bf16x8 afrag = *(const LAS bf16x8*)(alowb + (32 * tb + l31) * 16 + 8 * hh);
        f32x16 z;
#pragma unroll
        for (int r = 0; r < 16; ++r) z[r] = 0.f;
        z = MFMA32(afrag, wfrag, z);
        float gs[4], other[4];
#pragma unroll
        for (int g = 0; g < 4; ++g) {
#pragma unroll
            for (int e = 0; e < 4; ++e) { const float zz = z[4 * g + e] + ba; const float la = (fminf(zz, 0.f) - __logf(1.0f + __expf(-fabsf(zz)))) * (1.0f / 16.0f); z[4 * g + e] = la + (e ? z[4 * g + e - 1] : 0.f); }
            gs[g] = z[4 * g + 3]; other[g] = __shfl_xor(gs[g], 32);
        }
        float run = carry;
#pragma unroll
        for (int g = 0; g < 4; ++g) { const float h0 = hh ? other[g] : gs[g], h1 = hh ? gs[g] : other[g]; const float off = run + (hh ? h0 : 0.f);
#pragma unroll
            for (int e = 0; e < 4; ++e) bc[tb][4 * g + e] = z[4 * g + e] + off;
            run += h0 + h1; }
        carry = run;
    }
    const float blast = carry;
#pragma unroll
    for (int tb = 0; tb < 2; ++tb)
#pragma unroll
        for (int r = 0; r < 16; ++r) BG[(size_t)(m0 + 32 * tb + crow(r, hh)) * KW + j] = bc[tb][r];
    if (hh == 0) DL[(size_t)(item * 4 + h) * 64 + 32 * kb + l31] = __expf(blast);
    f32x16 kh2[2];
#pragma unroll
    for (int tb = 0; tb < 2; ++tb)
#pragma unroll
        for (int r = 0; r < 16; ++r) kh2[tb][r] = bf2f(kraw[tb][r]) * __expf(blast - bc[tb][r]);
#pragma unroll
    for (int vb = 0; vb < 4; ++vb) {
        f32x16 acc;
#pragma unroll
        for (int r = 0; r < 16; ++r) acc[r] = 0.f;
        const int vrow = 128 * h + 32 * vb + l31;
#pragma unroll
        for (int tb = 0; tb < 2; ++tb) { acc = MFMA32(vt_frag(vt, vrow, 32 * tb, hh), PACK8(kh2[tb], 0), acc); acc = MFMA32(vt_frag(vt, vrow, 32 * tb + 16, hh), PACK8(kh2[tb], 1), acc); }
#pragma unroll
        for (int r = 0; r < 16; ++r) U[((size_t)(item * 4 + h) * 128 + 32 * vb + crow(r, hh)) * 64 + 32 * kb + l31] = acc[r];
    }
}
DEV void conv_item(bf16* p, const float* cw, int item) {
    int tid_ = threadIdx.x; asm volatile("" : "+v"(tid_));
    const int tid = tid_, c0 = (tid & 63) * 8, tr = tid >> 6, m0 = item * 64 + 8 * tr, ts0 = m0 % SEQ;
    u32x4 xv[10], gv[10], bv[8];
#pragma unroll
    for (int i = 0; i < 10; ++i) { const bool ok = i >= 2 || ts0 > 0; const size_t r = (size_t)(ok ? m0 - 2 + i : m0) * PLD;
        xv[i] = *(const u32x4*)(p + r + P_XC + c0); gv[i] = *(const u32x4*)(p + r + P_GC + c0); if (!ok) { xv[i] = (u32x4){0u, 0u, 0u, 0u}; } }
#pragma unroll
    for (int i = 0; i < 8; ++i) bv[i] = *(const u32x4*)(p + (size_t)(m0 + i) * PLD + P_GB + c0);
    float w0[8], w1[8], w2[8];
#pragma unroll
    for (int e = 0; e < 8; ++e) { w0[e] = cw[0 * CC + c0 + e]; w1[e] = cw[1 * CC + c0 + e]; w2[e] = cw[2 * CC + c0 + e]; }
    float u[10][8];
#pragma unroll
    for (int i = 0; i < 10; ++i) { u[i][0] = blo(xv[i].x) * blo(gv[i].x); u[i][1] = bhi(xv[i].x) * bhi(gv[i].x); u[i][2] = blo(xv[i].y) * blo(gv[i].y); u[i][3] = bhi(xv[i].y) * bhi(gv[i].y);
        u[i][4] = blo(xv[i].z) * blo(gv[i].z); u[i][5] = bhi(xv[i].z) * bhi(gv[i].z); u[i][6] = blo(xv[i].w) * blo(gv[i].w); u[i][7] = bhi(xv[i].w) * bhi(gv[i].w); }
#pragma unroll
    for (int tt = 0; tt < 8; ++tt) {
        const float gbv[8] = {blo(bv[tt].x), bhi(bv[tt].x), blo(bv[tt].y), bhi(bv[tt].y), blo(bv[tt].z), bhi(bv[tt].z), blo(bv[tt].w), bhi(bv[tt].w)};
        float y[8];
#pragma unroll
        for (int e = 0; e < 8; ++e) y[e] = gbv[e] * (w0[e] * u[tt][e] + w1[e] * u[tt + 1][e] + w2[e] * u[tt + 2][e]);
        u32x4 o; o.x = pkbf(y[0], y[1]); o.y = pkbf(y[2], y[3]); o.z = pkbf(y[4], y[5]); o.w = pkbf(y[6], y[7]);
        *(u32x4*)(p + (size_t)(m0 + tt) * PLD + P_GB + c0) = o;
    }
}
DEV void gla_scan(const float* U, const float* DL, bf16* Sp, int bx, int nthreads) {
    const int gtid = bx * 512 + otid();
    for (int idx = gtid; idx < BATCH * NH * 128 * 16; idx += nthreads) {
        const int bh = idx >> 11, v = (idx >> 4) & 127, k4 = idx & 15, b = bh >> 2, h = bh & 3;
        f32x4 S = {0.f, 0.f, 0.f, 0.f};
#pragma unroll 8
        for (int n = 0; n < SEQ / 64; ++n) { const int item = b * (SEQ / 64) + n; const size_t base = ((size_t)(item * 4 + h) * 128 + v) * 64 + k4 * 4;
            const f32x4 u = *(const f32x4*)(U + base), d = *(const f32x4*)(DL + (size_t)(item * 4 + h) * 64 + k4 * 4);
            u32x2 o; o.x = pkbf(S[0], S[1]); o.y = pkbf(S[2], S[3]); *(u32x2*)(Sp + base) = o;
            S = d * S + u; }
    }
}
DEV void gla_pass3(LAS unsigned char* lds, bf16* p, const float* BG, const bf16* Sp, const float* gn, int item, bf16* ydst, int yld) {
    int tid_ = threadIdx.x; asm volatile("" : "+v"(tid_));
    const int tid = tid_, lane = tid & 63, w = __builtin_amdgcn_readfirstlane(tid >> 6), l31 = lane & 31, hh = lane >> 5, m0 = item * 64, h = w >> 1, vh = w & 1;
    LAS float* ssb = (LAS float*)lds;
    LAS bf16* vt = (LAS bf16*)(lds + 16384);
    stage_vt(p, m0, vt, tid);
    bf16x8 qf[2][4], kf[2][4];
#pragma unroll
    for (int blk = 0; blk < 2; ++blk)
#pragma unroll
        for (int ks = 0; ks < 4; ++ks) { const size_t row = (size_t)(m0 + 32 * blk + l31); const int kk = 64 * h + 16 * ks + 8 * hh;
            const u32x4 qv = *(const u32x4*)(p + row * PLD + P_Q + kk), kv = *(const u32x4*)(p + row * PLD + P_K + kk);
            const f32x4 b0 = *(const f32x4*)(BG + row * KW + kk), b1 = *(const f32x4*)(BG + row * KW + kk + 4);
            float ep[8], em[8];
#pragma unroll
            for (int e = 0; e < 4; ++e) { ep[e] = 0.125f * __expf(b0[e]); ep[4 + e] = 0.125f * __expf(b1[e]); em[e] = __expf(-b0[e]); em[4 + e] = __expf(-b1[e]); }
            qf[blk][ks] = __builtin_bit_cast(bf16x8, (u32x4){pkbf(blo(qv.x) * ep[0], bhi(qv.x) * ep[1]), pkbf(blo(qv.y) * ep[2], bhi(qv.y) * ep[3]), pkbf(blo(qv.z) * ep[4], bhi(qv.z) * ep[5]), pkbf(blo(qv.w) * ep[6], bhi(qv.w) * ep[7])});
            kf[blk][ks] = __builtin_bit_cast(bf16x8, (u32x4){pkbf(blo(kv.x) * em[0], bhi(kv.x) * em[1]), pkbf(blo(kv.y) * em[2], bhi(kv.y) * em[3]), pkbf(blo(kv.z) * em[4], bhi(kv.z) * em[5]), pkbf(blo(kv.w) * em[6], bhi(kv.w) * em[7])}); }
    bf16x8 spf[2][4];
#pragma unroll
    for (int vb = 0; vb < 2; ++vb)
#pragma unroll
        for (int ks = 0; ks < 4; ++ks) spf[vb][ks] = *(const bf16x8*)(Sp + ((size_t)(item * 4 + h) * 128 + 64 * vh + 32 * vb + l31) * 64 + 16 * ks + 8 * hh);
    f32x16 X00, X01, X11;
#pragma unroll
    for (int r = 0; r < 16; ++r) { X00[r] = 0.f; X01[r] = 0.f; X11[r] = 0.f; }
#pragma unroll
    for (int ks = 0; ks < 4; ++ks) { X00 = MFMA32(kf[0][ks], qf[0][ks], X00); X01 = MFMA32(kf[0][ks], qf[1][ks], X01); X11 = MFMA32(kf[1][ks], qf[1][ks], X11); }
#pragma unroll
    for (int r = 0; r < 16; ++r) if (crow(r, hh) > l31) { X00[r] = 0.f; X11[r] = 0.f; }
    f32x4 gnv[2][4];
#pragma unroll
    for (int vb = 0; vb < 2; ++vb)
#pragma unroll
        for (int g = 0; g < 4; ++g) gnv[vb][g] = *(const f32x4*)(gn + 64 * vh + 32 * vb + 8 * g + 4 * hh);
    u32x2 gvv[2][2][4];
#pragma unroll
    for (int vb = 0; vb < 2; ++vb)
#pragma unroll
        for (int ib = 0; ib < 2; ++ib)
#pragma unroll
            for (int g = 0; g < 4; ++g) gvv[vb][ib][g] = *(const u32x2*)(p + (size_t)(m0 + 32 * ib + l31) * PLD + P_GO + 128 * h + 64 * vh + 32 * vb + 8 * g + 4 * hh);
    __syncthreads();
    f32x16 O[2][2];
#pragma unroll
    for (int vb = 0; vb < 2; ++vb) {
        f32x16 O0, O1;
#pragma unroll
        for (int r = 0; r < 16; ++r) { O0[r] = 0.f; O1[r] = 0.f; }
        const int vloc = 64 * vh + 32 * vb + l31, vrow = 128 * h + vloc;
#pragma unroll
        for (int ks = 0; ks < 4; ++ks) { const bf16x8 sf = spf[vb][ks]; O0 = MFMA32(sf, qf[0][ks], O0); O1 = MFMA32(sf, qf[1][ks], O1); }
        { const bf16x8 a0 = vt_frag(vt, vrow, 0, hh), a1 = vt_frag(vt, vrow, 16, hh), a2 = vt_frag(vt, vrow, 32, hh), a3 = vt_frag(vt, vrow, 48, hh);
          O0 = MFMA32(a0, PACK8(X00, 0), O0); O0 = MFMA32(a1, PACK8(X00, 1), O0);
          O1 = MFMA32(a0, PACK8(X01, 0), O1); O1 = MFMA32(a1, PACK8(X01, 1), O1);
          O1 = MFMA32(a2, PACK8(X11, 0), O1); O1 = MFMA32(a3, PACK8(X11, 1), O1); }
        O[vb][0] = O0; O[vb][1] = O1;
    }
    float ss0 = 0.f, ss1 = 0.f;
#pragma unroll
    for (int vb = 0; vb < 2; ++vb)
#pragma unroll
        for (int r = 0; r < 16; ++r) { ss0 += O[vb][0][r] * O[vb][0][r]; ss1 += O[vb][1][r] * O[vb][1][r]; }
    ss0 += __shfl_xor(ss0, 32); ss1 += __shfl_xor(ss1, 32);
    if (hh == 0) { ssb[w * 64 + l31] = ss0; ssb[w * 64 + 32 + l31] = ss1; }
    __syncthreads();
    float rstd[2];
#pragma unroll
    for (int ib = 0; ib < 2; ++ib) rstd[ib] = rsqrtf((ssb[(2 * h) * 64 + 32 * ib + l31] + ssb[(2 * h + 1) * 64 + 32 * ib + l31]) * (1.0f / 128.0f) + EPS);
#pragma unroll
    for (int vb = 0; vb < 2; ++vb)
#pragma unroll
        for (int ib = 0; ib < 2; ++ib)
#pragma unroll
            for (int g = 0; g < 4; ++g) { const int v0 = 64 * vh + 32 * vb + 8 * g + 4 * hh; bf16* dst = ydst + (size_t)(m0 + 32 * ib + l31) * yld + 128 * h + v0;
                const u32x2 gv = gvv[vb][ib][g]; const f32x4 gg = gnv[vb][g];
                const float g0 = blo(gv.x), g1 = bhi(gv.x), g2 = blo(gv.y), g3 = bhi(gv.y);
                u32x2 o; o.x = pkbf(O[vb][ib][4 * g] * rstd[ib] * gg[0] * g0 * fsig(g0), O[vb][ib][4 * g + 1] * rstd[ib] * gg[1] * g1 * fsig(g1));
                o.y = pkbf(O[vb][ib][4 * g + 2] * rstd[ib] * gg[2] * g2 * fsig(g2), O[vb][ib][4 * g + 3] * rstd[ib] * gg[3] * g3 * fsig(g3));
                *(u32x2*)dst = o; }
}

DEV void xb_rows(const float* x, bf16* xb, float* ssq, int gw, int ngw) {
    const int lane = otid() & 63;
    for (int m0 = gw; m0 < M; m0 += 2 * ngw) {
        const int m1 = m0 + ngw < M ? m0 + ngw : m0;
        const float4* xr0 = (const float4*)(x + (size_t)m0 * D); const float4* xr1 = (const float4*)(x + (size_t)m1 * D);
        float4 v0[4], v1[4];
#pragma unroll
        for (int j = 0; j < 4; ++j) { v0[j] = xr0[lane + 64 * j]; v1[j] = xr1[lane + 64 * j]; }
        uint2* o0 = (uint2*)(xb + (size_t)m0 * D); uint2* o1 = (uint2*)(xb + (size_t)m1 * D); float s0 = 0.f, s1 = 0.f;
#pragma unroll
        for (int j = 0; j < 4; ++j) { s0 += v0[j].x * v0[j].x + v0[j].y * v0[j].y + v0[j].z * v0[j].z + v0[j].w * v0[j].w; s1 += v1[j].x * v1[j].x + v1[j].y * v1[j].y + v1[j].z * v1[j].z + v1[j].w * v1[j].w;
            uint2 w; w.x = pk2(v0[j].x, v0[j].y); w.y = pk2(v0[j].z, v0[j].w); o0[lane + 64 * j] = w; w.x = pk2(v1[j].x, v1[j].y); w.y = pk2(v1[j].z, v1[j].w); o1[lane + 64 * j] = w; }
        s0 = wave_sum(s0); s1 = wave_sum(s1);
        if (lane < 4) { ssq[(size_t)lane * M + m0] = lane == 0 ? s0 : 0.f; ssq[(size_t)lane * M + m1] = lane == 0 ? s1 : 0.f; }
    }
}
DEV void rms_rows(const float* x, const float* g, bf16* hb, int gw, int ngw) {
    const int lane = otid() & 63;
    for (int m = gw; m < M; m += ngw) {
        const float4* xr = (const float4*)(x + (size_t)m * D); const float4* gr = (const float4*)g;
        float4 v[4]; float ss = 0.f;
#pragma unroll
        for (int j = 0; j < 4; ++j) { v[j] = xr[lane + 64 * j]; ss += v[j].x * v[j].x + v[j].y * v[j].y + v[j].z * v[j].z + v[j].w * v[j].w; }
        const float rstd = rsqrtf(wave_sum(ss) * (1.0f / D) + EPS);
        uint2* o = (uint2*)(hb + (size_t)m * D);
#pragma unroll
        for (int j = 0; j < 4; ++j) { const float4 gg = gr[lane + 64 * j]; uint2 w; w.x = pk2(v[j].x * rstd * gg.x, v[j].y * rstd * gg.y); w.y = pk2(v[j].z * rstd * gg.z, v[j].w * rstd * gg.w); o[lane + 64 * j] = w; }
    }
}
DEV void route1_stage(LAS float* wT, const float* g2, const float* wr) {
    const int tid = otid();
    for (int k = tid; k < D; k += 512) { const float g = g2[k]; const float4 w0 = *(const float4*)(wr + (size_t)k * 8), w1 = *(const float4*)(wr + (size_t)k * 8 + 4);
        wT[0 * D + k] = w0.x * g; wT[1 * D + k] = w0.y * g; wT[2 * D + k] = w0.z * g; wT[3 * D + k] = w0.w * g; wT[4 * D + k] = w1.x * g; wT[5 * D + k] = w1.y * g; wT[6 * D + k] = w1.z * g; wT[7 * D + k] = w1.w * g; }
    __syncthreads();
}
DEV void route1_grp(const LAS float* wT, LAS int* lcnt, const bf16* x, float* rstd_o, int* tok_e, float* tok_w, int* counts, int grp) {
    const int tid = otid(), lane = tid & 63, wave = tid >> 6;
    if (tid < 8) lcnt[tid] = 0;
    __syncthreads();
    const int hh = lane >> 5, b4 = (lane >> 4) & 1, b3 = (lane >> 3) & 1;
    uint2 xraw[8][4];
#pragma unroll
    for (int i = 0; i < 8; ++i)
#pragma unroll
        for (int j = 0; j < 4; ++j) xraw[i][j] = ((const uint2*)(x + (size_t)(grp * 64 + wave * 8 + i) * D))[lane + 64 * j];
#pragma unroll
    for (int i = 0; i < 8; ++i) {
        const int m = grp * 64 + wave * 8 + i;
        float4 v[4]; float ss = 0.f; float a[8];
#pragma unroll
        for (int e = 0; e < 8; ++e) a[e] = 0.f;
#pragma unroll
        for (int j = 0; j < 4; ++j) { const uint2 t = xraw[i][j]; v[j] = make_float4(blo(t.x), bhi(t.x), blo(t.y), bhi(t.y)); ss += v[j].x * v[j].x + v[j].y * v[j].y + v[j].z * v[j].z + v[j].w * v[j].w; }
#pragma unroll
        for (int j = 0; j < 4; ++j)
#pragma unroll
            for (int e = 0; e < 8; ++e) { const f32x4 w = *(const LAS f32x4*)(wT + e * D + 4 * (lane + 64 * j)); a[e] += v[j].x * w[0] + v[j].y * w[1] + v[j].z * w[2] + v[j].w * w[3]; }
        ss = wave_sum(ss);
        float c4[4], c2[2];
#pragma unroll
        for (int e = 0; e < 4; ++e) { const float keep = hh ? a[e + 4] : a[e], send = hh ? a[e] : a[e + 4]; c4[e] = keep + __shfl_xor(send, 32); }
#pragma unroll
        for (int e = 0; e < 2; ++e) { const float keep = b4 ? c4[e + 2] : c4[e], send = b4 ? c4[e] : c4[e + 2]; c2[e] = keep + __shfl_xor(send, 16); }
        float c1 = (b3 ? c2[1] : c2[0]) + __shfl_xor(b3 ? c2[0] : c2[1], 8);
        c1 += __shfl_xor(c1, 4); c1 += __shfl_xor(c1, 2); c1 += __shfl_xor(c1, 1);
        const float rstd = rsqrtf(ss * (1.0f / D) + EPS);
        float lg[8];
#pragma unroll
        for (int e = 0; e < 8; ++e) lg[e] = __uint_as_float(__builtin_amdgcn_readlane((int)__float_as_uint(c1), 32 * (e >> 2) + 16 * ((e >> 1) & 1) + 8 * (e & 1))) * rstd;
        int i1 = 0; float l1 = lg[0];
#pragma unroll
        for (int e = 1; e < 8; ++e) if (lg[e] > l1) { l1 = lg[e]; i1 = e; }
        int i2 = -1; float l2 = -3.0e38f;
#pragma unroll
        for (int e = 0; e < 8; ++e) if (e != i1 && lg[e] > l2) { l2 = lg[e]; i2 = e; }
        const float ex = expf(l2 - l1), w1v = 1.0f / (1.0f + ex), w2v = ex / (1.0f + ex);
        if (lane == 0) { rstd_o[m] = rstd; tok_e[m * 2] = i1; tok_e[m * 2 + 1] = i2; tok_w[m * 2] = w1v; tok_w[m * 2 + 1] = w2v;
            __hip_atomic_fetch_add(&lcnt[i1], 1, __ATOMIC_RELAXED, __HIP_MEMORY_SCOPE_WORKGROUP); __hip_atomic_fetch_add(&lcnt[i2], 1, __ATOMIC_RELAXED, __HIP_MEMORY_SCOPE_WORKGROUP); }
    }
    __syncthreads();
    if (tid < 8) counts[grp * 8 + tid] = lcnt[tid];
    __syncthreads();
}
DEV void route2_grp(LAS int* L, const bf16* x, const float* g2, const float* rstd_i, const int* counts, const int* tok_e, int* slot, unsigned char* hbp, int* tilet, int grp, int wgi, int nwg) {
    LAS int* ltot = L; LAS int* lpre = L + 8; LAS int* lseg = L + 16; LAS int* lslot = L + 32; LAS int* lte = L + 160;
    const int tid = otid(), lane = tid & 63, wave = tid >> 6;
    if (tid < 128) lte[tid] = tok_e[(grp * 64) * 2 + tid];
    { int tot = 0, pre = 0;
#pragma unroll
        for (int q = 0; q < 4; ++q) { const int w = lane + 64 * q; const int c = counts[w * 8 + wave]; tot += c; pre += (w < grp) ? c : 0; }
#pragma unroll
        for (int o = 1; o < 64; o <<= 1) { tot += __shfl_xor(tot, o); pre += __shfl_xor(pre, o); }
        if (lane == 0) { ltot[wave] = tot; lpre[wave] = pre; } }
    __syncthreads();
    if (tid == 0) { int off = 0; for (int e = 0; e < 8; ++e) { lseg[e] = off; off += ((ltot[e] + 255) / 256) * 256; } lseg[8] = off; }
    __syncthreads();
    { const int base = lseg[wave] + lpre[wave]; const bool m0 = lte[2 * lane] == wave, m1 = lte[2 * lane + 1] == wave;
        const unsigned long long b0 = __ballot(m0), b1 = __ballot(m1), lt = (1ull << lane) - 1ull;
        const int r0 = __popcll(b0 & lt) + __popcll(b1 & lt);
        if (m0) lslot[2 * lane] = base + r0;
        if (m1) lslot[2 * lane + 1] = base + r0 + (m0 ? 1 : 0); }
    __syncthreads();
    if (tid < 128) slot[(grp * 64) * 2 + tid] = lslot[tid];
    {   const float4* gr = (const float4*)g2; float4 gq[4];
#pragma unroll
        for (int j = 0; j < 4; ++j) gq[j] = gr[lane + 64 * j];
        uint2 xraw[8][4]; float rs[8];
#pragma unroll
        for (int q = 0; q < 8; ++q) { const int m = grp * 64 + wave + 8 * q; rs[q] = rstd_i[m];
#pragma unroll
            for (int j = 0; j < 4; ++j) xraw[q][j] = ((const uint2*)(x + (size_t)m * D))[lane + 64 * j]; }
#pragma unroll
        for (int q = 0; q < 8; ++q) { const int i = wave + 8 * q; const float rstd = rs[q];
            unsigned* o1 = (unsigned*)(hbp + (size_t)lslot[2 * i] * D); unsigned* o2 = (unsigned*)(hbp + (size_t)lslot[2 * i + 1] * D);
#pragma unroll
            for (int j = 0; j < 4; ++j) { const uint2 t = xraw[q][j]; const float4 gg = gq[j]; const unsigned w = pk4_fp8(blo(t.x) * rstd * gg.x, bhi(t.x) * rstd * gg.y, blo(t.y) * rstd * gg.z, bhi(t.y) * rstd * gg.w); o1[lane + 64 * j] = w; o2[lane + 64 * j] = w; } }
    }
    if (grp == 0) {
        if (tid < NTILE_MAX) { const int r = tid * 256; int e = -1; for (int q = 0; q < 8; ++q) if (r >= lseg[q] && r < lseg[q + 1]) e = q; tilet[tid] = e; }
        if (tid == 0) tilet[NTILE_MAX] = lseg[8] / 256;
    }
    if (grp == wgi) {
        for (int e = 0; e < 8; ++e) { const int r0 = lseg[e] + ltot[e], r1 = lseg[e + 1];
            for (int r = r0 + wgi; r < r1; r += nwg) if (tid < 256) ((unsigned*)(hbp + (size_t)r * D))[tid] = 0u; }
    }
    __syncthreads();
}
DEV void combine_rows(const bf16* x, const bf16* obuf, const float* obx, const int* slot, const float* tok_w, const float* gf, float* out, int gw, int ngw) {
    const int lane = otid() & 63;
    const float4* gr = (const float4*)gf; float4 gq[4];
#pragma unroll
    for (int j = 0; j < 4; ++j) gq[j] = gr[lane + 64 * j];
    for (int m0 = gw; m0 < M; m0 += 2 * ngw) {
        const int mm[2] = {m0, m0 + ngw < M ? m0 + ngw : m0};
        int s1[2], s2[2]; float w1[2], w2[2];
#pragma unroll
        for (int q = 0; q < 2; ++q) { const int2 sl = *(const int2*)(slot + mm[q] * 2); const float2 tw = *(const float2*)(tok_w + mm[q] * 2); s1[q] = sl.x; s2[q] = sl.y; w1[q] = tw.x; w2[q] = tw.y; }
        float4 v[2][4], ea[2][4], ec[2][4];
        if (s1[0] < 128 * 256 && s2[0] < 128 * 256 && s1[1] < 128 * 256 && s2[1] < 128 * 256) {
            uint2 xa[2][4], oa[2][4], oc[2][4];
#pragma unroll
            for (int q = 0; q < 2; ++q)
#pragma unroll
                for (int j = 0; j < 4; ++j) { xa[q][j] = ((const uint2*)(x + (size_t)mm[q] * D))[lane + 64 * j]; oa[q][j] = ((const uint2*)(obuf + (size_t)s1[q] * D))[lane + 64 * j]; oc[q][j] = ((const uint2*)(obuf + (size_t)s2[q] * D))[lane + 64 * j]; }
#pragma unroll
            for (int q = 0; q < 2; ++q)
#pragma unroll
                for (int j = 0; j < 4; ++j) { v[q][j] = make_float4(blo(xa[q][j].x), bhi(xa[q][j].x), blo(xa[q][j].y), bhi(xa[q][j].y)); ea[q][j] = make_float4(blo(oa[q][j].x), bhi(oa[q][j].x), blo(oa[q][j].y), bhi(oa[q][j].y)); ec[q][j] = make_float4(blo(oc[q][j].x), bhi(oc[q][j].x), blo(oc[q][j].y), bhi(oc[q][j].y)); }
        } else
#pragma unroll
        for (int q = 0; q < 2; ++q) {
            const bf16* xr = x + (size_t)mm[q] * D; const uint2* o1 = (const uint2*)(obuf + (size_t)s1[q] * D); const uint2* o2 = (const uint2*)(obuf + (size_t)s2[q] * D);
#pragma unroll
            for (int j = 0; j < 4; ++j) { v[q][j] = ldx4(xr, lane + 64 * j);
                if (s1[q] < 128 * 256) { const uint2 a = o1[lane + 64 * j]; ea[q][j] = make_float4(blo(a.x), bhi(a.x), blo(a.y), bhi(a.y)); }
                else { float4 e = make_float4(0.f, 0.f, 0.f, 0.f); for (int ks = 0; ks < KSPLIT; ++ks) { const float4 t = ((const float4*)(obx + ((size_t)ks * 2048 + (s1[q] - 128 * 256)) * D))[lane + 64 * j]; e.x += t.x; e.y += t.y; e.z += t.z; e.w += t.w; } ea[q][j] = e; }
                if (s2[q] < 128 * 256) { const uint2 c = o2[lane + 64 * j]; ec[q][j] = make_float4(blo(c.x), bhi(c.x), blo(c.y), bhi(c.y)); }
                else { float4 e = make_float4(0.f, 0.f, 0.f, 0.f); for (int ks = 0; ks < KSPLIT; ++ks) { const float4 t = ((const float4*)(obx + ((size_t)ks * 2048 + (s2[q] - 128 * 256)) * D))[lane + 64 * j]; e.x += t.x; e.y += t.y; e.z += t.z; e.w += t.w; } ec[q][j] = e; } }
        }
#pragma unroll
        for (int q = 0; q < 2; ++q) { float ss = 0.f;
#pragma unroll
            for (int j = 0; j < 4; ++j) { v[q][j].x += w1[q] * ea[q][j].x + w2[q] * ec[q][j].x; v[q][j].y += w1[q] * ea[q][j].y + w2[q] * ec[q][j].y; v[q][j].z += w1[q] * ea[q][j].z + w2[q] * ec[q][j].z; v[q][j].w += w1[q] * ea[q][j].w + w2[q] * ec[q][j].w;
                ss += v[q][j].x * v[q][j].x + v[q][j].y * v[q][j].y + v[q][j].z * v[q][j].z + v[q][j].w * v[q][j].w; }
            const float rstd = rsqrtf(wave_sum(ss) * (1.0f / D) + EPS);
            float4* orow = (float4*)(out + (size_t)mm[q] * D);
#pragma unroll
            for (int j = 0; j < 4; ++j) orow[lane + 64 * j] = make_float4(v[q][j].x * rstd * gq[j].x, v[q][j].y * rstd * gq[j].y, v[q][j].z * rstd * gq[j].z, v[q][j].w * rstd * gq[j].w); }
    }
}

DEV void cvt_item8(const float* W, int ldw, int k0, int n0, unsigned char* dst, int Kd, LAS float* scr, int lane) {
#pragma unroll
    for (int i = 0; i < 32; ++i) { const int kk = 2 * i + (lane >> 5); scr[kk * 33 + (lane & 31)] = W[(size_t)(k0 + kk) * ldw + n0 + (lane & 31)]; }
    asm volatile("s_waitcnt lgkmcnt(0)" ::: "memory");
    const int c = lane & 3;
#pragma unroll
    for (int j = 0; j < 2; ++j) { const int n = (lane >> 2) + 16 * j; const LAS float* sp = scr + (16 * c) * 33 + n;
        u32x4 o; o.x = pk4_fp8(sp[0 * 33] * W8_SCALE, sp[1 * 33] * W8_SCALE, sp[2 * 33] * W8_SCALE, sp[3 * 33] * W8_SCALE); o.y = pk4_fp8(sp[4 * 33] * W8_SCALE, sp[5 * 33] * W8_SCALE, sp[6 * 33] * W8_SCALE, sp[7 * 33] * W8_SCALE);
        o.z = pk4_fp8(sp[8 * 33] * W8_SCALE, sp[9 * 33] * W8_SCALE, sp[10 * 33] * W8_SCALE, sp[11 * 33] * W8_SCALE); o.w = pk4_fp8(sp[12 * 33] * W8_SCALE, sp[13 * 33] * W8_SCALE, sp[14 * 33] * W8_SCALE, sp[15 * 33] * W8_SCALE);
        *(u32x4*)(dst + (size_t)n * Kd + 16 * c) = o; }
    asm volatile("s_waitcnt lgkmcnt(0)" ::: "memory");
}
struct CvtD { const float* W; const float* gain; unsigned char* dst; int ldw, k0, n0, Kd, kind; };
DEV void cvt_load(const CvtD& d, int lane, float (&r)[32]) {
#pragma unroll
    for (int i = 0; i < 8; ++i) { const f32x4 t = *(const f32x4*)(d.W + (size_t)(d.k0 + 8 * i + (lane >> 3)) * d.ldw + d.n0 + 4 * (lane & 7)); r[4 * i] = t[0]; r[4 * i + 1] = t[1]; r[4 * i + 2] = t[2]; r[4 * i + 3] = t[3]; }
}
DEV void cvt_finish(const CvtD& d, const float (&r)[32], LAS float* scr, int lane) {
#pragma unroll
    for (int i = 0; i < 8; ++i)
#pragma unroll
        for (int e = 0; e < 4; ++e) scr[(8 * i + (lane >> 3)) * 33 + 4 * (lane & 7) + e] = r[4 * i + e];
    asm volatile("s_waitcnt lgkmcnt(0)" ::: "memory");
    if (d.kind == 2) {
        const int c = lane & 3;
#pragma unroll
        for (int j = 0; j < 2; ++j) { const int n = (lane >> 2) + 16 * j; const LAS float* sp = scr + (16 * c) * 33 + n;
            u32x4 o; o.x = pk4_fp8(sp[0 * 33] * W8_SCALE, sp[1 * 33] * W8_SCALE, sp[2 * 33] * W8_SCALE, sp[3 * 33] * W8_SCALE); o.y = pk4_fp8(sp[4 * 33] * W8_SCALE, sp[5 * 33] * W8_SCALE, sp[6 * 33] * W8_SCALE, sp[7 * 33] * W8_SCALE);
            o.z = pk4_fp8(sp[8 * 33] * W8_SCALE, sp[9 * 33] * W8_SCALE, sp[10 * 33] * W8_SCALE, sp[11 * 33] * W8_SCALE); o.w = pk4_fp8(sp[12 * 33] * W8_SCALE, sp[13 * 33] * W8_SCALE, sp[14 * 33] * W8_SCALE, sp[15 * 33] * W8_SCALE);
            *(u32x4*)(d.dst + (size_t)n * d.Kd + 16 * c) = o; }
    } else {
        const int c = lane & 7;
        f32x4 g0 = {1.f, 1.f, 1.f, 1.f}, g1 = g0;
        if (d.kind == 1) { g0 = *(const f32x4*)(d.gain + d.k0 + 8 * c); g1 = *(const f32x4*)(d.gain + d.k0 + 8 * c + 4); }
#pragma unroll
        for (int j = 0; j < 4; ++j) { const int n = (lane >> 3) + 8 * j; const LAS float* sp = scr + (8 * c) * 33 + n;
            u32x4 o; o.x = pk2(sp[0 * 33] * g0[0], sp[1 * 33] * g0[1]); o.y = pk2(sp[2 * 33] * g0[2], sp[3 * 33] * g0[3]); o.z = pk2(sp[4 * 33] * g1[0], sp[5 * 33] * g1[1]); o.w = pk2(sp[6 * 33] * g1[2], sp[7 * 33] * g1[3]);
            *(u32x4*)(d.dst + ((size_t)n * d.Kd + 8 * c) * 2) = o; }
    }
    asm volatile("s_waitcnt lgkmcnt(0)" ::: "memory");
}
struct Args { const float* in[18]; float* out; unsigned char* ws; int ph_lo, ph_hi; };
enum { PH_CVT = 0, PH_G1 = 1, PH_GLA1 = 2, PH_SCAN = 3, PH_GLA3 = 4, PH_G2 = 5, PH_G3 = 6, PH_RMS2 = 7, PH_UP = 8, PH_DOWN = 9, PH_RMS1 = 10, PH_LAYER = 16, PH_ROUTE1 = 23, PH_ROUTE2 = 24, PH_MUPA = 25, PH_MDOWNA = 26, PH_MUPB = 27, PH_MDOWNB = 28, PH_COMBINE = 29, PH_END = 30 };

__global__ void __launch_bounds__(512, 2) mega(Args args) {
    extern __shared__ __attribute__((aligned(16))) unsigned char lds_raw[];
    LAS unsigned char* lds = (LAS unsigned char*)lds_raw;
    const int wave = __builtin_amdgcn_readfirstlane((int)threadIdx.x >> 6);
    const int G = gridDim.x, bx = blockIdx.x;
    unsigned char* ws = args.ws;
    const int lo = args.ph_lo, hi = args.ph_hi;
#define IN(k) (lo <= (k) && (k) < hi)
#define SEAM(k) do { if ((k) + 1 < hi) { xcd_barrier(bar); if (DUP_PH == 99) xcd_barrier(bar); } } while (0)
    volatile LAS unsigned* MISC = (volatile LAS unsigned*)(lds + MISC_OFF);
    if (threadIdx.x < 16) MISC[threadIdx.x] = 0u;
    __syncthreads();
    XcdBarrier bar = xcd_barrier_post((unsigned*)(ws + WS_BAR), MISC + 8);
    const int gw = bx * 8 + wave, ngw = G * 8;
    if (IN(PH_CVT)) {
        const int tid = otid(), lane = tid & 63;
        LAS float* scr = (LAS float*)(lds + wave * 16384);
        const int NGW = ngw;
        constexpr int I_IN = 16 * 160, I_BR = 8 * 32, I_OUT = 16 * 32, I_FGU = 16 * 88, I_FD = 44 * 32, I_MGU = 16 * 112, I_MD = 56 * 32;
        constexpr int I_LAYER = I_IN + 2 * I_BR + I_OUT, I_FFN = 2 * I_FGU + I_FD, I_EXP = 2 * I_MGU + I_MD, NITEMS = 2 * I_LAYER + I_FFN + 8 * I_EXP;
        auto decode = [&](int it) -> CvtD {
            CvtD d; int r = it;
            if (r < 2 * I_LAYER) { const int l = r / I_LAYER; r -= l * I_LAYER;
                if (r < I_IN) { const int kb = r / 160, nb = r % 160, n0d = nb * 32, n0s = n0d < 3072 ? n0d : n0d + 16;
                    d.W = args.in[2] + (size_t)l * D * IN_COLS; d.ldw = IN_COLS; d.k0 = kb * 64; d.n0 = n0s; d.dst = ws + WS_WIN + (((size_t)l * PLD + n0d) * D + kb * 64) * 2; d.Kd = D; d.gain = args.in[1] + l * D; d.kind = 1; return d; }
                r -= I_IN;
                if (r < 2 * I_BR) { const int br = r / I_BR; r -= br * I_BR; const int kb = r / 32, nb = r % 32;
                    d.W = args.in[7] + (size_t)(l * 2 + br) * CC * D; d.ldw = D; d.k0 = kb * 64; d.n0 = nb * 32; d.dst = ws + WS_WBR + (((size_t)(l * 2 + br) * D + nb * 32) * CC + kb * 64) * 2; d.Kd = CC; d.gain = nullptr; d.kind = 0; return d; }
                r -= 2 * I_BR;
                { const int kb = r / 32, nb = r % 32; d.W = args.in[8] + (size_t)l * D * D; d.ldw = D; d.k0 = kb * 64; d.n0 = nb * 32; d.dst = ws + WS_WOUT + (((size_t)l * D + nb * 32) * D + kb * 64) * 2; d.Kd = D; d.gain = nullptr; d.kind = 0; return d; }
            }
            r -= 2 * I_LAYER;
            if (r < I_FFN) {
                if (r < 2 * I_FGU) { const int up = r / I_FGU; r -= up * I_FGU; const int kb = r / 88, nb = r % 88, n0 = nb * 32, drow = (n0 >> 7) * 256 + up * 128 + (n0 & 127);
                    d.W = args.in[10 + up]; d.ldw = DFF; d.k0 = kb * 64; d.n0 = n0; d.dst = ws + WS_WFGU + ((size_t)drow * D + kb * 64) * 2; d.Kd = D; d.gain = args.in[9]; d.kind = 1; return d; }
                r -= 2 * I_FGU;
                { const int kb = r / 32, nb = r % 32; d.W = args.in[12]; d.ldw = D; d.k0 = kb * 64; d.n0 = nb * 32; d.dst = ws + WS_WFD + ((size_t)(nb * 32) * DFF + kb * 64) * 2; d.Kd = DFF; d.gain = nullptr; d.kind = 0; return d; }
            }
            r -= I_FFN;
            { const int e = r / I_EXP; r -= e * I_EXP;
                if (r < 2 * I_MGU) { const int up = r / I_MGU; r -= up * I_MGU; const int kb = r / 112, nb = r % 112, n0 = nb * 32, drow = (n0 >> 7) * 256 + up * 128 + (n0 & 127);
                    d.W = args.in[14 + up] + (size_t)e * D * DFE; d.ldw = DFE; d.k0 = kb * 64; d.n0 = n0; d.dst = ws + WS_WMGU + ((size_t)e * 2 * DFE + drow) * D + kb * 64; d.Kd = D; d.gain = nullptr; d.kind = 2; return d; }
                r -= 2 * I_MGU;
                { const int kb = r / 32, nb = r % 32; d.W = args.in[16] + (size_t)e * DFE * D; d.ldw = D; d.k0 = kb * 64; d.n0 = nb * 32; d.dst = ws + WS_WMD + ((size_t)e * D + nb * 32) * DFE + kb * 64; d.Kd = DFE; d.gain = nullptr; d.kind = 2; return d; } }
        };
        if (gw < NITEMS) {
            int it = gw; CvtD d = decode(it); float r[32]; cvt_load(d, lane, r);
            for (;;) {
                const int nx = it + NGW;
                if (nx < NITEMS) { const CvtD dn = decode(nx); float rn[32]; cvt_load(dn, lane, rn); cvt_finish(d, r, scr, lane); d = dn;
#pragma unroll
                    for (int i = 0; i < 32; ++i) r[i] = rn[i];
                    it = nx; }
                else { cvt_finish(d, r, scr, lane); break; }
            }
        }
        for (int i = bx * 512 + tid; i < 2 * RANK * D; i += G * 512) { const int l = i / (RANK * D), n = (i / D) % RANK, k = i % D; ((bf16*)(ws + WS_WA))[i] = (bf16)f2bf(args.in[2][(size_t)l * D * IN_COLS + (size_t)k * IN_COLS + 3072 + n] * args.in[1][l * D + k]); }
        for (int i = bx * 512 + tid; i < 2 * KW * RANK; i += G * 512) { const int l = i / (KW * RANK), j = (i / RANK) % KW, r = i % RANK; ((bf16*)(ws + WS_WA2))[i] = (bf16)f2bf(args.in[3][(size_t)l * RANK * KW + r * KW + j]); }
        xb_rows(args.in[0], (bf16*)(ws + WS_HB), (float*)(ws + WS_SSQ), gw, ngw);
        __syncthreads();
        SEAM(PH_CVT);
    }
    for (int l = 0; l < 2; ++l) {
        const int pb = l * PH_LAYER;
        bf16* p = (bf16*)(ws + WS_P); bf16* hb = (bf16*)(ws + WS_HB); bf16* merged = (bf16*)(ws + WS_U);
        if (IN(pb + PH_G1)) {
            SchedGrid S{(const char*)hb, (const char*)((bf16*)(ws + WS_WIN) + (size_t)l * PLD * D), (size_t)256 * D * 2, (size_t)256 * D * 2, M / 256, PLD / 256, G, bx};
            fill_rstd((LAS float*)(lds + RSTD_OFF), S, (const float*)(ws + WS_SSQ));
            for (int rep_ = 0; rep_ < NREP(pb + PH_G1); ++rep_) pg8::gemm_phase<EBf16T<true>, SchedGrid, true, true>(lds, D, D, D, S, EBf16T<true>{p, PLD, 1.0f, (const LAS float*)(lds + RSTD_OFF)});
            SEAM(pb + PH_G1);
        }
        if (IN(pb + PH_GLA1)) {
            for (int rep_ = 0; rep_ < NREP(pb + PH_GLA1); ++rep_)
            for (int item = bx; item < M / 64; item += G) {
                if (rep_ == NREP(pb + PH_GLA1) - 1) conv_item(p, args.in[5] + l * 3 * CC, item);
                gla_pass1(lds, hb, (const float*)(ws + WS_SSQ), p, (const bf16*)(ws + WS_WA) + (size_t)l * RANK * D, (const bf16*)(ws + WS_WA2) + (size_t)l * KW * RANK, args.in[4] + l * KW, (float*)(ws + WS_BG), (float*)(ws + WS_U), (float*)(ws + WS_DL), item);
                __syncthreads();
            }
            SEAM(pb + PH_GLA1);
        }
        if (IN(pb + PH_SCAN)) { for (int rep_ = 0; rep_ < NREP(pb + PH_SCAN); ++rep_) gla_scan((const float*)(ws + WS_U), (const float*)(ws + WS_DL), (bf16*)(ws + WS_SP), bx, G * 512); SEAM(pb + PH_SCAN); }
        if (IN(pb + PH_GLA3)) {
            for (int rep_ = 0; rep_ < NREP(pb + PH_GLA3); ++rep_)
            for (int item = bx; item < M / 64; item += G) { const bool lastrep = rep_ == NREP(pb + PH_GLA3) - 1;
                gla_pass3(lds, p, (const float*)(ws + WS_BG), (const bf16*)(ws + WS_SP), args.in[6] + l * DV, item, lastrep ? p + P_GO : (bf16*)(ws + WS_ACTP), lastrep ? PLD : VW); __syncthreads(); }
            SEAM(pb + PH_GLA3);
        }
        if (IN(pb + PH_G2)) {
            const bf16* wb = (const bf16*)(ws + WS_WBR) + (size_t)l * 2 * D * CC;
            SchedPair S{(const char*)(p + P_GB), (const char*)(p + P_GO), (const char*)wb, (const char*)(wb + (size_t)D * CC), (size_t)256 * PLD * 2, (size_t)256 * CC * 2, M / 256, D / 256, G, bx};
            for (int rep_ = 0; rep_ < NREP(pb + PH_G2); ++rep_) pg8::gemm_phase<EMerge, SchedPair, true, true>(lds, CC, PLD, CC, S, EMerge{merged, p});
            SEAM(pb + PH_G2);
        }
        if (IN(pb + PH_G3)) {
            SchedGrid S{(const char*)merged, (const char*)((bf16*)(ws + WS_WOUT) + (size_t)l * D * D), (size_t)256 * D * 2, (size_t)256 * D * 2, M / 256, D / 256, G, bx};
            if (l == 0) { for (int rep_ = 0; rep_ < NREP(pb + PH_G3); ++rep_) pg8::gemm_phase<ERes, SchedGrid, true, true>(lds, D, D, D, S, ERes{hb, (float*)(ws + WS_SSQ), (LAS float*)(lds + PSTAT_OFF)}); }
            else pg8::gemm_phase<EResT<false>, SchedGrid, true, true>(lds, D, D, D, S, EResT<false>{hb, nullptr, nullptr});
            SEAM(pb + PH_G3);
        }
        if (l == 0) {
            bf16* act = (bf16*)(ws + WS_P);
            if (IN(PH_UP)) {
                SchedGrid S{(const char*)hb, (const char*)(ws + WS_WFGU), (size_t)256 * D * 2, (size_t)256 * D * 2, M / 256, 2 * DFF / 256, G, bx};
                fill_rstd((LAS float*)(lds + RSTD_OFF), S, (const float*)(ws + WS_SSQ));
                for (int rep_ = 0; rep_ < NREP(PH_UP); ++rep_) pg8::gemm_phase<ESwiglu, SchedGrid, true, true>(lds, D, D, D, S, ESwiglu{act, DFF, (const LAS float*)(lds + RSTD_OFF)});
                SEAM(PH_UP);
            }
            if (IN(PH_DOWN)) {
                SchedGrid S{(const char*)act, (const char*)(ws + WS_WFD), (size_t)256 * DFF * 2, (size_t)256 * DFF * 2, M / 256, D / 256, G, bx};
                pg8::gemm_phase<ERes, SchedGrid, true, true>(lds, DFF, DFF, DFF, S, ERes{hb, (float*)(ws + WS_SSQ), (LAS float*)(lds + PSTAT_OFF)});
                SEAM(PH_DOWN);
            }
        } else {
            int* tilet = (int*)(ws + WS_TILE); unsigned char* hbp = ws + WS_HBP; unsigned char* actp = ws + WS_ACTP; bf16* obuf = (bf16*)(ws + WS_OBUF);
            int* counts = (int*)(ws + WS_CNT); int* tok_e = (int*)(ws + WS_TOKE); float* tok_w = (float*)(ws + WS_TOKW); int* slot = (int*)(ws + WS_SLOT); float* rstd = (float*)(ws + WS_RSTD);
            if (IN(PH_ROUTE1)) { route1_stage((LAS float*)lds, args.in[9] + D, args.in[13]);
                for (int rep_ = 0; rep_ < NREP(PH_ROUTE1); ++rep_) for (int grp = bx; grp < M / 64; grp += G) route1_grp((const LAS float*)lds, (LAS int*)(lds + 32768), hb, rstd, tok_e, tok_w, counts, grp); SEAM(PH_ROUTE1); }
            if (IN(PH_ROUTE2)) { for (int rep_ = 0; rep_ < NREP(PH_ROUTE2); ++rep_) for (int grp = bx; grp < M / 64; grp += G) route2_grp((LAS int*)lds, hb, args.in[9] + D, rstd, counts, tok_e, slot, hbp, tilet, grp, bx, G); SEAM(PH_ROUTE2); }
            {
                int nT = 0; if (IN(PH_MUPA) || IN(PH_MDOWNA)) nT = tilet[NTILE_MAX];
                const int nFull = nT < 128 ? nT : 128, nL = nT > 128 ? nT - 128 : 0;
                if (IN(PH_MUPA)) {
                    SchedMoe S{(const char*)hbp, (const char*)(ws + WS_WMGU), tilet, (size_t)256 * D, (size_t)256 * D, (size_t)2 * DFE * D, 0, nT, 2 * DFE / 256, G, bx};
                    for (int rep_ = 0; rep_ < NREP(PH_MUPA); ++rep_) pg8::gemm_phase<ESwiglu8, SchedMoe, true, true, true>(lds, D / 2, D / 2, D / 2, S, ESwiglu8{actp, DFE, W8_INV});
                    SEAM(PH_MUPA);
                }
                if (IN(PH_MDOWNA)) {
                    SchedMoe S{(const char*)actp, (const char*)(ws + WS_WMD), tilet, (size_t)256 * DFE, (size_t)256 * DFE, (size_t)D * DFE, 0, nFull, D / 256, G, bx};
                    for (int rep_ = 0; rep_ < NREP(PH_MDOWNA); ++rep_) pg8::gemm_phase<EBf16, SchedMoe, true, true, true>(lds, DFE / 2, DFE / 2, DFE / 2, S, EBf16{obuf, D, W8_INV, nullptr});
                    SchedMoeK SK{(const char*)actp, (const char*)(ws + WS_WMD), tilet, nL, G, bx};
                    pg8::gemm_phase<ESlab, SchedMoeK, true, true, true>(lds, KSLICE / 2, DFE / 2, DFE / 2, SK, ESlab{(float*)(ws + WS_OBX), W8_INV});
                    SEAM(PH_MDOWNA);
                }
            }
            if (IN(PH_COMBINE)) combine_rows(hb, obuf, (const float*)(ws + WS_OBX), slot, tok_w, args.in[17], args.out, gw, ngw);
        }
    }
#undef IN
}

extern "C" void kernel_launch(void* const* d_in, const int* in_sizes, int n_in, void* d_out, int out_size, void* d_ws, size_t ws_size, hipStream_t stream) {
    (void)in_sizes;
    if (n_in != 18 || out_size != M * D || ws_size < WS_END) { fprintf(stderr, "kernel_launch: unexpected arguments (n_in %d out %d ws %zu)\n", n_in, out_size, ws_size); return; }
    static int grid = 0;
    if (grid == 0) {
        int dev = 0, cus = 0;
        if (hipGetDevice(&dev) != hipSuccess || hipDeviceGetAttribute(&cus, hipDeviceAttributeMultiprocessorCount, dev) != hipSuccess) { fprintf(stderr, "kernel_launch: device query failed\n"); grid = -1; return; }
        if (hipFuncSetAttribute((const void*)mega, hipFuncAttributeMaxDynamicSharedMemorySize, LDS_BYTES) != hipSuccess) { fprintf(stderr, "kernel_launch: hipFuncSetAttribute failed\n"); grid = -1; return; }
        grid = cus;
    }
    if (grid < 0) return;
    Args a{};
    for (int i = 0; i < 18; ++i) a.in[i] = (const float*)d_in[i];
    a.out = (float*)d_out; a.ws = (unsigned char*)d_ws;
#define MEGA(lo_, hi_) do { a.ph_lo = (lo_); a.ph_hi = (hi_); hipLaunchKernelGGL(mega, dim3(grid), dim3(512), LDS_BYTES, stream, a); } while (0)
    if (hipMemsetAsync(d_ws, 0, 65536, stream) != hipSuccess) { fprintf(stderr, "kernel_launch: memset failed\n"); return; }
#if MK_SPLIT
    { const int ph[] = {0, 1, 2, 3, 4, 5, 6, 7, 8, 9, 10, 17, 18, 19, 20, 21, 22, 23, 24, 25, 26, 27, 28, 29}; for (int i = 0; i < 24; ++i) MEGA(ph[i], ph[i] + 1); }
#else
    MEGA(0, PH_END);
#endif
}
```

```cpp
#include <hip/hip_runtime.h>
#include <cstdio>
#include <cstdint>
#include <cstddef>
#ifndef MK_SPLIT
#define MK_SPLIT 0
#endif
#ifndef DUP_PH
#define DUP_PH -1
#endif
#define NREP(k) (((k) == (DUP_PH)) ? 2 : 1)

typedef unsigned short bf16;
#define DEV __device__ __forceinline__

constexpr int D = 1024, BATCH = 8, SEQ = 2048, M = BATCH * SEQ;
constexpr int CC = 512, KW = 256, VW = 512, RANK = 16, NH = 4, DK = 64, DV = 128;
constexpr int IN_COLS = 5136, NW1 = 5120  , PLD = 3584  ;
constexpr int P_U = 0, P_GB = 512, P_Q = 1024, P_K = 1280, P_V = 1536, P_GO = 2048, PB_GA = 5120, PB_GBB = 6144;
constexpr int DFF = 2816, NE = 8, DFE = 3584;
constexpr float EPS = 1e-6f;
constexpr int PERM_ROWS = 2 * M + NE * 256;
constexpr int NTILE_MAX = PERM_ROWS / 256;
constexpr int CHUNK_TILES = 64;
constexpr int KSPLIT = 7, KSLICE = DFE / KSPLIT;

constexpr size_t MiB = 1ull << 20;
constexpr size_t WS_CNT = 1 * MiB;
constexpr size_t WS_TILE = 1 * MiB + 16384;
constexpr size_t WS_TOKE = 1 * MiB + 65536;
constexpr size_t WS_TOKW = WS_TOKE + 131072;
constexpr size_t WS_SLOT = WS_TOKW + 131072;
constexpr size_t WS_RSTD = WS_SLOT + 131072;
constexpr size_t WS_ALOW = 3 * MiB;
constexpr size_t WS_LOGA = 4 * MiB;
constexpr size_t WS_HB = 234 * MiB;
constexpr size_t WS_P = 266 * MiB;
constexpr size_t WS_U = 426 * MiB;
constexpr size_t WS_ACTP = 266 * MiB;
constexpr size_t WS_HBP = 385 * MiB;
constexpr size_t WS_OBUF = 419 * MiB;
constexpr size_t WS_OBX = 4 * MiB;
constexpr size_t WS_END = 489 * MiB;

DEV float bf2f(unsigned v) { return __uint_as_float(v << 16); }
DEV unsigned f2bf(float f) { unsigned u = __float_as_uint(f); return (u + 0x7fffu + ((u >> 16) & 1u)) >> 16; }
DEV unsigned pk2(float lo, float hi) { return f2bf(lo) | (f2bf(hi) << 16); }
DEV float wave_sum(float v) {
#pragma unroll
    for (int o = 1; o < 64; o <<= 1) v += __shfl_xor(v, o);
    return v;
}

DEV float row_rstd(const float* ssq, int row) { return rsqrtf(((ssq[row] + ssq[M + row]) + (ssq[2 * M + row] + ssq[3 * M + row])) * (1.0f / D) + EPS); }
#define LAS __attribute__((address_space(3)))
typedef short bf16x8 __attribute__((ext_vector_type(8)));
typedef float f32x4 __attribute__((ext_vector_type(4)));
typedef float f32x2 __attribute__((ext_vector_type(2)));
typedef unsigned u32x4 __attribute__((ext_vector_type(4)));
typedef unsigned u32x2 __attribute__((ext_vector_type(2)));
DEV unsigned cvt_pk_bf16(float lo, float hi) { unsigned r; asm volatile("v_cvt_pk_bf16_f32 %0, %1, %2" : "=v"(r) : "v"(lo), "v"(hi)); return r; }
DEV float fsig(float x) { return __builtin_amdgcn_rcpf(1.0f + __builtin_amdgcn_exp2f(-1.44269504f * x)); }
DEV float blo(unsigned w) { return __uint_as_float(w << 16); }
DEV float bhi(unsigned w) { return __uint_as_float(w & 0xffff0000u); }

typedef int i32x4 __attribute__((ext_vector_type(4)));
typedef int i32x8 __attribute__((ext_vector_type(8)));
DEV i32x8 cat8(bf16x8 lo, bf16x8 hi) { return __builtin_shufflevector(__builtin_bit_cast(i32x4, lo), __builtin_bit_cast(i32x4, hi), 0, 1, 2, 3, 4, 5, 6, 7); }
DEV unsigned pk4_fp8(float a, float b, float c, float d) { int w = 0; w = __builtin_amdgcn_cvt_pk_fp8_f32(a, b, w, false); w = __builtin_amdgcn_cvt_pk_fp8_f32(c, d, w, true); return (unsigned)w; }
constexpr float W8_SCALE = 64.0f, W8_INV = 1.0f / 64.0f;
namespace pg8 {
constexpr int BM = 256, BK = 64, HALF = 128, HTB = HALF * BK * 2, STAGE_BYTES = 8 * HTB, NXCD = 8, WGM = 8;
__host__ __device__ __forceinline__ int lds_byte(int r, int c) { const int st = (r >> 4) * 2 + (c >> 5), rr = r & 15, cc = c & 31, ob = rr * 64 + cc * 2; return st * 1024 + (ob ^ (((ob >> 9) & 1) << 5)); }
__host__ __device__ __forceinline__ void stage_rc(int b, int& R, int& C) { const int st = b / 1024, sb = b % 1024, swz = sb ^ (((sb >> 9) & 1) << 5); R = (st >> 1) * 16 + swz / 64; C = (st & 1) * 32 + (swz % 64) / 2; }
__host__ __device__ __forceinline__ int perm32(int rho) { const int n = rho >> 4, i = rho & 15; return 8 * (i >> 2) + 4 * n + (i & 3); }

struct Unit { const char* A; const char* B; int pm, pn, aux; };
DEV bool tile_of(int L, int nM, int nN, int& pm, int& pn) {
    const int nwg = nM * nN; if (L >= nwg) return false;
    int wgid = L; { const int q = nwg / NXCD, r = nwg % NXCD, xcd = wgid % NXCD, off = wgid / NXCD; wgid = (xcd < r ? xcd * (q + 1) : r * (q + 1) + (xcd - r) * q) + off; }
    const int nig = WGM * nN, gid = wgid / nig, fm = gid * WGM, gsz = (nM - fm) < WGM ? (nM - fm) : WGM;
    pm = fm + ((wgid % nig) % gsz); pn = (wgid % nig) / gsz; return true;
}

template <class Epi, class Sched, bool ALIGN_EPI, bool SP2, bool FP8 = false>
DEV void gemm_phase(LAS unsigned char* lds, const int K, const int lda, const int ldb, const Sched& S, const Epi& E) {
    int tid_ = threadIdx.x; asm volatile("" : "+v"(tid_));
    const int tid = tid_, wid = __builtin_amdgcn_readfirstlane(tid >> 6), lane = tid & 63, wr = wid >> 2, wc = wid & 3, fr = lane & 15, fq = lane >> 4;
    const int nt = K / BK;
    unsigned voffA[2], voffB[2];
#pragma unroll
    for (int i = 0; i < 2; ++i) { int R, C; stage_rc(tid * 16 + i * 8192, R, C); const int Rb = Epi::PERM ? ((R & ~31) + perm32(R & 31)) : R;
        voffA[i] = (unsigned)(R * lda + C) * 2u; voffB[i] = (unsigned)(Rb * ldb + C) * 2u; }
    const size_t kstep = (size_t)(BK * 2);
    const size_t hstepA = (size_t)HALF * lda * 2, hstepB = (size_t)HALF * ldb * 2;
    const unsigned ldsw = (unsigned)wid * 1024u;
    const int aoff = FP8 ? lds_byte(wr * 64 + fr, fq * 16) : lds_byte(wr * 64 + fr, fq * 8), boff = FP8 ? lds_byte(wc * 32 + fr, fq * 16) : lds_byte(wc * 32 + fr, fq * 8);

#define PG8_SA(b, h) (((b) * 2 + (h)) * HTB)
#define PG8_SB(b, h) ((4 + (b) * 2 + (h)) * HTB)
#define PG8_STAGE(bufoff, gbase, voff) do { _Pragma("unroll") for (int _i = 0; _i < 2; ++_i) \
        __builtin_amdgcn_global_load_lds((const unsigned*)((const char*)(gbase) + (voff)[_i]), (LAS unsigned*)(lds + (bufoff) + ldsw + _i * 8192), 16, 0, 0); } while (0)
#define PG8_RD(off) (*(const LAS bf16x8*)(lds + (off)))
#define PG8_LDA(dst, b, h) do { if constexpr (FP8) { _Pragma("unroll") for (int m = 0; m < 4; ++m) dst##8[m] = cat8(PG8_RD(PG8_SA(b, h) + aoff + m * 2048), PG8_RD(PG8_SA(b, h) + aoff + m * 2048 + 16)); } \
        else { _Pragma("unroll") for (int m = 0; m < 4; ++m) _Pragma("unroll") for (int k = 0; k < 2; ++k) dst[m][k] = PG8_RD(PG8_SA(b, h) + aoff + m * 2048 + k * 1024); } } while (0)
#define PG8_LDB(dst, b, h) do { if constexpr (FP8) { _Pragma("unroll") for (int n = 0; n < 2; ++n) dst##8[n] = cat8(PG8_RD(PG8_SB(b, h) + boff + n * 2048), PG8_RD(PG8_SB(b, h) + boff + n * 2048 + 16)); } \
        else { _Pragma("unroll") for (int n = 0; n < 2; ++n) _Pragma("unroll") for (int k = 0; k < 2; ++k) dst[n][k] = PG8_RD(PG8_SB(b, h) + boff + n * 2048 + k * 1024); } } while (0)
#define PG8_MMA(ai, bj, At, Bt) do { __builtin_amdgcn_s_setprio(1); _Pragma("unroll") for (int m = 0; m < 4; ++m) _Pragma("unroll") for (int n = 0; n < 2; ++n) { \
        if constexpr (FP8) asm volatile("v_mfma_scale_f32_16x16x128_f8f6f4 %0, %1, %2, %0, %3, %3 op_sel_hi:[0,0,0]" : "+v"(acc[ai][bj][m][n]) : "v"(Bt##8[n]), "v"(At##8[m]), "v"(one8)); \
        else { _Pragma("unroll") for (int k = 0; k < 2; ++k) acc[ai][bj][m][n] = __builtin_amdgcn_mfma_f32_16x16x32_bf16(Bt[n][k], At[m][k], acc[ai][bj][m][n], 0, 0, 0); } } __builtin_amdgcn_s_setprio(0); } while (0)
#define PG8_WAIT_V(n) asm volatile("s_waitcnt vmcnt(" #n ")" ::: "memory")
#define PG8_WAIT_L(n) asm volatile("s_waitcnt lgkmcnt(" #n ")" ::: "memory")
#define PG8_BAR __builtin_amdgcn_s_barrier()
#define PG8_SCHED __builtin_amdgcn_sched_barrier(0)
    Unit cur, nxt; int ui = 0;
    if (!S.next(0, cur)) return;
    f32x4 acc[2][2][4][2];
#pragma unroll
    for (int a = 0; a < 2; ++a)
#pragma unroll
        for (int b = 0; b < 2; ++b)
#pragma unroll
            for (int m = 0; m < 4; ++m)
#pragma unroll
                for (int n = 0; n < 2; ++n) acc[a][b][m][n] = (f32x4){0.f, 0.f, 0.f, 0.f};
    const int one8 = 0x7F7F7F7F;
    bf16x8 At[4][2], B0[2][2], B1[2][2]; i32x8 At8[4], B08[2], B18[2];
    const char* cA = cur.A; const char* cB = cur.B;
    if constexpr (SP2) {
        PG8_STAGE(PG8_SB(0, 0), cB, voffB); PG8_STAGE(PG8_SB(0, 1), cB + hstepB, voffB); PG8_STAGE(PG8_SA(0, 0), cA, voffA); PG8_STAGE(PG8_SA(0, 1), cA + hstepA, voffA);
        if (wr == 1) PG8_BAR;
        PG8_WAIT_V(2); PG8_BAR;
        PG8_STAGE(PG8_SB(1, 0), cB + kstep, voffB); PG8_STAGE(PG8_SA(1, 0), cA + kstep, voffA); PG8_STAGE(PG8_SB(1, 1), cB + hstepB + kstep, voffB);
        PG8_WAIT_V(6); PG8_BAR;
    } else {
        PG8_STAGE(PG8_SB(0, 0), cB, voffB); PG8_STAGE(PG8_SA(0, 0), cA, voffA); PG8_STAGE(PG8_SB(0, 1), cB + hstepB, voffB); PG8_STAGE(PG8_SA(0, 1), cA + hstepA, voffA);
        if (wr == 1) PG8_BAR;
        PG8_WAIT_V(4); PG8_BAR;
        PG8_STAGE(PG8_SB(1, 0), cB + kstep, voffB); PG8_STAGE(PG8_SA(1, 0), cA + kstep, voffA); PG8_STAGE(PG8_SB(1, 1), cB + hstepB + kstep, voffB);
        PG8_WAIT_V(6); PG8_BAR;
    }
    for (;;) {
        const bool has_next = S.next(ui + 1, nxt);
        const char* nA = has_next ? nxt.A : cA; const char* nB = has_next ? nxt.B : cB;
#pragma nounroll
        for (int t = 0; t < nt; t += 2) {
            const bool last = (t == nt - 2);
            const char* a1 = cA + (size_t)(t + 1) * kstep;
            const char* a2 = last ? nA : cA + (size_t)(t + 2) * kstep; const char* b2 = last ? nB : cB + (size_t)(t + 2) * kstep;
            const char* a3 = a2 + kstep; const char* b3 = b2 + kstep;
            if constexpr (SP2) {
            PG8_LDB(B0, 0, 0); PG8_LDB(B1, 0, 1); PG8_SCHED; PG8_LDA(At, 0, 0); PG8_STAGE(PG8_SA(1, 1), a1 + hstepA, voffA);
            PG8_WAIT_V(8); PG8_WAIT_L(0); PG8_BAR; PG8_MMA(0, 0, At, B0); PG8_MMA(0, 1, At, B1); PG8_BAR; PG8_SCHED;
            PG8_LDA(At, 0, 1); PG8_STAGE(PG8_SB(0, 0), b2, voffB); PG8_STAGE(PG8_SB(0, 1), b2 + hstepB, voffB); PG8_STAGE(PG8_SA(0, 0), a2, voffA);
            PG8_WAIT_V(8); PG8_WAIT_L(0); PG8_BAR; PG8_MMA(1, 0, At, B0); PG8_MMA(1, 1, At, B1); PG8_BAR; PG8_SCHED;
            PG8_LDB(B0, 1, 0); PG8_LDB(B1, 1, 1); PG8_SCHED; PG8_LDA(At, 1, 0); PG8_STAGE(PG8_SA(0, 1), a2 + hstepA, voffA);
            PG8_WAIT_V(8); PG8_WAIT_L(0); PG8_BAR; PG8_MMA(0, 0, At, B0); PG8_MMA(0, 1, At, B1); PG8_BAR; PG8_SCHED;
            PG8_LDA(At, 1, 1); PG8_STAGE(PG8_SB(1, 0), b3, voffB); PG8_STAGE(PG8_SB(1, 1), b3 + hstepB, voffB); PG8_STAGE(PG8_SA(1, 0), a3, voffA);
            PG8_WAIT_V(8); PG8_WAIT_L(0); PG8_BAR; PG8_MMA(1, 0, At, B0); PG8_MMA(1, 1, At, B1); PG8_BAR; PG8_SCHED;
            } else {
            PG8_LDB(B0, 0, 0); PG8_SCHED; PG8_LDA(At, 0, 0); PG8_STAGE(PG8_SA(1, 1), a1 + hstepA, voffA);
            PG8_WAIT_L(8); PG8_BAR; PG8_WAIT_L(0); PG8_MMA(0, 0, At, B0); PG8_BAR; PG8_SCHED;
            PG8_LDB(B1, 0, 1); PG8_STAGE(PG8_SB(0, 0), b2, voffB);
            PG8_BAR; PG8_WAIT_L(0); PG8_MMA(0, 1, At, B1); PG8_BAR;
            PG8_LDA(At, 0, 1); PG8_STAGE(PG8_SA(0, 0), a2, voffA);
            PG8_BAR; PG8_WAIT_L(0); PG8_MMA(1, 0, At, B0); PG8_BAR; PG8_SCHED;
            PG8_STAGE(PG8_SB(0, 1), b2 + hstepB, voffB);
            PG8_WAIT_V(6); PG8_BAR; PG8_MMA(1, 1, At, B1); PG8_BAR;
            PG8_LDB(B0, 1, 0); PG8_SCHED; PG8_LDA(At, 1, 0); PG8_STAGE(PG8_SA(0, 1), a2 + hstepA, voffA);
            PG8_WAIT_L(8); PG8_BAR; PG8_WAIT_L(0); PG8_MMA(0, 0, At, B0); PG8_BAR; PG8_SCHED;
            PG8_LDB(B1, 1, 1); PG8_STAGE(PG8_SB(1, 0), b3, voffB);
            PG8_BAR; PG8_WAIT_L(0); PG8_MMA(0, 1, At, B1); PG8_BAR;
            PG8_LDA(At, 1, 1); PG8_STAGE(PG8_SA(1, 0), a3, voffA);
            PG8_BAR; PG8_WAIT_L(0); PG8_MMA(1, 0, At, B0); PG8_BAR; PG8_SCHED;
            PG8_STAGE(PG8_SB(1, 1), b3 + hstepB, voffB);
            PG8_WAIT_V(6); PG8_BAR; PG8_MMA(1, 1, At, B1); PG8_BAR;
            }
        }
        if constexpr (ALIGN_EPI) { if (wr == 0) PG8_BAR; }
        if constexpr (FP8) asm volatile("s_nop 15\n\ts_nop 15" ::: "memory");
        E(acc, cur, wr, wc, fr, fq);
        if (!has_next) break;
#pragma unroll
        for (int a = 0; a < 2; ++a)
#pragma unroll
            for (int b = 0; b < 2; ++b)
#pragma unroll
                for (int m = 0; m < 4; ++m)
#pragma unroll
                    for (int n = 0; n < 2; ++n) acc[a][b][m][n] = (f32x4){0.f, 0.f, 0.f, 0.f};
        cur = nxt; cA = nA; cB = nB; ++ui;
        if constexpr (ALIGN_EPI) { if (wr == 1) PG8_BAR; }
    }
    PG8_WAIT_V(0);
    if constexpr (!ALIGN_EPI) { if (wr == 0) PG8_BAR; }
    PG8_BAR;
#undef PG8_SA
#undef PG8_SB
#undef PG8_STAGE
#undef PG8_LDA
#undef PG8_RD
#undef PG8_LDB
#undef PG8_MMA
#undef PG8_WAIT_V
#undef PG8_WAIT_L
#undef PG8_BAR
#undef PG8_SCHED
}
}
using pg8::Unit;

struct SchedGrid { const char* A; const char* B; size_t astep, bstep; int nM, nN, G, c;
    DEV bool next(int i, Unit& u) const { int pm, pn; if (!pg8::tile_of(i * G + c, nM, nN, pm, pn)) return false; u.A = A + (size_t)pm * astep; u.B = B + (size_t)pn * bstep; u.pm = pm; u.pn = pn; u.aux = i; return true; } };
struct SchedPair { const char* A0; const char* A1; const char* B0; const char* B1; size_t astep, bstep; int nM, nN, G, c;
    DEV bool next(int i, Unit& u) const { int pm, pn; if (!pg8::tile_of((i >> 1) * G + c, nM, nN, pm, pn)) return false; const int br = i & 1; u.A = (br ? A1 : A0) + (size_t)pm * astep; u.B = (br ? B1 : B0) + (size_t)pn * bstep; u.pm = pm; u.pn = pn; u.aux = br; return true; } };
struct SchedMoe { const char* A; const char* B; const int* tile_e; size_t astep, bstep, estep; int t0, nM, nN, G, c;
    DEV bool next(int i, Unit& u) const { int pm, pn; if (!pg8::tile_of(i * G + c, nM, nN, pm, pn)) return false; const int e = tile_e[t0 + pm]; u.A = A + (size_t)pm * astep; u.B = B + (size_t)e * estep + (size_t)pn * bstep; u.pm = pm; u.pn = pn; u.aux = e; return true; } };

struct SchedMoeK { const char* A; const char* B; const int* tile_e; int nL, G, c;
    DEV bool next(int i, Unit& u) const { const int L = i * G + c; if (L >= nL * 4 * KSPLIT) return false; const int ks = L % KSPLIT, pn = (L / KSPLIT) & 3, lt = L / (4 * KSPLIT); const int e = tile_e[128 + lt];
        u.A = A + ((size_t)(128 + lt) * 256 * DFE + (size_t)ks * KSLICE); u.B = B + ((size_t)e * D * DFE + (size_t)pn * 256 * DFE + (size_t)ks * KSLICE);     u.pm = lt; u.pn = pn; u.aux = ks; return true; } };
template <class Sched> DEV void fill_rstd(LAS float* R, const Sched& S, const float* ssq) {
    int t = threadIdx.x; asm volatile("" : "+v"(t)); Unit u;
    for (int i = 0; i < 8 && S.next(i, u); ++i) if (t < 256) R[i * 256 + t] = row_rstd(ssq, u.pm * 256 + t);
    __syncthreads();
}
typedef const f32x4 (&AccRef)[2][2][4][2];
template <bool RS> struct EBf16T { static constexpr bool PERM = true; bf16* O; int ldc; float sc; const LAS float* R;
    DEV void operator()(AccRef acc, const Unit& u, int wr, int wc, int fr, int fq) const {
        const int row0 = u.pm * 256 + wr * 64 + fr, col0 = u.pn * 256 + wc * 32 + 8 * fq;
        float rsv[2][4];
#pragma unroll
        for (int ai = 0; ai < 2; ++ai)
#pragma unroll
            for (int m = 0; m < 4; ++m) rsv[ai][m] = RS ? sc * R[u.aux * 256 + ai * 128 + wr * 64 + m * 16 + fr] : sc;
#pragma unroll
        for (int ai = 0; ai < 2; ++ai)
#pragma unroll
            for (int m = 0; m < 4; ++m) { const int row = row0 + ai * 128 + m * 16; bf16* rowp = O + (size_t)row * ldc + col0; const float rs = rsv[ai][m];
#pragma unroll
                for (int bj = 0; bj < 2; ++bj) { const f32x4 v0 = acc[ai][bj][m][0] * rs, v1 = acc[ai][bj][m][1] * rs; u32x4 w; w.x = cvt_pk_bf16(v0[0], v0[1]); w.y = cvt_pk_bf16(v0[2], v0[3]); w.z = cvt_pk_bf16(v1[0], v1[1]); w.w = cvt_pk_bf16(v1[2], v1[3]);
                    *(u32x4*)(rowp + bj * 128) = w; } }
    } };
typedef EBf16T<false> EBf16;
struct EG1 { static constexpr bool PERM = true; bf16* p; const LAS float* R;
    DEV void operator()(AccRef acc, const Unit& u, int wr, int wc, int fr, int fq) const {
        const int row0 = u.pm * 256 + wr * 64 + fr, c8 = wc * 32 + 8 * fq;
        float rsv[2][4];
#pragma unroll
        for (int ai = 0; ai < 2; ++ai)
#pragma unroll
            for (int m = 0; m < 4; ++m) rsv[ai][m] = R[u.aux * 256 + ai * 128 + wr * 64 + m * 16 + fr];
        if (u.pn < 4) {
#pragma unroll
            for (int ai = 0; ai < 2; ++ai)
#pragma unroll
                for (int m = 0; m < 4; ++m) { const float r2 = rsv[ai][m] * rsv[ai][m]; const f32x4 a0 = acc[ai][0][m][0], a1 = acc[ai][0][m][1], g0 = acc[ai][1][m][0] * r2, g1 = acc[ai][1][m][1] * r2;
                    u32x4 w; w.x = cvt_pk_bf16(a0[0] * g0[0], a0[1] * g0[1]); w.y = cvt_pk_bf16(a0[2] * g0[2], a0[3] * g0[3]); w.z = cvt_pk_bf16(a1[0] * g1[0], a1[1] * g1[1]); w.w = cvt_pk_bf16(a1[2] * g1[2], a1[3] * g1[3]);
                    *(u32x4*)(p + (size_t)(row0 + ai * 128 + m * 16) * PLD + P_U + 128 * u.pn + c8) = w; }
        } else if (u.pn < 12) {
            const int colt = P_GB + 256 * (u.pn - 4) + c8;
#pragma unroll
            for (int ai = 0; ai < 2; ++ai)
#pragma unroll
                for (int m = 0; m < 4; ++m) { const float rs = rsv[ai][m]; bf16* rowp = p + (size_t)(row0 + ai * 128 + m * 16) * PLD + colt;
#pragma unroll
                    for (int bj = 0; bj < 2; ++bj) { const f32x4 v0 = acc[ai][bj][m][0] * rs, v1 = acc[ai][bj][m][1] * rs; u32x4 w; w.x = cvt_pk_bf16(v0[0], v0[1]); w.y = cvt_pk_bf16(v0[2], v0[3]); w.z = cvt_pk_bf16(v1[0], v1[1]); w.w = cvt_pk_bf16(v1[2], v1[3]);
                        *(u32x4*)(rowp + bj * 128) = w; } }
        } else {
            const int bofs = PB_GA + 256 * (u.pn - 12) + c8;
#pragma unroll
            for (int ai = 0; ai < 2; ++ai)
#pragma unroll
                for (int m = 0; m < 4; ++m) { const float rs = rsv[ai][m]; unsigned char* rowb = (unsigned char*)(p + (size_t)(row0 + ai * 128 + m * 16) * PLD) + bofs;
#pragma unroll
                    for (int bj = 0; bj < 2; ++bj) { const f32x4 v0 = acc[ai][bj][m][0] * rs, v1 = acc[ai][bj][m][1] * rs;
                        unsigned q[8] = {(unsigned)(fsig(v0[0]) * 255.0f + 0.5f), (unsigned)(fsig(v0[1]) * 255.0f + 0.5f), (unsigned)(fsig(v0[2]) * 255.0f + 0.5f), (unsigned)(fsig(v0[3]) * 255.0f + 0.5f),
                                         (unsigned)(fsig(v1[0]) * 255.0f + 0.5f), (unsigned)(fsig(v1[1]) * 255.0f + 0.5f), (unsigned)(fsig(v1[2]) * 255.0f + 0.5f), (unsigned)(fsig(v1[3]) * 255.0f + 0.5f)};
                        u32x2 w; w.x = q[0] | (q[1] << 8) | (q[2] << 16) | (q[3] << 24); w.y = q[4] | (q[5] << 8) | (q[6] << 16) | (q[7] << 24);
                        *(u32x2*)(rowb + bj * 128) = w; } }
        }
    } };
struct EMerge { static constexpr bool PERM = true; bf16* mg; const bf16* p;
    DEV void operator()(AccRef acc, const Unit& u, int wr, int wc, int fr, int fq) const {
        const int row0 = u.pm * 256 + wr * 64 + fr, col0 = u.pn * 256 + wc * 32 + 8 * fq; const int gofs = u.aux ? PB_GBB : PB_GA;
#pragma unroll
        for (int ai = 0; ai < 2; ++ai) {
            u32x2 gt[4][2]; u32x4 od[4][2];
#pragma unroll
            for (int m = 0; m < 4; ++m)
#pragma unroll
                for (int bj = 0; bj < 2; ++bj) { const size_t row = (size_t)(row0 + ai * 128 + m * 16); const int col = col0 + bj * 128;
                    gt[m][bj] = *(const u32x2*)((const unsigned char*)(p + row * PLD) + gofs + col); od[m][bj] = u.aux ? *(const u32x4*)(mg + row * D + col) : (u32x4){0u, 0u, 0u, 0u}; }
#pragma unroll
            for (int m = 0; m < 4; ++m)
#pragma unroll
                for (int bj = 0; bj < 2; ++bj) { const size_t row = (size_t)(row0 + ai * 128 + m * 16); const int col = col0 + bj * 128; const u32x2 g = gt[m][bj]; const u32x4 o = od[m][bj];
                    const f32x4 v0 = acc[ai][bj][m][0] * (1.0f / 255.0f), v1 = acc[ai][bj][m][1] * (1.0f / 255.0f);
                    u32x4 w; w.x = cvt_pk_bf16((float)(g.x & 0xffu) * v0[0] + blo(o.x), (float)((g.x >> 8) & 0xffu) * v0[1] + bhi(o.x)); w.y = cvt_pk_bf16((float)((g.x >> 16) & 0xffu) * v0[2] + blo(o.y), (float)(g.x >> 24) * v0[3] + bhi(o.y));
                    w.z = cvt_pk_bf16((float)(g.y & 0xffu) * v1[0] + blo(o.z), (float)((g.y >> 8) & 0xffu) * v1[1] + bhi(o.z)); w.w = cvt_pk_bf16((float)((g.y >> 16) & 0xffu) * v1[2] + blo(o.w), (float)(g.y >> 24) * v1[3] + bhi(o.w));
                    *(u32x4*)(mg + row * D + col) = w; }
        }
    } };
template <bool STATS> struct EResT { static constexpr bool PERM = true; bf16* xb; float* ssq; LAS float* P;
    DEV void operator()(AccRef acc, const Unit& u, int wr, int wc, int fr, int fq) const {
        const int row0 = u.pm * 256 + wr * 64 + fr, col0 = u.pn * 256 + wc * 32 + 8 * fq;
#pragma unroll
        for (int ai = 0; ai < 2; ++ai) {
        u32x4 xo[4][2];
#pragma unroll
            for (int m = 0; m < 4; ++m)
#pragma unroll
                for (int bj = 0; bj < 2; ++bj) xo[m][bj] = *(const u32x4*)(xb + (size_t)(row0 + ai * 128 + m * 16) * D + col0 + bj * 128);
#pragma unroll
            for (int m = 0; m < 4; ++m) { bf16* rowp = xb + (size_t)(row0 + ai * 128 + m * 16) * D + col0; float sq = 0.f;
#pragma unroll
                for (int bj = 0; bj < 2; ++bj) { const u32x4 o = xo[m][bj]; const f32x4 a0 = acc[ai][bj][m][0], a1 = acc[ai][bj][m][1];
                    u32x4 w; w.x = cvt_pk_bf16(blo(o.x) + a0[0], bhi(o.x) + a0[1]); w.y = cvt_pk_bf16(blo(o.y) + a0[2], bhi(o.y) + a0[3]); w.z = cvt_pk_bf16(blo(o.z) + a1[0], bhi(o.z) + a1[1]); w.w = cvt_pk_bf16(blo(o.w) + a1[2], bhi(o.w) + a1[3]);
                    *(u32x4*)(rowp + bj * 128) = w;
                    if (STATS) sq += (blo(w.x) * blo(w.x) + bhi(w.x) * bhi(w.x)) + (blo(w.y) * blo(w.y) + bhi(w.y) * bhi(w.y)) + (blo(w.z) * blo(w.z) + bhi(w.z) * bhi(w.z)) + (blo(w.w) * blo(w.w) + bhi(w.w) * bhi(w.w)); }
                if (STATS) { sq += __shfl_xor(sq, 16); sq += __shfl_xor(sq, 32);
                    if (fq == 0) P[(ai * 128 + wr * 64 + m * 16 + fr) * 4 + wc] = sq; } } }
        if (!STATS) return;
        asm volatile("s_waitcnt lgkmcnt(0)" ::: "memory"); __builtin_amdgcn_s_barrier(); asm volatile("" ::: "memory");
        const int t = wr * 256 + wc * 64 + fq * 16 + fr;
        if (t < 256) ssq[(size_t)u.pn * M + u.pm * 256 + t] = (P[t * 4] + P[t * 4 + 1]) + (P[t * 4 + 2] + P[t * 4 + 3]);
    } };
typedef EResT<true> ERes;
struct ESlab { static constexpr bool PERM = false; float* obx; float sc;
    DEV void operator()(AccRef acc, const Unit& u, int wr, int wc, int fr, int fq) const {
        const int row0 = u.pm * 256 + wr * 64 + fr, col0 = u.pn * 256 + wc * 32 + 4 * fq; float* base = obx + (size_t)u.aux * 2048 * D;
#pragma unroll
        for (int ai = 0; ai < 2; ++ai)
#pragma unroll
            for (int m = 0; m < 4; ++m) { const size_t off = (size_t)(row0 + ai * 128 + m * 16) * D + col0;
#pragma unroll
                for (int bj = 0; bj < 2; ++bj)
#pragma unroll
                    for (int n = 0; n < 2; ++n) *(f32x4*)(base + off + bj * 128 + n * 16) = acc[ai][bj][m][n] * sc; }
    } };
struct ESwiglu8 { static constexpr bool PERM = true; unsigned char* act; int ld; float sc;
    DEV void operator()(AccRef acc, const Unit& u, int wr, int wc, int fr, int fq) const {
        const int row0 = u.pm * 256 + wr * 64 + fr, col0 = u.pn * 128 + wc * 32 + 8 * fq;
#pragma unroll
        for (int ai = 0; ai < 2; ++ai)
#pragma unroll
            for (int m = 0; m < 4; ++m) { const f32x4 g0 = acc[ai][0][m][0] * sc, g1 = acc[ai][0][m][1] * sc, u0 = acc[ai][1][m][0] * sc, u1 = acc[ai][1][m][1] * sc;
                u32x2 w; w.x = pk4_fp8(g0[0] * fsig(g0[0]) * u0[0], g0[1] * fsig(g0[1]) * u0[1], g0[2] * fsig(g0[2]) * u0[2], g0[3] * fsig(g0[3]) * u0[3]);
                w.y = pk4_fp8(g1[0] * fsig(g1[0]) * u1[0], g1[1] * fsig(g1[1]) * u1[1], g1[2] * fsig(g1[2]) * u1[2], g1[3] * fsig(g1[3]) * u1[3]);
                *(u32x2*)(act + (size_t)(row0 + ai * 128 + m * 16) * ld + col0) = w; }
    } };
struct ESwiglu { static constexpr bool PERM = true; bf16* act; int ld; const LAS float* R;
    DEV void operator()(AccRef acc, const Unit& u, int wr, int wc, int fr, int fq) const {
        const int row0 = u.pm * 256 + wr * 64 + fr, col0 = u.pn * 128 + wc * 32 + 8 * fq;
        float rsv[2][4];
#pragma unroll
        for (int ai = 0; ai < 2; ++ai)
#pragma unroll
            for (int m = 0; m < 4; ++m) rsv[ai][m] = R[u.aux * 256 + ai * 128 + wr * 64 + m * 16 + fr];
#pragma unroll
        for (int ai = 0; ai < 2; ++ai)
#pragma unroll
            for (int m = 0; m < 4; ++m) { const float rs = rsv[ai][m]; const f32x4 g0 = acc[ai][0][m][0] * rs, g1 = acc[ai][0][m][1] * rs, u0 = acc[ai][1][m][0] * rs, u1 = acc[ai][1][m][1] * rs;
                u32x4 w; w.x = cvt_pk_bf16(g0[0] * fsig(g0[0]) * u0[0], g0[1] * fsig(g0[1]) * u0[1]); w.y = cvt_pk_bf16(g0[2] * fsig(g0[2]) * u0[2], g0[3] * fsig(g0[3]) * u0[3]);
                w.z = cvt_pk_bf16(g1[0] * fsig(g1[0]) * u1[0], g1[1] * fsig(g1[1]) * u1[1]); w.w = cvt_pk_bf16(g1[2] * fsig(g1[2]) * u1[2], g1[3] * fsig(g1[3]) * u1[3]);
                *(u32x4*)(act + (size_t)(row0 + ai * 128 + m * 16) * ld + col0) = w; }
    } };

#define XB_TMO      128
#define XB_XCNT(j)  (256  + 64 * (j))
#define XB_XSUB(j)  (1280 + 64 * (j))
#define XB_XGEN(j)  (2304 + 64 * (j))
#define XB_TOP      3328
#define XB_TOPGEN   3392
#define XCD_BAR_WORDS 3456
#define XB_SPIN_CAP (1u << 18)
__device__ __forceinline__ unsigned xb_ld(unsigned* p)              { return __hip_atomic_load(p, __ATOMIC_RELAXED, __HIP_MEMORY_SCOPE_AGENT); }
__device__ __forceinline__ unsigned xb_add(unsigned* p, unsigned v) { return __hip_atomic_fetch_add(p, v, __ATOMIC_RELAXED, __HIP_MEMORY_SCOPE_AGENT); }
__device__ __forceinline__ unsigned xb_xcc_id() { return (unsigned)__builtin_amdgcn_s_getreg((3 << 11) | 20) & 0xFu; }
#define XB_SPIN(cond, bar) do { unsigned _sp = 0; while (cond) { __builtin_amdgcn_s_sleep(1); \
    if ((++_sp & 255u) == 0u) { if (xb_ld(&(bar)[XB_TMO])) break; if (_sp > XB_SPIN_CAP) { atomicAdd(&(bar)[XB_TMO], 1u); break; } } } } while (0)
struct XcdBarrier { unsigned* bar; unsigned x; volatile LAS unsigned* st; };
__device__ __forceinline__ XcdBarrier xcd_barrier_post(unsigned* bar, volatile LAS unsigned* st) {
    XcdBarrier b; b.bar = bar; b.x = xb_xcc_id(); b.st = st;
    if (threadIdx.x == 0) (void)xb_add(&bar[XB_XCNT(b.x)], 1u);
    return b;
}
__device__ __forceinline__ void xcd_barrier_complete(unsigned* bar, unsigned x, unsigned& nloc, unsigned& nx) {
    const unsigned G = gridDim.x * gridDim.y * gridDim.z;
    unsigned sum, cnt, mine, sp = 0u;
    for (;;) {
        sum = 0u; cnt = 0u; mine = 0u;
#pragma unroll
        for (unsigned j = 0; j < 16; ++j) { const unsigned c = xb_ld(&bar[XB_XCNT(j)]); sum += c; cnt += (c > 0u) ? 1u : 0u; mine = (j == x) ? c : mine; }
        if (sum == G) break;
        __builtin_amdgcn_s_sleep(1);
        if ((++sp & 255u) == 0u) { if (xb_ld(&bar[XB_TMO])) break; if (sp > XB_SPIN_CAP) { atomicAdd(&bar[XB_TMO], 1u); break; } }
    }
    nloc = mine > 0u ? mine : 1u; nx = cnt > 0u ? cnt : 1u;
}
__device__ __forceinline__ void xcd_barrier(const XcdBarrier& b) {
    asm volatile("s_waitcnt vmcnt(0)" ::: "memory");
    __syncthreads();
    if (threadIdx.x == 0) {
        unsigned* bar = b.bar;
        __builtin_amdgcn_s_waitcnt(0);
        unsigned nloc = b.st[0], nx = b.st[1];
        if (nloc == 0u) { xcd_barrier_complete(bar, b.x, nloc, nx); b.st[0] = nloc; b.st[1] = nx; }
        const unsigned old = xb_add(&bar[XB_XSUB(b.x)], 1u);
        const unsigned gen = old / nloc;
        if (old + 1u == (gen + 1u) * nloc) {
            __builtin_amdgcn_fence(__ATOMIC_RELEASE, "agent");
            asm volatile("s_waitcnt vmcnt(0)" ::: "memory");
            const unsigned og = xb_add(&bar[XB_TOP], 1u);
            const unsigned tg = og / nx;
            if (og + 1u == (tg + 1u) * nx) xb_add(&bar[XB_TOPGEN], 1u);
            else XB_SPIN(xb_ld(&bar[XB_TOPGEN]) == tg, bar);
            __builtin_amdgcn_fence(__ATOMIC_ACQUIRE, "agent");
            xb_add(&bar[XB_XGEN(b.x)], 1u);
            asm volatile("s_waitcnt vmcnt(0)" ::: "memory");
        } else {
            XB_SPIN(xb_ld(&bar[XB_XGEN(b.x)]) == gen, bar);
            __builtin_amdgcn_fence(__ATOMIC_ACQUIRE, "agent");
            asm volatile("s_waitcnt vmcnt(0)" ::: "memory");
        }
    }
    __syncthreads();
}

constexpr size_t WS_WIN = 20 * MiB;
constexpr size_t WS_WA = 40 * MiB;
constexpr size_t WS_WBR = 41 * MiB;
constexpr size_t WS_WOUT = 45 * MiB;
constexpr size_t WS_WFGU = 49 * MiB;
constexpr size_t WS_WFD = 60 * MiB;
constexpr size_t WS_WMGU = 66 * MiB;
constexpr size_t WS_WMD = 178 * MiB;
constexpr size_t WS_BAR = 4096;
constexpr int RING_BYTES = 131072, MISC_OFF = RING_BYTES + 320, PSTAT_OFF = RING_BYTES + 1024  , RSTD_OFF = RING_BYTES + 6144  , LDS_BYTES = 147456;

template <bool GAIN>
DEV void cvt_item_t(const float* W, int ldw, int k0, int n0, bf16* dst, int Kd, LAS float* scr, int lane, const float* gain) {
    const int c = lane & 7;
    f32x4 g0 = {1.f, 1.f, 1.f, 1.f}, g1 = g0;
    if (GAIN) { g0 = *(const f32x4*)(gain + k0 + 8 * c); g1 = *(const f32x4*)(gain + k0 + 8 * c + 4); }
#pragma unroll
    for (int i = 0; i < 32; ++i) { const int kk = 2 * i + (lane >> 5); scr[kk * 33 + (lane & 31)] = W[(size_t)(k0 + kk) * ldw + n0 + (lane & 31)]; }
    asm volatile("s_waitcnt lgkmcnt(0)" ::: "memory");
#pragma unroll
    for (int j = 0; j < 4; ++j) { const int n = (lane >> 3) + 8 * j; const LAS float* s = scr + (8 * c) * 33 + n;
        u32x4 o; o.x = pk2(s[0 * 33] * g0[0], s[1 * 33] * g0[1]); o.y = pk2(s[2 * 33] * g0[2], s[3 * 33] * g0[3]); o.z = pk2(s[4 * 33] * g1[0], s[5 * 33] * g1[1]); o.w = pk2(s[6 * 33] * g1[2], s[7 * 33] * g1[3]);
        *(u32x4*)(dst + (size_t)n * Kd + 8 * c) = o; }
    asm volatile("s_waitcnt lgkmcnt(0)" ::: "memory");
}
DEV void cvt_item(const float* W, int ldw, int k0, int n0, bf16* dst, int Kd, LAS float* scr, int lane) { cvt_item_t<false>(W, ldw, k0, n0, dst, Kd, scr, lane, nullptr); }
DEV void cvt_item_g(const float* W, int ldw, int k0, int n0, bf16* dst, int Kd, LAS float* scr, int lane, const float* gain) { cvt_item_t<true>(W, ldw, k0, n0, dst, Kd, scr, lane, gain); }


DEV float4 ldx4(const bf16* row, int idx) { const uint2 t = ((const uint2*)row)[idx]; return make_float4(__uint_as_float(t.x << 16), __uint_as_float(t.x & 0xffff0000u), __uint_as_float(t.y << 16), __uint_as_float(t.y & 0xffff0000u)); }
DEV int otid() { int t = threadIdx.x; asm volatile("" : "+v"(t)); return t; }
typedef float f32x16 __attribute__((ext_vector_type(16)));
typedef __bf16 bf16x2_t __attribute__((ext_vector_type(2)));
DEV unsigned pkbf(float lo, float hi) { const f32x2 v = {lo, hi}; return __builtin_bit_cast(unsigned, __builtin_convertvector(v, bf16x2_t)); }
#define MFMA32(a, b, c) __builtin_amdgcn_mfma_f32_32x32x16_bf16((a), (b), (c), 0, 0, 0)
DEV int crow(int reg, int h) { return (reg & 3) + 8 * (reg >> 2) + 4 * h; }
constexpr int VT_LD = 68;
constexpr size_t WS_DL = 2 * MiB;
constexpr size_t WS_SSQ = 2 * MiB + 262144;
constexpr size_t WS_BG = WS_LOGA;
constexpr size_t WS_SP = 458 * MiB;
constexpr size_t WS_WA2 = 40 * MiB + 131072;
#define PACK8(x, s) __builtin_bit_cast(bf16x8, (u32x4){pkbf((x)[8 * (s)], (x)[8 * (s) + 1]), pkbf((x)[8 * (s) + 2], (x)[8 * (s) + 3]), pkbf((x)[8 * (s) + 4], (x)[8 * (s) + 5]), pkbf((x)[8 * (s) + 6], (x)[8 * (s) + 7])})
DEV void stage_vt(const bf16* p, int m0, LAS bf16* vt, int tid) {
#pragma unroll
    for (int i = 0; i < 8; ++i) { const int idx = tid + 512 * i, t = idx & 63, c8 = idx >> 6;
        const u32x4 v = *(const u32x4*)(p + (size_t)(m0 + t) * PLD + P_V + c8 * 8);
        LAS bf16* dst = vt + (c8 * 8) * VT_LD + t;
        dst[0 * VT_LD] = (bf16)(v.x & 0xffffu); dst[1 * VT_LD] = (bf16)(v.x >> 16); dst[2 * VT_LD] = (bf16)(v.y & 0xffffu); dst[3 * VT_LD] = (bf16)(v.y >> 16);
        dst[4 * VT_LD] = (bf16)(v.z & 0xffffu); dst[5 * VT_LD] = (bf16)(v.z >> 16); dst[6 * VT_LD] = (bf16)(v.w & 0xffffu); dst[7 * VT_LD] = (bf16)(v.w >> 16); }
}
DEV bf16x8 vt_frag(const LAS bf16* vt, int vrow, int tbase, int hh) {
    const LAS bf16* s = vt + vrow * VT_LD + tbase + 4 * hh;
    const u32x2 lo = *(const LAS u32x2*)s, hi = *(const LAS u32x2*)(s + 8);
    return __builtin_bit_cast(bf16x8, (u32x4){lo.x, lo.y, hi.x, hi.y});
}
DEV void gla_pass1(LAS unsigned char* lds, const bf16* hb, const float* ssq, const bf16* p, const bf16* WaT, const bf16* Wa2T, const float* b_a, float* BG, float* U, float* DL, int item) {
    int tid_ = threadIdx.x; asm volatile("" : "+v"(tid_));
    const int tid = tid_, lane = tid & 63, w = __builtin_amdgcn_readfirstlane(tid >> 6), l31 = lane & 31, hh = lane >> 5, m0 = item * 64, h = w >> 1, kb = w & 1;
    LAS float* alowf = (LAS float*)lds;
    LAS bf16* alowb = (LAS bf16*)(lds + 8192);
    LAS bf16* vt = (LAS bf16*)(lds + 16384);
    const int j = 32 * w + l31;
    bf16x8 af[16], wf[16];
    {   const int tb4 = w & 3, kh = w >> 2, row = m0 + 16 * tb4 + (lane & 15), kofs = 512 * kh + 8 * (lane >> 4);
#pragma unroll
        for (int ks = 0; ks < 16; ++ks) { af[ks] = *(const bf16x8*)(hb + (size_t)row * D + kofs + 32 * ks); wf[ks] = *(const bf16x8*)(WaT + (size_t)(lane & 15) * D + kofs + 32 * ks); } }
    unsigned kraw[2][16];
#pragma unroll
    for (int tb = 0; tb < 2; ++tb)
#pragma unroll
        for (int r = 0; r < 16; ++r) kraw[tb][r] = p[(size_t)(m0 + 32 * tb + crow(r, hh)) * PLD + P_K + j];
    const bf16x8 wfrag = *(const bf16x8*)(Wa2T + j * 16 + 8 * hh);
    const float ba = b_a[j];
    {
        const int tb4 = w & 3, kh = w >> 2;
        f32x4 acc = {0.f, 0.f, 0.f, 0.f};
#pragma unroll
        for (int ks = 0; ks < 16; ++ks) acc = __builtin_amdgcn_mfma_f32_16x16x32_bf16(af[ks], wf[ks], acc, 0, 0, 0);
#pragma unroll
        for (int r = 0; r < 4; ++r) alowf[(kh * 64 + 16 * tb4 + 4 * (lane >> 4) + r) * 16 + (lane & 15)] = acc[r];
    }
    stage_vt(p, m0, vt, tid);
    __syncthreads();
    for (int i = tid; i < 1024; i += 512) alowb[i] = (bf16)f2bf((alowf[i] + alowf[1024 + i]) * row_rstd(ssq, m0 + (i >> 4)));
    __syncthreads();
    f32x16 bc[2]; float carry = 0.f;
#pragma unroll
    for (int tb = 0; tb < 2; ++tb) {
        const bf16x8 afrag = *(const LAS bf16x8*)(alowb + (32 * tb + l31) * 16 + 8 * hh);
        f32x16 z;
#pragma unroll
        for (int r = 0; r < 16; ++r) z[r] = 0.f;
        z = MFMA32(afrag, wfrag, z);
        float gs[4], other[4];
#pragma unroll
        for (int g = 0; g < 4; ++g) {
#pragma unroll
            for (int e = 0; e < 4; ++e) { const float zz = z[4 * g + e] + ba; const float la = (fminf(zz, 0.f) - __logf(1.0f + __expf(-fabsf(zz)))) * (1.0f / 16.0f); z[4 * g + e] = la + (e ? z[4 * g + e - 1] : 0.f); }
            gs[g] = z[4 * g + 3]; other[g] = __shfl_xor(gs[g], 32);
        }
        float run = carry;
#pragma unroll
        for (int g = 0; g < 4; ++g) { const float h0 = hh ? other[g] : gs[g], h1 = hh ? gs[g] : other[g]; const float off = run + (hh ? h0 : 0.f);
#pragma unroll
            for (int e = 0; e < 4; ++e) bc[tb][4 * g + e] = z[4 * g + e] + off;
            run += h0 + h1; }
        carry = run;
    }
    const float blast = carry;
#pragma unroll
    for (int tb = 0; tb < 2; ++tb)
#pragma unroll
        for (int r = 0; r < 16; ++r) BG[(size_t)(m0 + 32 * tb + crow(r, hh)) * KW + j] = bc[tb][r];
    if (hh == 0) DL[(size_t)(item * 4 + h) * 64 + 32 * kb + l31] = __expf(blast);
    f32x16 kh2[2];
#pragma unroll
    for (int tb = 0; tb < 2; ++tb)
#pragma unroll
        for (int r = 0; r < 16; ++r) kh2[tb][r] = bf2f(kraw[tb][r]) * __expf(blast - bc[tb][r]);
#pragma unroll
    for (int vb = 0; vb < 4; ++vb) {
        f32x16 acc;
#pragma unroll
        for (int r = 0; r < 16; ++r) acc[r] = 0.f;
        const int vrow = 128 * h + 32 * vb + l31;
#pragma unroll
        for (int tb = 0; tb < 2; ++tb) { acc = MFMA32(vt_frag(vt, vrow, 32 * tb, hh), PACK8(kh2[tb], 0), acc); acc = MFMA32(vt_frag(vt, vrow, 32 * tb + 16, hh), PACK8(kh2[tb], 1), acc); }
#pragma unroll
        for (int r = 0; r < 16; ++r) U[((size_t)(item * 4 + h) * 128 + 32 * vb + crow(r, hh)) * 64 + 32 * kb + l31] = acc[r];
    }
}
DEV void conv_item(bf16* p, const float* cw, int item) {
    int tid_ = threadIdx.x; asm volatile("" : "+v"(tid_));
    const int tid = tid_, c0 = (tid & 63) * 8, tr = tid >> 6, m0 = item * 64 + 8 * tr, ts0 = m0 % SEQ;
    u32x4 uv[10], bv[8];
#pragma unroll
    for (int i = 0; i < 10; ++i) { const bool ok = i >= 2 || ts0 > 0; const size_t r = (size_t)(ok ? m0 - 2 + i : m0) * PLD;
        uv[i] = *(const u32x4*)(p + r + P_U + c0); if (!ok) { uv[i] = (u32x4){0u, 0u, 0u, 0u}; } }
#pragma unroll
    for (int i = 0; i < 8; ++i) bv[i] = *(const u32x4*)(p + (size_t)(m0 + i) * PLD + P_GB + c0);
    float w0[8], w1[8], w2[8];
#pragma unroll
    for (int e = 0; e < 8; ++e) { w0[e] = cw[0 * CC + c0 + e]; w1[e] = cw[1 * CC + c0 + e]; w2[e] = cw[2 * CC + c0 + e]; }
    float u[10][8];
#pragma unroll
    for (int i = 0; i < 10; ++i) { u[i][0] = blo(uv[i].x); u[i][1] = bhi(uv[i].x); u[i][2] = blo(uv[i].y); u[i][3] = bhi(uv[i].y); u[i][4] = blo(uv[i].z); u[i][5] = bhi(uv[i].z); u[i][6] = blo(uv[i].w); u[i][7] = bhi(uv[i].w); }
#pragma unroll
    for (int tt = 0; tt < 8; ++tt) {
        const float gbv[8] = {blo(bv[tt].x), bhi(bv[tt].x), blo(bv[tt].y), bhi(bv[tt].y), blo(bv[tt].z), bhi(bv[tt].z), blo(bv[tt].w), bhi(bv[tt].w)};
        float y[8];
#pragma unroll
        for (int e = 0; e < 8; ++e) y[e] = gbv[e] * (w0[e] * u[tt][e] + w1[e] * u[tt + 1][e] + w2[e] * u[tt + 2][e]);
        u32x4 o; o.x = pkbf(y[0], y[1]); o.y = pkbf(y[2], y[3]); o.z = pkbf(y[4], y[5]); o.w = pkbf(y[6], y[7]);
        *(u32x4*)(p + (size_t)(m0 + tt) * PLD + P_GB + c0) = o;
    }
}
DEV void gla_scan(const float* U, const float* DL, bf16* Sp, int bx, int nthreads) {
    const int gtid = bx * 512 + otid();
    for (int idx = gtid; idx < BATCH * NH * 128 * 16; idx += nthreads) {
        const int bh = idx >> 11, v = (idx >> 4) & 127, k4 = idx & 15, b = bh >> 2, h = bh & 3;
        f32x4 S = {0.f, 0.f, 0.f, 0.f};
#pragma unroll 8
        for (int n = 0; n < SEQ / 64; ++n) { const int item = b * (SEQ / 64) + n; const size_t base = ((size_t)(item * 4 + h) * 128 + v) * 64 + k4 * 4;
            const f32x4 u = *(const f32x4*)(U + base), d = *(const f32x4*)(DL + (size_t)(item * 4 + h) * 64 + k4 * 4);
            u32x2 o; o.x = pkbf(S[0], S[1]); o.y = pkbf(S[2], S[3]); *(u32x2*)(Sp + base) = o;
            S = d * S + u; }
    }
}
DEV void gla_pass3(LAS unsigned char* lds, bf16* p, const float* BG, const bf16* Sp, const float* gn, int item, bf16* ydst, int yld) {
    int tid_ = threadIdx.x; asm volatile("" : "+v"(tid_));
    const int tid = tid_, lane = tid & 63, w = __builtin_amdgcn_readfirstlane(tid >> 6), l31 = lane & 31, hh = lane >> 5, m0 = item * 64, h = w >> 1, vh = w & 1;
    LAS float* ssb = (LAS float*)lds;
    LAS bf16* vt = (LAS bf16*)(lds + 16384);
    stage_vt(p, m0, vt, tid);
    bf16x8 qf[2][4], kf[2][4];
#pragma unroll
    for (int blk = 0; blk < 2; ++blk)
#pragma unroll
        for (int ks = 0; ks < 4; ++ks) { const size_t row = (size_t)(m0 + 32 * blk + l31); const int kk = 64 * h + 16 * ks + 8 * hh;
            const u32x4 qv = *(const u32x4*)(p + row * PLD + P_Q + kk), kv = *(const u32x4*)(p + row * PLD + P_K + kk);
            const f32x4 b0 = *(const f32x4*)(BG + row * KW + kk), b1 = *(const f32x4*)(BG + row * KW + kk + 4);
            float ep[8], em[8];
#pragma unroll
            for (int e = 0; e < 4; ++e) { ep[e] = 0.125f * __expf(b0[e]); ep[4 + e] = 0.125f * __expf(b1[e]); em[e] = __expf(-b0[e]); em[4 + e] = __expf(-b1[e]); }
            qf[blk][ks] = __builtin_bit_cast(bf16x8, (u32x4){pkbf(blo(qv.x) * ep[0], bhi(qv.x) * ep[1]), pkbf(blo(qv.y) * ep[2], bhi(qv.y) * ep[3]), pkbf(blo(qv.z) * ep[4], bhi(qv.z) * ep[5]), pkbf(blo(qv.w) * ep[6], bhi(qv.w) * ep[7])});
            kf[blk][ks] = __builtin_bit_cast(bf16x8, (u32x4){pkbf(blo(kv.x) * em[0], bhi(kv.x) * em[1]), pkbf(blo(kv.y) * em[2], bhi(kv.y) * em[3]), pkbf(blo(kv.z) * em[4], bhi(kv.z) * em[5]), pkbf(blo(kv.w) * em[6], bhi(kv.w) * em[7])}); }
    bf16x8 spf[2][4];
#pragma unroll
    for (int vb = 0; vb < 2; ++vb)
#pragma unroll
        for (int ks = 0; ks < 4; ++ks) spf[vb][ks] = *(const bf16x8*)(Sp + ((size_t)(item * 4 + h) * 128 + 64 * vh + 32 * vb + l31) * 64 + 16 * ks + 8 * hh);
    f32x16 X00, X01, X11;
#pragma unroll
    for (int r = 0; r < 16; ++r) { X00[r] = 0.f; X01[r] = 0.f; X11[r] = 0.f; }
#pragma unroll
    for (int ks = 0; ks < 4; ++ks) { X00 = MFMA32(kf[0][ks], qf[0][ks], X00); X01 = MFMA32(kf[0][ks], qf[1][ks], X01); X11 = MFMA32(kf[1][ks], qf[1][ks], X11); }
#pragma unroll
    for (int r = 0; r < 16; ++r) if (crow(r, hh) > l31) { X00[r] = 0.f; X11[r] = 0.f; }
    f32x4 gnv[2][4];
#pragma unroll
    for (int vb = 0; vb < 2; ++vb)
#pragma unroll
        for (int g = 0; g < 4; ++g) gnv[vb][g] = *(const f32x4*)(gn + 64 * vh + 32 * vb + 8 * g + 4 * hh);
    u32x2 gvv[2][2][4];
#pragma unroll
    for (int vb = 0; vb < 2; ++vb)
#pragma unroll
        for (int ib = 0; ib < 2; ++ib)
#pragma unroll
            for (int g = 0; g < 4; ++g) gvv[vb][ib][g] = *(const u32x2*)(p + (size_t)(m0 + 32 * ib + l31) * PLD + P_GO + 128 * h + 64 * vh + 32 * vb + 8 * g + 4 * hh);
    __syncthreads();
    f32x16 O[2][2];
#pragma unroll
    for (int vb = 0; vb < 2; ++vb) {
        f32x16 O0, O1;
#pragma unroll
        for (int r = 0; r < 16; ++r) { O0[r] = 0.f; O1[r] = 0.f; }
        const int vloc = 64 * vh + 32 * vb + l31, vrow = 128 * h + vloc;
#pragma unroll
        for (int ks = 0; ks < 4; ++ks) { const bf16x8 sf = spf[vb][ks]; O0 = MFMA32(sf, qf[0][ks], O0); O1 = MFMA32(sf, qf[1][ks], O1); }
        { const bf16x8 a0 = vt_frag(vt, vrow, 0, hh), a1 = vt_frag(vt, vrow, 16, hh), a2 = vt_frag(vt, vrow, 32, hh), a3 = vt_frag(vt, vrow, 48, hh);
          O0 = MFMA32(a0, PACK8(X00, 0), O0); O0 = MFMA32(a1, PACK8(X00, 1), O0);
          O1 = MFMA32(a0, PACK8(X01, 0), O1); O1 = MFMA32(a1, PACK8(X01, 1), O1);
          O1 = MFMA32(a2, PACK8(X11, 0), O1); O1 = MFMA32(a3, PACK8(X11, 1), O1); }
        O[vb][0] = O0; O[vb][1] = O1;
    }
    float ss0 = 0.f, ss1 = 0.f;
#pragma unroll
    for (int vb = 0; vb < 2; ++vb)
#pragma unroll
        for (int r = 0; r < 16; ++r) { ss0 += O[vb][0][r] * O[vb][0][r]; ss1 += O[vb][1][r] * O[vb][1][r]; }
    ss0 += __shfl_xor(ss0, 32); ss1 += __shfl_xor(ss1, 32);
    if (hh == 0) { ssb[w * 64 + l31] = ss0; ssb[w * 64 + 32 + l31] = ss1; }
    __syncthreads();
    float rstd[2];
#pragma unroll
    for (int ib = 0; ib < 2; ++ib) rstd[ib] = rsqrtf((ssb[(2 * h) * 64 + 32 * ib + l31] + ssb[(2 * h + 1) * 64 + 32 * ib + l31]) * (1.0f / 128.0f) + EPS);
#pragma unroll
    for (int vb = 0; vb < 2; ++vb)
#pragma unroll
        for (int ib = 0; ib < 2; ++ib)
#pragma unroll
            for (int g = 0; g < 4; ++g) { const int v0 = 64 * vh + 32 * vb + 8 * g + 4 * hh; bf16* dst = ydst + (size_t)(m0 + 32 * ib + l31) * yld + 128 * h + v0;
                const u32x2 gv = gvv[vb][ib][g]; const f32x4 gg = gnv[vb][g];
                const float g0 = blo(gv.x), g1 = bhi(gv.x), g2 = blo(gv.y), g3 = bhi(gv.y);
                u32x2 o; o.x = pkbf(O[vb][ib][4 * g] * rstd[ib] * gg[0] * g0 * fsig(g0), O[vb][ib][4 * g + 1] * rstd[ib] * gg[1] * g1 * fsig(g1));
                o.y = pkbf(O[vb][ib][4 * g + 2] * rstd[ib] * gg[2] * g2 * fsig(g2), O[vb][ib][4 * g + 3] * rstd[ib] * gg[3] * g3 * fsig(g3));
                *(u32x2*)dst = o; }
}

DEV void xb_rows(const float* x, bf16* xb, float* ssq, int gw, int ngw) {
    const int lane = otid() & 63;
    for (int m0 = gw; m0 < M; m0 += 2 * ngw) {
        const int m1 = m0 + ngw < M ? m0 + ngw : m0;
        const float4* xr0 = (const float4*)(x + (size_t)m0 * D); const float4* xr1 = (const float4*)(x + (size_t)m1 * D);
        float4 v0[4], v1[4];
#pragma unroll
        for (int j = 0; j < 4; ++j) { v0[j] = xr0[lane + 64 * j]; v1[j] = xr1[lane + 64 * j]; }
        uint2* o0 = (uint2*)(xb + (size_t)m0 * D); uint2* o1 = (uint2*)(xb + (size_t)m1 * D); float s0 = 0.f, s1 = 0.f;
#pragma unroll
        for (int j = 0; j < 4; ++j) { s0 += v0[j].x * v0[j].x + v0[j].y * v0[j].y + v0[j].z * v0[j].z + v0[j].w * v0[j].w; s1 += v1[j].x * v1[j].x + v1[j].y * v1[j].y + v1[j].z * v1[j].z + v1[j].w * v1[j].w;
            uint2 w; w.x = pk2(v0[j].x, v0[j].y); w.y = pk2(v0[j].z, v0[j].w); o0[lane + 64 * j] = w; w.x = pk2(v1[j].x, v1[j].y); w.y = pk2(v1[j].z, v1[j].w); o1[lane + 64 * j] = w; }
        s0 = wave_sum(s0); s1 = wave_sum(s1);
        if (lane < 4) { ssq[(size_t)lane * M + m0] = lane == 0 ? s0 : 0.f; ssq[(size_t)lane * M + m1] = lane == 0 ? s1 : 0.f; }
    }
}
DEV void rms_rows(const float* x, const float* g, bf16* hb, int gw, int ngw) {
    const int lane = otid() & 63;
    for (int m = gw; m < M; m += ngw) {
        const float4* xr = (const float4*)(x + (size_t)m * D); const float4* gr = (const float4*)g;
        float4 v[4]; float ss = 0.f;
#pragma unroll
        for (int j = 0; j < 4; ++j) { v[j] = xr[lane + 64 * j]; ss += v[j].x * v[j].x + v[j].y * v[j].y + v[j].z * v[j].z + v[j].w * v[j].w; }
        const float rstd = rsqrtf(wave_sum(ss) * (1.0f / D) + EPS);
        uint2* o = (uint2*)(hb + (size_t)m * D);
#pragma unroll
        for (int j = 0; j < 4; ++j) { const float4 gg = gr[lane + 64 * j]; uint2 w; w.x = pk2(v[j].x * rstd * gg.x, v[j].y * rstd * gg.y); w.y = pk2(v[j].z * rstd * gg.z, v[j].w * rstd * gg.w); o[lane + 64 * j] = w; }
    }
}
DEV void route1_stage(LAS float* wT, const float* g2, const float* wr) {
    const int tid = otid();
    for (int k = tid; k < D; k += 512) { const float g = g2[k]; const float4 w0 = *(const float4*)(wr + (size_t)k * 8), w1 = *(const float4*)(wr + (size_t)k * 8 + 4);
        wT[0 * D + k] = w0.x * g; wT[1 * D + k] = w0.y * g; wT[2 * D + k] = w0.z * g; wT[3 * D + k] = w0.w * g; wT[4 * D + k] = w1.x * g; wT[5 * D + k] = w1.y * g; wT[6 * D + k] = w1.z * g; wT[7 * D + k] = w1.w * g; }
    __syncthreads();
}
DEV void route1_grp(const LAS float* wT, LAS int* lcnt, const bf16* x, float* rstd_o, int* tok_e, float* tok_w, int* counts, int grp) {
    const int tid = otid(), lane = tid & 63, wave = tid >> 6;
    if (tid < 8) lcnt[tid] = 0;
    __syncthreads();
    const int hh = lane >> 5, b4 = (lane >> 4) & 1, b3 = (lane >> 3) & 1;
    uint2 xraw[8][4];
#pragma unroll
    for (int i = 0; i < 8; ++i)
#pragma unroll
        for (int j = 0; j < 4; ++j) xraw[i][j] = ((const uint2*)(x + (size_t)(grp * 64 + wave * 8 + i) * D))[lane + 64 * j];
#pragma unroll
    for (int i = 0; i < 8; ++i) {
        const int m = grp * 64 + wave * 8 + i;
        float4 v[4]; float ss = 0.f; float a[8];
#pragma unroll
        for (int e = 0; e < 8; ++e) a[e] = 0.f;
#pragma unroll
        for (int j = 0; j < 4; ++j) { const uint2 t = xraw[i][j]; v[j] = make_float4(blo(t.x), bhi(t.x), blo(t.y), bhi(t.y)); ss += v[j].x * v[j].x + v[j].y * v[j].y + v[j].z * v[j].z + v[j].w * v[j].w; }
#pragma unroll
        for (int j = 0; j < 4; ++j)
#pragma unroll
            for (int e = 0; e < 8; ++e) { const f32x4 w = *(const LAS f32x4*)(wT + e * D + 4 * (lane + 64 * j)); a[e] += v[j].x * w[0] + v[j].y * w[1] + v[j].z * w[2] + v[j].w * w[3]; }
        ss = wave_sum(ss);
        float c4[4], c2[2];
#pragma unroll
        for (int e = 0; e < 4; ++e) { const float keep = hh ? a[e + 4] : a[e], send = hh ? a[e] : a[e + 4]; c4[e] = keep + __shfl_xor(send, 32); }
#pragma unroll
        for (int e = 0; e < 2; ++e) { const float keep = b4 ? c4[e + 2] : c4[e], send = b4 ? c4[e] : c4[e + 2]; c2[e] = keep + __shfl_xor(send, 16); }
        float c1 = (b3 ? c2[1] : c2[0]) + __shfl_xor(b3 ? c2[0] : c2[1], 8);
        c1 += __shfl_xor(c1, 4); c1 += __shfl_xor(c1, 2); c1 += __shfl_xor(c1, 1);
        const float rstd = rsqrtf(ss * (1.0f / D) + EPS);
        float lg[8];
#pragma unroll
        for (int e = 0; e < 8; ++e) lg[e] = __uint_as_float(__builtin_amdgcn_readlane((int)__float_as_uint(c1), 32 * (e >> 2) + 16 * ((e >> 1) & 1) + 8 * (e & 1))) * rstd;
        int i1 = 0; float l1 = lg[0];
#pragma unroll
        for (int e = 1; e < 8; ++e) if (lg[e] > l1) { l1 = lg[e]; i1 = e; }
        int i2 = -1; float l2 = -3.0e38f;
#pragma unroll
        for (int e = 0; e < 8; ++e) if (e != i1 && lg[e] > l2) { l2 = lg[e]; i2 = e; }
        const float ex = expf(l2 - l1), w1v = 1.0f / (1.0f + ex), w2v = ex / (1.0f + ex);
        if (lane == 0) { rstd_o[m] = rstd; tok_e[m * 2] = i1; tok_e[m * 2 + 1] = i2; tok_w[m * 2] = w1v; tok_w[m * 2 + 1] = w2v;
            __hip_atomic_fetch_add(&lcnt[i1], 1, __ATOMIC_RELAXED, __HIP_MEMORY_SCOPE_WORKGROUP); __hip_atomic_fetch_add(&lcnt[i2], 1, __ATOMIC_RELAXED, __HIP_MEMORY_SCOPE_WORKGROUP); }
    }
    __syncthreads();
    if (tid < 8) counts[grp * 8 + tid] = lcnt[tid];
    __syncthreads();
}
DEV void route2_grp(LAS int* L, const bf16* x, const float* g2, const float* rstd_i, const int* counts, const int* tok_e, int* slot, unsigned char* hbp, int* tilet, int grp, int wgi, int nwg) {
    LAS int* ltot = L; LAS int* lpre = L + 8; LAS int* lseg = L + 16; LAS int* lslot = L + 32; LAS int* lte = L + 160;
    const int tid = otid(), lane = tid & 63, wave = tid >> 6;
    if (tid < 128) lte[tid] = tok_e[(grp * 64) * 2 + tid];
    { int tot = 0, pre = 0;
#pragma unroll
        for (int q = 0; q < 4; ++q) { const int w = lane + 64 * q; const int c = counts[w * 8 + wave]; tot += c; pre += (w < grp) ? c : 0; }
#pragma unroll
        for (int o = 1; o < 64; o <<= 1) { tot += __shfl_xor(tot, o); pre += __shfl_xor(pre, o); }
        if (lane == 0) { ltot[wave] = tot; lpre[wave] = pre; } }
    __syncthreads();
    if (tid == 0) { int off = 0; for (int e = 0; e < 8; ++e) { lseg[e] = off; off += ((ltot[e] + 255) / 256) * 256; } lseg[8] = off; }
    __syncthreads();
    { const int base = lseg[wave] + lpre[wave]; const bool m0 = lte[2 * lane] == wave, m1 = lte[2 * lane + 1] == wave;
        const unsigned long long b0 = __ballot(m0), b1 = __ballot(m1), lt = (1ull << lane) - 1ull;
        const int r0 = __popcll(b0 & lt) + __popcll(b1 & lt);
        if (m0) lslot[2 * lane] = base + r0;
        if (m1) lslot[2 * lane + 1] = base + r0 + (m0 ? 1 : 0); }
    __syncthreads();
    if (tid < 128) slot[(grp * 64) * 2 + tid] = lslot[tid];
    {   const float4* gr = (const float4*)g2; float4 gq[4];
#pragma unroll
        for (int j = 0; j < 4; ++j) gq[j] = gr[lane + 64 * j];
        uint2 xraw[8][4]; float rs[8];
#pragma unroll
        for (int q = 0; q < 8; ++q) { const int m = grp * 64 + wave + 8 * q; rs[q] = rstd_i[m];
#pragma unroll
            for (int j = 0; j < 4; ++j) xraw[q][j] = ((const uint2*)(x + (size_t)m * D))[lane + 64 * j]; }
#pragma unroll
        for (int q = 0; q < 8; ++q) { const int i = wave + 8 * q; const float rstd = rs[q];
            unsigned* o1 = (unsigned*)(hbp + (size_t)lslot[2 * i] * D); unsigned* o2 = (unsigned*)(hbp + (size_t)lslot[2 * i + 1] * D);
#pragma unroll
            for (int j = 0; j < 4; ++j) { const uint2 t = xraw[q][j]; const float4 gg = gq[j]; const unsigned w = pk4_fp8(blo(t.x) * rstd * gg.x, bhi(t.x) * rstd * gg.y, blo(t.y) * rstd * gg.z, bhi(t.y) * rstd * gg.w); o1[lane + 64 * j] = w; o2[lane + 64 * j] = w; } }
    }
    if (grp == 0) {
        if (tid < NTILE_MAX) { const int r = tid * 256; int e = -1; for (int q = 0; q < 8; ++q) if (r >= lseg[q] && r < lseg[q + 1]) e = q; tilet[tid] = e; }
        if (tid == 0) tilet[NTILE_MAX] = lseg[8] / 256;
    }
    if (grp == wgi) {
        for (int e = 0; e < 8; ++e) { const int r0 = lseg[e] + ltot[e], r1 = lseg[e + 1];
            for (int r = r0 + wgi; r < r1; r += nwg) if (tid < 256) ((unsigned*)(hbp + (size_t)r * D))[tid] = 0u; }
    }
    __syncthreads();
}
DEV void combine_rows(const bf16* x, const bf16* obuf, const float* obx, const int* slot, const float* tok_w, const float* gf, float* out, int gw, int ngw) {
    const int lane = otid() & 63;
    const float4* gr = (const float4*)gf; float4 gq[4];
#pragma unroll
    for (int j = 0; j < 4; ++j) gq[j] = gr[lane + 64 * j];
    for (int m0 = gw; m0 < M; m0 += 2 * ngw) {
        const int mm[2] = {m0, m0 + ngw < M ? m0 + ngw : m0};
        int s1[2], s2[2]; float w1[2], w2[2];
#pragma unroll
        for (int q = 0; q < 2; ++q) { const int2 sl = *(const int2*)(slot + mm[q] * 2); const float2 tw = *(const float2*)(tok_w + mm[q] * 2); s1[q] = sl.x; s2[q] = sl.y; w1[q] = tw.x; w2[q] = tw.y; }
        float4 v[2][4], ea[2][4], ec[2][4];
        if (s1[0] < 128 * 256 && s2[0] < 128 * 256 && s1[1] < 128 * 256 && s2[1] < 128 * 256) {
            uint2 xa[2][4], oa[2][4], oc[2][4];
#pragma unroll
            for (int q = 0; q < 2; ++q)
#pragma unroll
                for (int j = 0; j < 4; ++j) { xa[q][j] = ((const uint2*)(x + (size_t)mm[q] * D))[lane + 64 * j]; oa[q][j] = ((const uint2*)(obuf + (size_t)s1[q] * D))[lane + 64 * j]; oc[q][j] = ((const uint2*)(obuf + (size_t)s2[q] * D))[lane + 64 * j]; }
#pragma unroll
            for (int q = 0; q < 2; ++q)
#pragma unroll
                for (int j = 0; j < 4; ++j) { v[q][j] = make_float4(blo(xa[q][j].x), bhi(xa[q][j].x), blo(xa[q][j].y), bhi(xa[q][j].y)); ea[q][j] = make_float4(blo(oa[q][j].x), bhi(oa[q][j].x), blo(oa[q][j].y), bhi(oa[q][j].y)); ec[q][j] = make_float4(blo(oc[q][j].x), bhi(oc[q][j].x), blo(oc[q][j].y), bhi(oc[q][j].y)); }
        } else
#pragma unroll
        for (int q = 0; q < 2; ++q) {
            const bf16* xr = x + (size_t)mm[q] * D; const uint2* o1 = (const uint2*)(obuf + (size_t)s1[q] * D); const uint2* o2 = (const uint2*)(obuf + (size_t)s2[q] * D);
#pragma unroll
            for (int j = 0; j < 4; ++j) { v[q][j] = ldx4(xr, lane + 64 * j);
                if (s1[q] < 128 * 256) { const uint2 a = o1[lane + 64 * j]; ea[q][j] = make_float4(blo(a.x), bhi(a.x), blo(a.y), bhi(a.y)); }
                else { float4 e = make_float4(0.f, 0.f, 0.f, 0.f); for (int ks = 0; ks < KSPLIT; ++ks) { const float4 t = ((const float4*)(obx + ((size_t)ks * 2048 + (s1[q] - 128 * 256)) * D))[lane + 64 * j]; e.x += t.x; e.y += t.y; e.z += t.z; e.w += t.w; } ea[q][j] = e; }
                if (s2[q] < 128 * 256) { const uint2 c = o2[lane + 64 * j]; ec[q][j] = make_float4(blo(c.x), bhi(c.x), blo(c.y), bhi(c.y)); }
                else { float4 e = make_float4(0.f, 0.f, 0.f, 0.f); for (int ks = 0; ks < KSPLIT; ++ks) { const float4 t = ((const float4*)(obx + ((size_t)ks * 2048 + (s2[q] - 128 * 256)) * D))[lane + 64 * j]; e.x += t.x; e.y += t.y; e.z += t.z; e.w += t.w; } ec[q][j] = e; } }
        }
#pragma unroll
        for (int q = 0; q < 2; ++q) { float ss = 0.f;
#pragma unroll
            for (int j = 0; j < 4; ++j) { v[q][j].x += w1[q] * ea[q][j].x + w2[q] * ec[q][j].x; v[q][j].y += w1[q] * ea[q][j].y + w2[q] * ec[q][j].y; v[q][j].z += w1[q] * ea[q][j].z + w2[q] * ec[q][j].z; v[q][j].w += w1[q] * ea[q][j].w + w2[q] * ec[q][j].w;
                ss += v[q][j].x * v[q][j].x + v[q][j].y * v[q][j].y + v[q][j].z * v[q][j].z + v[q][j].w * v[q][j].w; }
            const float rstd = rsqrtf(wave_sum(ss) * (1.0f / D) + EPS);
            float4* orow = (float4*)(out + (size_t)mm[q] * D);
#pragma unroll
            for (int j = 0; j < 4; ++j) orow[lane + 64 * j] = make_float4(v[q][j].x * rstd * gq[j].x, v[q][j].y * rstd * gq[j].y, v[q][j].z * rstd * gq[j].z, v[q][j].w * rstd * gq[j].w); }
    }
}

DEV void cvt_item8(const float* W, int ldw, int k0, int n0, unsigned char* dst, int Kd, LAS float* scr, int lane) {
#pragma unroll
    for (int i = 0; i < 32; ++i) { const int kk = 2 * i + (lane >> 5); scr[kk * 33 + (lane & 31)] = W[(size_t)(k0 + kk) * ldw + n0 + (lane & 31)]; }
    asm volatile("s_waitcnt lgkmcnt(0)" ::: "memory");
    const int c = lane & 3;
#pragma unroll
    for (int j = 0; j < 2; ++j) { const int n = (lane >> 2) + 16 * j; const LAS float* sp = scr + (16 * c) * 33 + n;
        u32x4 o; o.x = pk4_fp8(sp[0 * 33] * W8_SCALE, sp[1 * 33] * W8_SCALE, sp[2 * 33] * W8_SCALE, sp[3 * 33] * W8_SCALE); o.y = pk4_fp8(sp[4 * 33] * W8_SCALE, sp[5 * 33] * W8_SCALE, sp[6 * 33] * W8_SCALE, sp[7 * 33] * W8_SCALE);
        o.z = pk4_fp8(sp[8 * 33] * W8_SCALE, sp[9 * 33] * W8_SCALE, sp[10 * 33] * W8_SCALE, sp[11 * 33] * W8_SCALE); o.w = pk4_fp8(sp[12 * 33] * W8_SCALE, sp[13 * 33] * W8_SCALE, sp[14 * 33] * W8_SCALE, sp[15 * 33] * W8_SCALE);
        *(u32x4*)(dst + (size_t)n * Kd + 16 * c) = o; }
    asm volatile("s_waitcnt lgkmcnt(0)" ::: "memory");
}
struct CvtD { const float* W; const float* gain; unsigned char* dst; int ldw, k0, n0, Kd, kind; };
DEV void cvt_load(const CvtD& d, int lane, float (&r)[32]) {
#pragma unroll
    for (int i = 0; i < 8; ++i) { const f32x4 t = *(const f32x4*)(d.W + (size_t)(d.k0 + 8 * i + (lane >> 3)) * d.ldw + d.n0 + 4 * (lane & 7)); r[4 * i] = t[0]; r[4 * i + 1] = t[1]; r[4 * i + 2] = t[2]; r[4 * i + 3] = t[3]; }
}
DEV void cvt_finish(const CvtD& d, const float (&r)[32], LAS float* scr, int lane) {
#pragma unroll
    for (int i = 0; i < 8; ++i)
#pragma unroll
        for (int e = 0; e < 4; ++e) scr[(8 * i + (lane >> 3)) * 33 + 4 * (lane & 7) + e] = r[4 * i + e];
    asm volatile("s_waitcnt lgkmcnt(0)" ::: "memory");
    if (d.kind == 2) {
        const int c = lane & 3;
#pragma unroll
        for (int j = 0; j < 2; ++j) { const int n = (lane >> 2) + 16 * j; const LAS float* sp = scr + (16 * c) * 33 + n;
            u32x4 o; o.x = pk4_fp8(sp[0 * 33] * W8_SCALE, sp[1 * 33] * W8_SCALE, sp[2 * 33] * W8_SCALE, sp[3 * 33] * W8_SCALE); o.y = pk4_fp8(sp[4 * 33] * W8_SCALE, sp[5 * 33] * W8_SCALE, sp[6 * 33] * W8_SCALE, sp[7 * 33] * W8_SCALE);
            o.z = pk4_fp8(sp[8 * 33] * W8_SCALE, sp[9 * 33] * W8_SCALE, sp[10 * 33] * W8_SCALE, sp[11 * 33] * W8_SCALE); o.w = pk4_fp8(sp[12 * 33] * W8_SCALE, sp[13 * 33] * W8_SCALE, sp[14 * 33] * W8_SCALE, sp[15 * 33] * W8_SCALE);
            *(u32x4*)(d.dst + (size_t)n * d.Kd + 16 * c) = o; }
    } else {
        const int c = lane & 7;
        f32x4 g0 = {1.f, 1.f, 1.f, 1.f}, g1 = g0;
        if (d.kind == 1) { g0 = *(const f32x4*)(d.gain + d.k0 + 8 * c); g1 = *(const f32x4*)(d.gain + d.k0 + 8 * c + 4); }
#pragma unroll
        for (int j = 0; j < 4; ++j) { const int n = (lane >> 3) + 8 * j; const LAS float* sp = scr + (8 * c) * 33 + n;
            u32x4 o; o.x = pk2(sp[0 * 33] * g0[0], sp[1 * 33] * g0[1]); o.y = pk2(sp[2 * 33] * g0[2], sp[3 * 33] * g0[3]); o.z = pk2(sp[4 * 33] * g1[0], sp[5 * 33] * g1[1]); o.w = pk2(sp[6 * 33] * g1[2], sp[7 * 33] * g1[3]);
            *(u32x4*)(d.dst + ((size_t)n * d.Kd + 8 * c) * 2) = o; }
    }
    asm volatile("s_waitcnt lgkmcnt(0)" ::: "memory");
}
struct Args { const float* in[18]; float* out; unsigned char* ws; int ph_lo, ph_hi; };
enum { PH_CVT = 0, PH_G1 = 1, PH_GLA1 = 2, PH_SCAN = 3, PH_GLA3 = 4, PH_G2 = 5, PH_G3 = 6, PH_RMS2 = 7, PH_UP = 8, PH_DOWN = 9, PH_RMS1 = 10, PH_LAYER = 16, PH_ROUTE1 = 23, PH_ROUTE2 = 24, PH_MUPA = 25, PH_MDOWNA = 26, PH_MUPB = 27, PH_MDOWNB = 28, PH_COMBINE = 29, PH_END = 30 };

__global__ void __launch_bounds__(512, 2) mega(Args args) {
    extern __shared__ __attribute__((aligned(16))) unsigned char lds_raw[];
    LAS unsigned char* lds = (LAS unsigned char*)lds_raw;
    const int wave = __builtin_amdgcn_readfirstlane((int)threadIdx.x >> 6);
    const int G = gridDim.x, bx = blockIdx.x;
    unsigned char* ws = args.ws;
    const int lo = args.ph_lo, hi = args.ph_hi;
#define IN(k) (lo <= (k) && (k) < hi)
#define SEAM(k) do { if ((k) + 1 < hi) { xcd_barrier(bar); if (DUP_PH == 99) xcd_barrier(bar); } } while (0)
    volatile LAS unsigned* MISC = (volatile LAS unsigned*)(lds + MISC_OFF);
    if (threadIdx.x < 16) MISC[threadIdx.x] = 0u;
    __syncthreads();
    XcdBarrier bar = xcd_barrier_post((unsigned*)(ws + WS_BAR), MISC + 8);
    const int gw = bx * 8 + wave, ngw = G * 8;
    if (IN(PH_CVT)) {
        const int tid = otid(), lane = tid & 63;
        LAS float* scr = (LAS float*)(lds + wave * 16384);
        const int NGW = ngw;
        constexpr int I_IN = 16 * 160, I_BR = 8 * 32, I_OUT = 16 * 32, I_FGU = 16 * 88, I_FD = 44 * 32, I_MGU = 16 * 112, I_MD = 56 * 32;
        constexpr int I_LAYER = I_IN + 2 * I_BR + I_OUT, I_FFN = 2 * I_FGU + I_FD, I_EXP = 2 * I_MGU + I_MD, NITEMS = 2 * I_LAYER + I_FFN + 8 * I_EXP;
        auto decode = [&](int it) -> CvtD {
            CvtD d; int r = it;
            if (r < 2 * I_LAYER) { const int l = r / I_LAYER; r -= l * I_LAYER;
                if (r < I_IN) { const int kb = r / 160, nb = r % 160, n0d = nb * 32, tpn = n0d >> 8, r0 = n0d & 255;
                    int n0s; if (tpn < 4) n0s = r0 < 128 ? 128 * tpn + r0 : 1024 + 128 * tpn + (r0 - 128); else if (tpn < 6) n0s = 512 + 256 * (tpn - 4) + r0; else { const int c = 1536 + 256 * (tpn - 6) + r0; n0s = c < 3072 ? c : c + 16; }
                    d.W = args.in[2] + (size_t)l * D * IN_COLS; d.ldw = IN_COLS; d.k0 = kb * 64; d.n0 = n0s; d.dst = ws + WS_WIN + (((size_t)l * NW1 + n0d) * D + kb * 64) * 2; d.Kd = D; d.gain = args.in[1] + l * D; d.kind = 1; return d; }
                r -= I_IN;
                if (r < 2 * I_BR) { const int br = r / I_BR; r -= br * I_BR; const int kb = r / 32, nb = r % 32;
                    d.W = args.in[7] + (size_t)(l * 2 + br) * CC * D; d.ldw = D; d.k0 = kb * 64; d.n0 = nb * 32; d.dst = ws + WS_WBR + (((size_t)(l * 2 + br) * D + nb * 32) * CC + kb * 64) * 2; d.Kd = CC; d.gain = nullptr; d.kind = 0; return d; }
                r -= 2 * I_BR;
                { const int kb = r / 32, nb = r % 32; d.W = args.in[8] + (size_t)l * D * D; d.ldw = D; d.k0 = kb * 64; d.n0 = nb * 32; d.dst = ws + WS_WOUT + (((size_t)l * D + nb * 32) * D + kb * 64) * 2; d.Kd = D; d.gain = nullptr; d.kind = 0; return d; }
            }
            r -= 2 * I_LAYER;
            if (r < I_FFN) {
                if (r < 2 * I_FGU) { const int up = r / I_FGU; r -= up * I_FGU; const int kb = r / 88, nb = r % 88, n0 = nb * 32, drow = (n0 >> 7) * 256 + up * 128 + (n0 & 127);
                    d.W = args.in[10 + up]; d.ldw = DFF; d.k0 = kb * 64; d.n0 = n0; d.dst = ws + WS_WFGU + ((size_t)drow * D + kb * 64) * 2; d.Kd = D; d.gain = args.in[9]; d.kind = 1; return d; }
                r -= 2 * I_FGU;
                { const int kb = r / 32, nb = r % 32; d.W = args.in[12]; d.ldw = D; d.k0 = kb * 64; d.n0 = nb * 32; d.dst = ws + WS_WFD + ((size_t)(nb * 32) * DFF + kb * 64) * 2; d.Kd = DFF; d.gain = nullptr; d.kind = 0; return d; }
            }
            r -= I_FFN;
            { const int e = r / I_EXP; r -= e * I_EXP;
                if (r < 2 * I_MGU) { const int up = r / I_MGU; r -= up * I_MGU; const int kb = r / 112, nb = r % 112, n0 = nb * 32, drow = (n0 >> 7) * 256 + up * 128 + (n0 & 127);
                    d.W = args.in[14 + up] + (size_t)e * D * DFE; d.ldw = DFE; d.k0 = kb * 64; d.n0 = n0; d.dst = ws + WS_WMGU + ((size_t)e * 2 * DFE + drow) * D + kb * 64; d.Kd = D; d.gain = nullptr; d.kind = 2; return d; }
                r -= 2 * I_MGU;
                { const int kb = r / 32, nb = r % 32; d.W = args.in[16] + (size_t)e * DFE * D; d.ldw = D; d.k0 = kb * 64; d.n0 = nb * 32; d.dst = ws + WS_WMD + ((size_t)e * D + nb * 32) * DFE + kb * 64; d.Kd = DFE; d.gain = nullptr; d.kind = 2; return d; } }
        };
        if (gw < NITEMS) {
            int it = gw; CvtD d = decode(it); float r[32]; cvt_load(d, lane, r);
            for (;;) {
                const int nx = it + NGW;
                if (nx < NITEMS) { const CvtD dn = decode(nx); float rn[32]; cvt_load(dn, lane, rn); cvt_finish(d, r, scr, lane); d = dn;
#pragma unroll
                    for (int i = 0; i < 32; ++i) r[i] = rn[i];
                    it = nx; }
                else { cvt_finish(d, r, scr, lane); break; }
            }
        }
        for (int i = bx * 512 + tid; i < 2 * RANK * D; i += G * 512) { const int l = i / (RANK * D), n = (i / D) % RANK, k = i % D; ((bf16*)(ws + WS_WA))[i] = (bf16)f2bf(args.in[2][(size_t)l * D * IN_COLS + (size_t)k * IN_COLS + 3072 + n] * args.in[1][l * D + k]); }
        for (int i = bx * 512 + tid; i < 2 * KW * RANK; i += G * 512) { const int l = i / (KW * RANK), j = (i / RANK) % KW, r = i % RANK; ((bf16*)(ws + WS_WA2))[i] = (bf16)f2bf(args.in[3][(size_t)l * RANK * KW + r * KW + j]); }
        xb_rows(args.in[0], (bf16*)(ws + WS_HB), (float*)(ws + WS_SSQ), gw, ngw);
        __syncthreads();
        SEAM(PH_CVT);
    }
    for (int l = 0; l < 2; ++l) {
        const int pb = l * PH_LAYER;
        bf16* p = (bf16*)(ws + WS_P); bf16* hb = (bf16*)(ws + WS_HB); bf16* merged = (bf16*)(ws + WS_U);
        if (IN(pb + PH_G1)) {
            SchedGrid S{(const char*)hb, (const char*)((bf16*)(ws + WS_WIN) + (size_t)l * NW1 * D), (size_t)256 * D * 2, (size_t)256 * D * 2, M / 256, NW1 / 256, G, bx};
            fill_rstd((LAS float*)(lds + RSTD_OFF), S, (const float*)(ws + WS_SSQ));
            for (int rep_ = 0; rep_ < NREP(pb + PH_G1); ++rep_) pg8::gemm_phase<EG1, SchedGrid, true, true>(lds, D, D, D, S, EG1{p, (const LAS float*)(lds + RSTD_OFF)});
            SEAM(pb + PH_G1);
        }
        if (IN(pb + PH_GLA1)) {
            for (int rep_ = 0; rep_ < NREP(pb + PH_GLA1); ++rep_)
            for (int item = bx; item < M / 64; item += G) {
                if (rep_ == NREP(pb + PH_GLA1) - 1) conv_item(p, args.in[5] + l * 3 * CC, item);
                gla_pass1(lds, hb, (const float*)(ws + WS_SSQ), p, (const bf16*)(ws + WS_WA) + (size_t)l * RANK * D, (const bf16*)(ws + WS_WA2) + (size_t)l * KW * RANK, args.in[4] + l * KW, (float*)(ws + WS_BG), (float*)(ws + WS_U), (float*)(ws + WS_DL), item);
                __syncthreads();
            }
            SEAM(pb + PH_GLA1);
        }
        if (IN(pb + PH_SCAN)) { for (int rep_ = 0; rep_ < NREP(pb + PH_SCAN); ++rep_) gla_scan((const float*)(ws + WS_U), (const float*)(ws + WS_DL), (bf16*)(ws + WS_SP), bx, G * 512); SEAM(pb + PH_SCAN); }
        if (IN(pb + PH_GLA3)) {
            for (int rep_ = 0; rep_ < NREP(pb + PH_GLA3); ++rep_)
            for (int item = bx; item < M / 64; item += G) { const bool lastrep = rep_ == NREP(pb + PH_GLA3) - 1;
                gla_pass3(lds, p, (const float*)(ws + WS_BG), (const bf16*)(ws + WS_SP), args.in[6] + l * DV, item, lastrep ? p + P_GO : (bf16*)(ws + WS_ACTP), lastrep ? PLD : VW); __syncthreads(); }
            SEAM(pb + PH_GLA3);
        }
        if (IN(pb + PH_G2)) {
            const bf16* wb = (const bf16*)(ws + WS_WBR) + (size_t)l * 2 * D * CC;
            SchedPair S{(const char*)(p + P_GB), (const char*)(p + P_GO), (const char*)wb, (const char*)(wb + (size_t)D * CC), (size_t)256 * PLD * 2, (size_t)256 * CC * 2, M / 256, D / 256, G, bx};
            for (int rep_ = 0; rep_ < NREP(pb + PH_G2); ++rep_) pg8::gemm_phase<EMerge, SchedPair, true, true>(lds, CC, PLD, CC, S, EMerge{merged, p});
            SEAM(pb + PH_G2);
        }
        if (IN(pb + PH_G3)) {
            SchedGrid S{(const char*)merged, (const char*)((bf16*)(ws + WS_WOUT) + (size_t)l * D * D), (size_t)256 * D * 2, (size_t)256 * D * 2, M / 256, D / 256, G, bx};
            if (l == 0) { for (int rep_ = 0; rep_ < NREP(pb + PH_G3); ++rep_) pg8::gemm_phase<ERes, SchedGrid, true, true>(lds, D, D, D, S, ERes{hb, (float*)(ws + WS_SSQ), (LAS float*)(lds + PSTAT_OFF)}); }
            else pg8::gemm_phase<EResT<false>, SchedGrid, true, true>(lds, D, D, D, S, EResT<false>{hb, nullptr, nullptr});
            SEAM(pb + PH_G3);
        }
        if (l == 0) {
            bf16* act = (bf16*)(ws + WS_P);
            if (IN(PH_UP)) {
                SchedGrid S{(const char*)hb, (const char*)(ws + WS_WFGU), (size_t)256 * D * 2, (size_t)256 * D * 2, M / 256, 2 * DFF / 256, G, bx};
                fill_rstd((LAS float*)(lds + RSTD_OFF), S, (const float*)(ws + WS_SSQ));
                for (int rep_ = 0; rep_ < NREP(PH_UP); ++rep_) pg8::gemm_phase<ESwiglu, SchedGrid, true, true>(lds, D, D, D, S, ESwiglu{act, DFF, (const LAS float*)(lds + RSTD_OFF)});
                SEAM(PH_UP);
            }
            if (IN(PH_DOWN)) {
                SchedGrid S{(const char*)act, (const char*)(ws + WS_WFD), (size_t)256 * DFF * 2, (size_t)256 * DFF * 2, M / 256, D / 256, G, bx};
                pg8::gemm_phase<ERes, SchedGrid, true, true>(lds, DFF, DFF, DFF, S, ERes{hb, (float*)(ws + WS_SSQ), (LAS float*)(lds + PSTAT_OFF)});
                SEAM(PH_DOWN);
            }
        } else {
            int* tilet = (int*)(ws + WS_TILE); unsigned char* hbp = ws + WS_HBP; unsigned char* actp = ws + WS_ACTP; bf16* obuf = (bf16*)(ws + WS_OBUF);
            int* counts = (int*)(ws + WS_CNT); int* tok_e = (int*)(ws + WS_TOKE); float* tok_w = (float*)(ws + WS_TOKW); int* slot = (int*)(ws + WS_SLOT); float* rstd = (float*)(ws + WS_RSTD);
            if (IN(PH_ROUTE1)) { route1_stage((LAS float*)lds, args.in[9] + D, args.in[13]);
                for (int rep_ = 0; rep_ < NREP(PH_ROUTE1); ++rep_) for (int grp = bx; grp < M / 64; grp += G) route1_grp((const LAS float*)lds, (LAS int*)(lds + 32768), hb, rstd, tok_e, tok_w, counts, grp); SEAM(PH_ROUTE1); }
            if (IN(PH_ROUTE2)) { for (int rep_ = 0; rep_ < NREP(PH_ROUTE2); ++rep_) for (int grp = bx; grp < M / 64; grp += G) route2_grp((LAS int*)lds, hb, args.in[9] + D, rstd, counts, tok_e, slot, hbp, tilet, grp, bx, G); SEAM(PH_ROUTE2); }
            {
                int nT = 0; if (IN(PH_MUPA) || IN(PH_MDOWNA)) nT = tilet[NTILE_MAX];
                const int nFull = nT < 128 ? nT : 128, nL = nT > 128 ? nT - 128 : 0;
                if (IN(PH_MUPA)) {
                    SchedMoe S{(const char*)hbp, (const char*)(ws + WS_WMGU), tilet, (size_t)256 * D, (size_t)256 * D, (size_t)2 * DFE * D, 0, nT, 2 * DFE / 256, G, bx};
                    for (int rep_ = 0; rep_ < NREP(PH_MUPA); ++rep_) pg8::gemm_phase<ESwiglu8, SchedMoe, true, true, true>(lds, D / 2, D / 2, D / 2, S, ESwiglu8{actp, DFE, W8_INV});
                    SEAM(PH_MUPA);
                }
                if (IN(PH_MDOWNA)) {
                    SchedMoe S{(const char*)actp, (const char*)(ws + WS_WMD), tilet, (size_t)256 * DFE, (size_t)256 * DFE, (size_t)D * DFE, 0, nFull, D / 256, G, bx};
                    for (int rep_ = 0; rep_ < NREP(PH_MDOWNA); ++rep_) pg8::gemm_phase<EBf16, SchedMoe, true, true, true>(lds, DFE / 2, DFE / 2, DFE / 2, S, EBf16{obuf, D, W8_INV, nullptr});
                    SchedMoeK SK{(const char*)actp, (const char*)(ws + WS_WMD), tilet, nL, G, bx};
                    pg8::gemm_phase<ESlab, SchedMoeK, true, true, true>(lds, KSLICE / 2, DFE / 2, DFE / 2, SK, ESlab{(float*)(ws + WS_OBX), W8_INV});
                    SEAM(PH_MDOWNA);
                }
            }
            if (IN(PH_COMBINE)) combine_rows(hb, obuf, (const float*)(ws + WS_OBX), slot, tok_w, args.in[17], args.out, gw, ngw);
        }
    }
#undef IN
}

extern "C" void kernel_launch(void* const* d_in, const int* in_sizes, int n_in, void* d_out, int out_size, void* d_ws, size_t ws_size, hipStream_t stream) {
    (void)in_sizes;
    if (n_in != 18 || out_size != M * D || ws_size < WS_END) { fprintf(stderr, "kernel_launch: unexpected arguments (n_in %d out %d ws %zu)\n", n_in, out_size, ws_size); return; }
    static int grid = 0;
    if (grid == 0) {
        int dev = 0, cus = 0;
        if (hipGetDevice(&dev) != hipSuccess || hipDeviceGetAttribute(&cus, hipDeviceAttributeMultiprocessorCount, dev) != hipSuccess) { fprintf(stderr, "kernel_launch: device query failed\n"); grid = -1; return; }
        if (hipFuncSetAttribute((const void*)mega, hipFuncAttributeMaxDynamicSharedMemorySize, LDS_BYTES) != hipSuccess) { fprintf(stderr, "kernel_launch: hipFuncSetAttribute failed\n"); grid = -1; return; }
        grid = cus;
    }
    if (grid < 0) return;
    Args a{};
    for (int i = 0; i < 18; ++i) a.in[i] = (const float*)d_in[i];
    a.out = (float*)d_out; a.ws = (unsigned char*)d_ws;
#define MEGA(lo_, hi_) do { a.ph_lo = (lo_); a.ph_hi = (hi_); hipLaunchKernelGGL(mega, dim3(grid), dim3(512), LDS_BYTES, stream, a); } while (0)
    if (hipMemsetAsync(d_ws, 0, 65536, stream) != hipSuccess) { fprintf(stderr, "kernel_launch: memset failed\n"); return; }
#if MK_SPLIT
    { const int ph[] = {0, 1, 2, 3, 4, 5, 6, 7, 8, 9, 10, 17, 18, 19, 20, 21, 22, 23, 24, 25, 26, 27, 28, 29}; for (int i = 0; i < 24; ++i) MEGA(ph[i], ph[i] + 1); }
#else
    MEGA(0, PH_END);
#endif
}
```

```cpp
#include <hip/hip_runtime.h>
#include <cstdio>
#include <cstdint>
#include <cstddef>
#ifndef MK_SPLIT
#define MK_SPLIT 0
#endif
#ifndef DUP_PH
#define DUP_PH -1
#endif
#define NREP(k) (((k) == (DUP_PH)) ? 2 : 1)

typedef unsigned short bf16;
#define DEV __device__ __forceinline__

constexpr int D = 1024, BATCH = 8, SEQ = 2048, M = BATCH * SEQ;
constexpr int CC = 512, KW = 256, VW = 512, RANK = 16, NH = 4, DK = 64, DV = 128;
constexpr int IN_COLS = 5136, NW1 = 5120  , PLD = 3584  ;
constexpr int P_U = 0, P_GB = 512, P_Q = 1024, P_K = 1280, P_V = 1536, P_GO = 2048, PB_GA = 5120, PB_GBB = 6144;
constexpr int DFF = 2816, NE = 8, DFE = 3584;
constexpr float EPS = 1e-6f;
constexpr int PERM_ROWS = 2 * M + NE * 256;
constexpr int NTILE_MAX = PERM_ROWS / 256;
constexpr int CHUNK_TILES = 64;
constexpr int KSPLIT = 7, KSLICE = DFE / KSPLIT;

constexpr size_t MiB = 1ull << 20;
constexpr size_t WS_CNT = 1 * MiB;
constexpr size_t WS_TILE = 1 * MiB + 16384;
constexpr size_t WS_TOKE = 1 * MiB + 65536;
constexpr size_t WS_TOKW = WS_TOKE + 131072;
constexpr size_t WS_SLOT = WS_TOKW + 131072;
constexpr size_t WS_RSTD = WS_SLOT + 131072;
constexpr size_t WS_ALOW = 3 * MiB;
constexpr size_t WS_LOGA = 4 * MiB;
constexpr size_t WS_HB = 234 * MiB;
constexpr size_t WS_P = 266 * MiB;
constexpr size_t WS_U = 426 * MiB;
constexpr size_t WS_ACTP = 266 * MiB;
constexpr size_t WS_HBP = 385 * MiB;
constexpr size_t WS_OBUF = 419 * MiB;
constexpr size_t WS_OBX = 4 * MiB;
constexpr size_t WS_END = 489 * MiB;

DEV float bf2f(unsigned v) { return __uint_as_float(v << 16); }
DEV unsigned f2bf(float f) { unsigned u = __float_as_uint(f); return (u + 0x7fffu + ((u >> 16) & 1u)) >> 16; }
DEV unsigned pk2(float lo, float hi) { return f2bf(lo) | (f2bf(hi) << 16); }
DEV float wave_sum(float v) {
#pragma unroll
    for (int o = 1; o < 64; o <<= 1) v += __shfl_xor(v, o);
    return v;
}

DEV float row_rstd(const float* ssq, int row) { return rsqrtf(((ssq[row] + ssq[M + row]) + (ssq[2 * M + row] + ssq[3 * M + row])) * (1.0f / D) + EPS); }
#define LAS __attribute__((address_space(3)))
typedef short bf16x8 __attribute__((ext_vector_type(8)));
typedef float f32x4 __attribute__((ext_vector_type(4)));
typedef float f32x2 __attribute__((ext_vector_type(2)));
typedef unsigned u32x4 __attribute__((ext_vector_type(4)));
typedef unsigned u32x2 __attribute__((ext_vector_type(2)));
DEV unsigned cvt_pk_bf16(float lo, float hi) { unsigned r; asm volatile("v_cvt_pk_bf16_f32 %0, %1, %2" : "=v"(r) : "v"(lo), "v"(hi)); return r; }
DEV float fsig(float x) { return __builtin_amdgcn_rcpf(1.0f + __builtin_amdgcn_exp2f(-1.44269504f * x)); }
DEV float blo(unsigned w) { return __uint_as_float(w << 16); }
DEV float bhi(unsigned w) { return __uint_as_float(w & 0xffff0000u); }

typedef int i32x4 __attribute__((ext_vector_type(4)));
typedef int i32x8 __attribute__((ext_vector_type(8)));
DEV i32x8 cat8(bf16x8 lo, bf16x8 hi) { return __builtin_shufflevector(__builtin_bit_cast(i32x4, lo), __builtin_bit_cast(i32x4, hi), 0, 1, 2, 3, 4, 5, 6, 7); }
DEV unsigned pk4_fp8(float a, float b, float c, float d) { int w = 0; w = __builtin_amdgcn_cvt_pk_fp8_f32(a, b, w, false); w = __builtin_amdgcn_cvt_pk_fp8_f32(c, d, w, true); return (unsigned)w; }
constexpr float W8_SCALE = 64.0f, W8_INV = 1.0f / 64.0f;
namespace pg8 {
constexpr int BM = 256, BK = 64, HALF = 128, HTB = HALF * BK * 2, STAGE_BYTES = 8 * HTB, NXCD = 8, WGM = 8;
__host__ __device__ __forceinline__ int lds_byte(int r, int c) { const int st = (r >> 4) * 2 + (c >> 5), rr = r & 15, cc = c & 31, ob = rr * 64 + cc * 2; return st * 1024 + (ob ^ (((ob >> 9) & 1) << 5)); }
__host__ __device__ __forceinline__ void stage_rc(int b, int& R, int& C) { const int st = b / 1024, sb = b % 1024, swz = sb ^ (((sb >> 9) & 1) << 5); R = (st >> 1) * 16 + swz / 64; C = (st & 1) * 32 + (swz % 64) / 2; }
__host__ __device__ __forceinline__ int perm32(int rho) { const int n = rho >> 4, i = rho & 15; return 8 * (i >> 2) + 4 * n + (i & 3); }

struct Unit { const char* A; const char* B; int pm, pn, aux; };
DEV bool tile_of(int L, int nM, int nN, int& pm, int& pn) {
    const int nwg = nM * nN; if (L >= nwg) return false;
    int wgid = L; { const int q = nwg / NXCD, r = nwg % NXCD, xcd = wgid % NXCD, off = wgid / NXCD; wgid = (xcd < r ? xcd * (q + 1) : r * (q + 1) + (xcd - r) * q) + off; }
    const int nig = WGM * nN, gid = wgid / nig, fm = gid * WGM, gsz = (nM - fm) < WGM ? (nM - fm) : WGM;
    pm = fm + ((wgid % nig) % gsz); pn = (wgid % nig) / gsz; return true;
}

template <class Epi, class Sched, bool ALIGN_EPI, bool SP2, bool FP8 = false>
DEV void gemm_phase(LAS unsigned char* lds, const int K, const int lda, const int ldb, const Sched& S, const Epi& E) {
    int tid_ = threadIdx.x; asm volatile("" : "+v"(tid_));
    const int tid = tid_, wid = __builtin_amdgcn_readfirstlane(tid >> 6), lane = tid & 63, wr = wid >> 2, wc = wid & 3, fr = lane & 15, fq = lane >> 4;
    const int nt = K / BK;
    unsigned voffA[2], voffB[2];
#pragma unroll
    for (int i = 0; i < 2; ++i) { int R, C; stage_rc(tid * 16 + i * 8192, R, C); const int Rb = Epi::PERM ? ((R & ~31) + perm32(R & 31)) : R;
        voffA[i] = (unsigned)(R * lda + C) * 2u; voffB[i] = (unsigned)(Rb * ldb + C) * 2u; }
    const size_t kstep = (size_t)(BK * 2);
    const size_t hstepA = (size_t)HALF * lda * 2, hstepB = (size_t)HALF * ldb * 2;
    const unsigned ldsw = (unsigned)wid * 1024u;
    const int aoff = FP8 ? lds_byte(wr * 64 + fr, fq * 16) : lds_byte(wr * 64 + fr, fq * 8), boff = FP8 ? lds_byte(wc * 32 + fr, fq * 16) : lds_byte(wc * 32 + fr, fq * 8);

#define PG8_SA(b, h) (((b) * 2 + (h)) * HTB)
#define PG8_SB(b, h) ((4 + (b) * 2 + (h)) * HTB)
#define PG8_STAGE(bufoff, gbase, voff) do { _Pragma("unroll") for (int _i = 0; _i < 2; ++_i) \
        __builtin_amdgcn_global_load_lds((const unsigned*)((const char*)(gbase) + (voff)[_i]), (LAS unsigned*)(lds + (bufoff) + ldsw + _i * 8192), 16, 0, 0); } while (0)
#define PG8_RD(off) (*(const LAS bf16x8*)(lds + (off)))
#define PG8_LDA(dst, b, h) do { if constexpr (FP8) { _Pragma("unroll") for (int m = 0; m < 4; ++m) dst##8[m] = cat8(PG8_RD(PG8_SA(b, h) + aoff + m * 2048), PG8_RD(PG8_SA(b, h) + aoff + m * 2048 + 16)); } \
        else { _Pragma("unroll") for (int m = 0; m < 4; ++m) _Pragma("unroll") for (int k = 0; k < 2; ++k) dst[m][k] = PG8_RD(PG8_SA(b, h) + aoff + m * 2048 + k * 1024); } } while (0)
#define PG8_LDB(dst, b, h) do { if constexpr (FP8) { _Pragma("unroll") for (int n = 0; n < 2; ++n) dst##8[n] = cat8(PG8_RD(PG8_SB(b, h) + boff + n * 2048), PG8_RD(PG8_SB(b, h) + boff + n * 2048 + 16)); } \
        else { _Pragma("unroll") for (int n = 0; n < 2; ++n) _Pragma("unroll") for (int k = 0; k < 2; ++k) dst[n][k] = PG8_RD(PG8_SB(b, h) + boff + n * 2048 + k * 1024); } } while (0)
#define PG8_MMA(ai, bj, At, Bt) do { __builtin_amdgcn_s_setprio(1); _Pragma("unroll") for (int m = 0; m < 4; ++m) _Pragma("unroll") for (int n = 0; n < 2; ++n) { \
        if constexpr (FP8) asm volatile("v_mfma_scale_f32_16x16x128_f8f6f4 %0, %1, %2, %0, %3, %3 op_sel_hi:[0,0,0]" : "+v"(acc[ai][bj][m][n]) : "v"(Bt##8[n]), "v"(At##8[m]), "v"(one8)); \
        else { _Pragma("unroll") for (int k = 0; k < 2; ++k) acc[ai][bj][m][n] = __builtin_amdgcn_mfma_f32_16x16x32_bf16(Bt[n][k], At[m][k], acc[ai][bj][m][n], 0, 0, 0); } } __builtin_amdgcn_s_setprio(0); } while (0)
#define PG8_WAIT_V(n) asm volatile("s_waitcnt vmcnt(" #n ")" ::: "memory")
#define PG8_WAIT_L(n) asm volatile("s_waitcnt lgkmcnt(" #n ")" ::: "memory")
#define PG8_BAR __builtin_amdgcn_s_barrier()
#define PG8_SCHED __builtin_amdgcn_sched_barrier(0)
    Unit cur, nxt; int ui = 0;
    if (!S.next(0, cur)) return;
    f32x4 acc[2][2][4][2];
#pragma unroll
    for (int a = 0; a < 2; ++a)
#pragma unroll
        for (int b = 0; b < 2; ++b)
#pragma unroll
            for (int m = 0; m < 4; ++m)
#pragma unroll
                for (int n = 0; n < 2; ++n) acc[a][b][m][n] = (f32x4){0.f, 0.f, 0.f, 0.f};
    const int one8 = 0x7F7F7F7F;
    bf16x8 At[4][2], B0[2][2], B1[2][2]; i32x8 At8[4], B08[2], B18[2];
    const char* cA = cur.A; const char* cB = cur.B;
    if constexpr (SP2) {
        PG8_STAGE(PG8_SB(0, 0), cB, voffB); PG8_STAGE(PG8_SB(0, 1), cB + hstepB, voffB); PG8_STAGE(PG8_SA(0, 0), cA, voffA); PG8_STAGE(PG8_SA(0, 1), cA + hstepA, voffA);
        if (wr == 1) PG8_BAR;
        PG8_WAIT_V(2); PG8_BAR;
        PG8_STAGE(PG8_SB(1, 0), cB + kstep, voffB); PG8_STAGE(PG8_SA(1, 0), cA + kstep, voffA); PG8_STAGE(PG8_SB(1, 1), cB + hstepB + kstep, voffB);
        PG8_WAIT_V(6); PG8_BAR;
    } else {
        PG8_STAGE(PG8_SB(0, 0), cB, voffB); PG8_STAGE(PG8_SA(0, 0), cA, voffA); PG8_STAGE(PG8_SB(0, 1), cB + hstepB, voffB); PG8_STAGE(PG8_SA(0, 1), cA + hstepA, voffA);
        if (wr == 1) PG8_BAR;
        PG8_WAIT_V(4); PG8_BAR;
        PG8_STAGE(PG8_SB(1, 0), cB + kstep, voffB); PG8_STAGE(PG8_SA(1, 0), cA + kstep, voffA); PG8_STAGE(PG8_SB(1, 1), cB + hstepB + kstep, voffB);
        PG8_WAIT_V(6); PG8_BAR;
    }
    for (;;) {
        const bool has_next = S.next(ui + 1, nxt);
        const char* nA = has_next ? nxt.A : cA; const char* nB = has_next ? nxt.B : cB;
#pragma nounroll
        for (int t = 0; t < nt; t += 2) {
            const bool last = (t == nt - 2);
            const char* a1 = cA + (size_t)(t + 1) * kstep;
            const char* a2 = last ? nA : cA + (size_t)(t + 2) * kstep; const char* b2 = last ? nB : cB + (size_t)(t + 2) * kstep;
            const char* a3 = a2 + kstep; const char* b3 = b2 + kstep;
            if constexpr (SP2) {
            PG8_LDB(B0, 0, 0); PG8_LDB(B1, 0, 1); PG8_SCHED; PG8_LDA(At, 0, 0); PG8_STAGE(PG8_SA(1, 1), a1 + hstepA, voffA);
            PG8_WAIT_V(8); PG8_WAIT_L(0); PG8_BAR; PG8_MMA(0, 0, At, B0); PG8_MMA(0, 1, At, B1); PG8_BAR; PG8_SCHED;
            PG8_LDA(At, 0, 1); PG8_STAGE(PG8_SB(0, 0), b2, voffB); PG8_STAGE(PG8_SB(0, 1), b2 + hstepB, voffB); PG8_STAGE(PG8_SA(0, 0), a2, voffA);
            PG8_WAIT_V(8); PG8_WAIT_L(0); PG8_BAR; PG8_MMA(1, 0, At, B0); PG8_MMA(1, 1, At, B1); PG8_BAR; PG8_SCHED;
            PG8_LDB(B0, 1, 0); PG8_LDB(B1, 1, 1); PG8_SCHED; PG8_LDA(At, 1, 0); PG8_STAGE(PG8_SA(0, 1), a2 + hstepA, voffA);
            PG8_WAIT_V(8); PG8_WAIT_L(0); PG8_BAR; PG8_MMA(0, 0, At, B0); PG8_MMA(0, 1, At, B1); PG8_BAR; PG8_SCHED;
            PG8_LDA(At, 1, 1); PG8_STAGE(PG8_SB(1, 0), b3, voffB); PG8_STAGE(PG8_SB(1, 1), b3 + hstepB, voffB); PG8_STAGE(PG8_SA(1, 0), a3, voffA);
            PG8_WAIT_V(8); PG8_WAIT_L(0); PG8_BAR; PG8_MMA(1, 0, At, B0); PG8_MMA(1, 1, At, B1); PG8_BAR; PG8_SCHED;
            } else {
            PG8_LDB(B0, 0, 0); PG8_SCHED; PG8_LDA(At, 0, 0); PG8_STAGE(PG8_SA(1, 1), a1 + hstepA, voffA);
            PG8_WAIT_L(8); PG8_BAR; PG8_WAIT_L(0); PG8_MMA(0, 0, At, B0); PG8_BAR; PG8_SCHED;
            PG8_LDB(B1, 0, 1); PG8_STAGE(PG8_SB(0, 0), b2, voffB);
            PG8_BAR; PG8_WAIT_L(0); PG8_MMA(0, 1, At, B1); PG8_BAR;
            PG8_LDA(At, 0, 1); PG8_STAGE(PG8_SA(0, 0), a2, voffA);
            PG8_BAR; PG8_WAIT_L(0); PG8_MMA(1, 0, At, B0); PG8_BAR; PG8_SCHED;
            PG8_STAGE(PG8_SB(0, 1), b2 + hstepB, voffB);
            PG8_WAIT_V(6); PG8_BAR; PG8_MMA(1, 1, At, B1); PG8_BAR;
            PG8_LDB(B0, 1, 0); PG8_SCHED; PG8_LDA(At, 1, 0); PG8_STAGE(PG8_SA(0, 1), a2 + hstepA, voffA);
            PG8_WAIT_L(8); PG8_BAR; PG8_WAIT_L(0); PG8_MMA(0, 0, At, B0); PG8_BAR; PG8_SCHED;
            PG8_LDB(B1, 1, 1); PG8_STAGE(PG8_SB(1, 0), b3, voffB);
            PG8_BAR; PG8_WAIT_L(0); PG8_MMA(0, 1, At, B1); PG8_BAR;
            PG8_LDA(At, 1, 1); PG8_STAGE(PG8_SA(1, 0), a3, voffA);
            PG8_BAR; PG8_WAIT_L(0); PG8_MMA(1, 0, At, B0); PG8_BAR; PG8_SCHED;
            PG8_STAGE(PG8_SB(1, 1), b3 + hstepB, voffB);
            PG8_WAIT_V(6); PG8_BAR; PG8_MMA(1, 1, At, B1); PG8_BAR;
            }
        }
        if constexpr (ALIGN_EPI) { if (wr == 0) PG8_BAR; }
        if constexpr (FP8) asm volatile("s_nop 15\n\ts_nop 15" ::: "memory");
        E(acc, cur, wr, wc, fr, fq);
        if (!has_next) break;
#pragma unroll
        for (int a = 0; a < 2; ++a)
#pragma unroll
            for (int b = 0; b < 2; ++b)
#pragma unroll
                for (int m = 0; m < 4; ++m)
#pragma unroll
                    for (int n = 0; n < 2; ++n) acc[a][b][m][n] = (f32x4){0.f, 0.f, 0.f, 0.f};
        cur = nxt; cA = nA; cB = nB; ++ui;
        if constexpr (ALIGN_EPI) { if (wr == 1) PG8_BAR; }
    }
    PG8_WAIT_V(0);
    if constexpr (!ALIGN_EPI) { if (wr == 0) PG8_BAR; }
    PG8_BAR;
#undef PG8_SA
#undef PG8_SB
#undef PG8_STAGE
#undef PG8_LDA
#undef PG8_RD
#undef PG8_LDB
#undef PG8_MMA
#undef PG8_WAIT_V
#undef PG8_WAIT_L
#undef PG8_BAR
#undef PG8_SCHED
}
}
using pg8::Unit;

struct SchedGrid { const char* A; const char* B; size_t astep, bstep; int nM, nN, G, c;
    DEV bool next(int i, Unit& u) const { int pm, pn; if (!pg8::tile_of(i * G + c, nM, nN, pm, pn)) return false; u.A = A + (size_t)pm * astep; u.B = B + (size_t)pn * bstep; u.pm = pm; u.pn = pn; u.aux = i; return true; } };
struct SchedPair { const char* A0; const char* A1; const char* B0; const char* B1; size_t astep, bstep; int nM, nN, G, c;
    DEV bool next(int i, Unit& u) const { int pm, pn; if (!pg8::tile_of((i >> 1) * G + c, nM, nN, pm, pn)) return false; const int br = i & 1; u.A = (br ? A1 : A0) + (size_t)pm * astep; u.B = (br ? B1 : B0) + (size_t)pn * bstep; u.pm = pm; u.pn = pn; u.aux = br; return true; } };
struct SchedMoe { const char* A; const char* B; const int* tile_e; size_t astep, bstep, estep; int t0, nM, nN, G, c;
    DEV bool next(int i, Unit& u) const { int pm, pn; if (!pg8::tile_of(i * G + c, nM, nN, pm, pn)) return false; const int e = tile_e[t0 + pm]; u.A = A + (size_t)pm * astep; u.B = B + (size_t)e * estep + (size_t)pn * bstep; u.pm = pm; u.pn = pn; u.aux = e; return true; } };

struct SchedMoeK { const char* A; const char* B; const int* tile_e; int nL, G, c;
    DEV bool next(int i, Unit& u) const { const int L = i * G + c; if (L >= nL * 4 * KSPLIT) return false; const int ks = L % KSPLIT, pn = (L / KSPLIT) & 3, lt = L / (4 * KSPLIT); const int e = tile_e[128 + lt];
        u.A = A + ((size_t)(128 + lt) * 256 * DFE + (size_t)ks * KSLICE); u.B = B + ((size_t)e * D * DFE + (size_t)pn * 256 * DFE + (size_t)ks * KSLICE);     u.pm = lt; u.pn = pn; u.aux = ks; return true; } };
template <class Sched> DEV void fill_rstd(LAS float* R, const Sched& S, const float* ssq) {
    int t = threadIdx.x; asm volatile("" : "+v"(t)); Unit u;
    for (int i = 0; i < 8 && S.next(i, u); ++i) if (t < 256) R[i * 256 + t] = row_rstd(ssq, u.pm * 256 + t);
    __syncthreads();
}
typedef const f32x4 (&AccRef)[2][2][4][2];
template <bool RS> struct EBf16T { static constexpr bool PERM = true; bf16* O; int ldc; float sc; const LAS float* R;
    DEV void operator()(AccRef acc, const Unit& u, int wr, int wc, int fr, int fq) const {
        const int row0 = u.pm * 256 + wr * 64 + fr, col0 = u.pn * 256 + wc * 32 + 8 * fq;
        float rsv[2][4];
#pragma unroll
        for (int ai = 0; ai < 2; ++ai)
#pragma unroll
            for (int m = 0; m < 4; ++m) rsv[ai][m] = RS ? sc * R[u.aux * 256 + ai * 128 + wr * 64 + m * 16 + fr] : sc;
#pragma unroll
        for (int ai = 0; ai < 2; ++ai)
#pragma unroll
            for (int m = 0; m < 4; ++m) { const int row = row0 + ai * 128 + m * 16; bf16* rowp = O + (size_t)row * ldc + col0; const float rs = rsv[ai][m];
#pragma unroll
                for (int bj = 0; bj < 2; ++bj) { const f32x4 v0 = acc[ai][bj][m][0] * rs, v1 = acc[ai][bj][m][1] * rs; u32x4 w; w.x = cvt_pk_bf16(v0[0], v0[1]); w.y = cvt_pk_bf16(v0[2], v0[3]); w.z = cvt_pk_bf16(v1[0], v1[1]); w.w = cvt_pk_bf16(v1[2], v1[3]);
                    *(u32x4*)(rowp + bj * 128) = w; } }
    } };
typedef EBf16T<false> EBf16;
constexpr float OB_SCALE = 8.0f;
struct EOut8 { static constexpr bool PERM = true; unsigned char* O; float sc;
    DEV void operator()(AccRef acc, const Unit& u, int wr, int wc, int fr, int fq) const {
        const int row0 = u.pm * 256 + wr * 64 + fr, col0 = u.pn * 256 + wc * 32 + 8 * fq;
#pragma unroll
        for (int ai = 0; ai < 2; ++ai)
#pragma unroll
            for (int m = 0; m < 4; ++m) { unsigned char* rowp = O + (size_t)(row0 + ai * 128 + m * 16) * D + col0;
#pragma unroll
                for (int bj = 0; bj < 2; ++bj) { const f32x4 v0 = acc[ai][bj][m][0] * sc, v1 = acc[ai][bj][m][1] * sc; u32x2 w; w.x = pk4_fp8(v0[0], v0[1], v0[2], v0[3]); w.y = pk4_fp8(v1[0], v1[1], v1[2], v1[3]);
                    *(u32x2*)(rowp + bj * 128) = w; } }
    } };
struct EG1 { static constexpr bool PERM = true; bf16* p; const LAS float* R;
    DEV void operator()(AccRef acc, const Unit& u, int wr, int wc, int fr, int fq) const {
        const int row0 = u.pm * 256 + wr * 64 + fr, c8 = wc * 32 + 8 * fq;
        float rsv[2][4];
#pragma unroll
        for (int ai = 0; ai < 2; ++ai)
#pragma unroll
            for (int m = 0; m < 4; ++m) rsv[ai][m] = R[u.aux * 256 + ai * 128 + wr * 64 + m * 16 + fr];
        if (u.pn < 4) {
#pragma unroll
            for (int ai = 0; ai < 2; ++ai)
#pragma unroll
                for (int m = 0; m < 4; ++m) { const float r2 = rsv[ai][m] * rsv[ai][m]; const f32x4 a0 = acc[ai][0][m][0], a1 = acc[ai][0][m][1], g0 = acc[ai][1][m][0] * r2, g1 = acc[ai][1][m][1] * r2;
                    u32x4 w; w.x = cvt_pk_bf16(a0[0] * g0[0], a0[1] * g0[1]); w.y = cvt_pk_bf16(a0[2] * g0[2], a0[3] * g0[3]); w.z = cvt_pk_bf16(a1[0] * g1[0], a1[1] * g1[1]); w.w = cvt_pk_bf16(a1[2] * g1[2], a1[3] * g1[3]);
                    *(u32x4*)(p + (size_t)(row0 + ai * 128 + m * 16) * PLD + P_U + 128 * u.pn + c8) = w; }
        } else if (u.pn < 12) {
            const int colt = P_GB + 256 * (u.pn - 4) + c8;
#pragma unroll
            for (int ai = 0; ai < 2; ++ai)
#pragma unroll
                for (int m = 0; m < 4; ++m) { const float rs = rsv[ai][m]; bf16* rowp = p + (size_t)(row0 + ai * 128 + m * 16) * PLD + colt;
#pragma unroll
                    for (int bj = 0; bj < 2; ++bj) { const f32x4 v0 = acc[ai][bj][m][0] * rs, v1 = acc[ai][bj][m][1] * rs; u32x4 w; w.x = cvt_pk_bf16(v0[0], v0[1]); w.y = cvt_pk_bf16(v0[2], v0[3]); w.z = cvt_pk_bf16(v1[0], v1[1]); w.w = cvt_pk_bf16(v1[2], v1[3]);
                        *(u32x4*)(rowp + bj * 128) = w; } }
        } else {
            const int bofs = PB_GA + 256 * (u.pn - 12) + c8;
#pragma unroll
            for (int ai = 0; ai < 2; ++ai)
#pragma unroll
                for (int m = 0; m < 4; ++m) { const float rs = rsv[ai][m]; unsigned char* rowb = (unsigned char*)(p + (size_t)(row0 + ai * 128 + m * 16) * PLD) + bofs;
#pragma unroll
                    for (int bj = 0; bj < 2; ++bj) { const f32x4 v0 = acc[ai][bj][m][0] * rs, v1 = acc[ai][bj][m][1] * rs;
                        unsigned q[8] = {(unsigned)(fsig(v0[0]) * 255.0f + 0.5f), (unsigned)(fsig(v0[1]) * 255.0f + 0.5f), (unsigned)(fsig(v0[2]) * 255.0f + 0.5f), (unsigned)(fsig(v0[3]) * 255.0f + 0.5f),
                                         (unsigned)(fsig(v1[0]) * 255.0f + 0.5f), (unsigned)(fsig(v1[1]) * 255.0f + 0.5f), (unsigned)(fsig(v1[2]) * 255.0f + 0.5f), (unsigned)(fsig(v1[3]) * 255.0f + 0.5f)};
                        u32x2 w; w.x = q[0] | (q[1] << 8) | (q[2] << 16) | (q[3] << 24); w.y = q[4] | (q[5] << 8) | (q[6] << 16) | (q[7] << 24);
                        *(u32x2*)(rowb + bj * 128) = w; } }
        }
    } };
struct EMerge { static constexpr bool PERM = true; bf16* mg; const bf16* p;
    DEV void operator()(AccRef acc, const Unit& u, int wr, int wc, int fr, int fq) const {
        const int row0 = u.pm * 256 + wr * 64 + fr, col0 = u.pn * 256 + wc * 32 + 8 * fq; const int gofs = u.aux ? PB_GBB : PB_GA;
#pragma unroll
        for (int ai = 0; ai < 2; ++ai) {
            u32x2 gt[4][2]; u32x4 od[4][2];
#pragma unroll
            for (int m = 0; m < 4; ++m)
#pragma unroll
                for (int bj = 0; bj < 2; ++bj) { const size_t row = (size_t)(row0 + ai * 128 + m * 16); const int col = col0 + bj * 128;
                    gt[m][bj] = *(const u32x2*)((const unsigned char*)(p + row * PLD) + gofs + col); od[m][bj] = u.aux ? *(const u32x4*)(mg + row * D + col) : (u32x4){0u, 0u, 0u, 0u}; }
#pragma unroll
            for (int m = 0; m < 4; ++m)
#pragma unroll
                for (int bj = 0; bj < 2; ++bj) { const size_t row = (size_t)(row0 + ai * 128 + m * 16); const int col = col0 + bj * 128; const u32x2 g = gt[m][bj]; const u32x4 o = od[m][bj];
                    const f32x4 v0 = acc[ai][bj][m][0] * (1.0f / 255.0f), v1 = acc[ai][bj][m][1] * (1.0f / 255.0f);
                    u32x4 w; w.x = cvt_pk_bf16((float)(g.x & 0xffu) * v0[0] + blo(o.x), (float)((g.x >> 8) & 0xffu) * v0[1] + bhi(o.x)); w.y = cvt_pk_bf16((float)((g.x >> 16) & 0xffu) * v0[2] + blo(o.y), (float)(g.x >> 24) * v0[3] + bhi(o.y));
                    w.z = cvt_pk_bf16((float)(g.y & 0xffu) * v1[0] + blo(o.z), (float)((g.y >> 8) & 0xffu) * v1[1] + bhi(o.z)); w.w = cvt_pk_bf16((float)((g.y >> 16) & 0xffu) * v1[2] + blo(o.w), (float)(g.y >> 24) * v1[3] + bhi(o.w));
                    *(u32x4*)(mg + row * D + col) = w; }
        }
    } };
template <bool STATS> struct EResT { static constexpr bool PERM = true; bf16* xb; float* ssq; LAS float* P;
    DEV void operator()(AccRef acc, const Unit& u, int wr, int wc, int fr, int fq) const {
        const int row0 = u.pm * 256 + wr * 64 + fr, col0 = u.pn * 256 + wc * 32 + 8 * fq;
#pragma unroll
        for (int ai = 0; ai < 2; ++ai) {
        u32x4 xo[4][2];
#pragma unroll
            for (int m = 0; m < 4; ++m)
#pragma unroll
                for (int bj = 0; bj < 2; ++bj) xo[m][bj] = *(const u32x4*)(xb + (size_t)(row0 + ai * 128 + m * 16) * D + col0 + bj * 128);
#pragma unroll
            for (int m = 0; m < 4; ++m) { bf16* rowp = xb + (size_t)(row0 + ai * 128 + m * 16) * D + col0; float sq = 0.f;
#pragma unroll
                for (int bj = 0; bj < 2; ++bj) { const u32x4 o = xo[m][bj]; const f32x4 a0 = acc[ai][bj][m][0], a1 = acc[ai][bj][m][1];
                    u32x4 w; w.x = cvt_pk_bf16(blo(o.x) + a0[0], bhi(o.x) + a0[1]); w.y = cvt_pk_bf16(blo(o.y) + a0[2], bhi(o.y) + a0[3]); w.z = cvt_pk_bf16(blo(o.z) + a1[0], bhi(o.z) + a1[1]); w.w = cvt_pk_bf16(blo(o.w) + a1[2], bhi(o.w) + a1[3]);
                    *(u32x4*)(rowp + bj * 128) = w;
                    if (STATS) sq += (blo(w.x) * blo(w.x) + bhi(w.x) * bhi(w.x)) + (blo(w.y) * blo(w.y) + bhi(w.y) * bhi(w.y)) + (blo(w.z) * blo(w.z) + bhi(w.z) * bhi(w.z)) + (blo(w.w) * blo(w.w) + bhi(w.w) * bhi(w.w)); }
                if (STATS) { sq += __shfl_xor(sq, 16); sq += __shfl_xor(sq, 32);
                    if (fq == 0) P[(ai * 128 + wr * 64 + m * 16 + fr) * 4 + wc] = sq; } } }
        if (!STATS) return;
        asm volatile("s_waitcnt lgkmcnt(0)" ::: "memory"); __builtin_amdgcn_s_barrier(); asm volatile("" ::: "memory");
        const int t = wr * 256 + wc * 64 + fq * 16 + fr;
        if (t < 256) ssq[(size_t)u.pn * M + u.pm * 256 + t] = (P[t * 4] + P[t * 4 + 1]) + (P[t * 4 + 2] + P[t * 4 + 3]);
    } };
typedef EResT<true> ERes;
struct ESlab { static constexpr bool PERM = false; float* obx; float sc;
    DEV void operator()(AccRef acc, const Unit& u, int wr, int wc, int fr, int fq) const {
        const int row0 = u.pm * 256 + wr * 64 + fr, col0 = u.pn * 256 + wc * 32 + 4 * fq; float* base = obx + (size_t)u.aux * 2048 * D;
#pragma unroll
        for (int ai = 0; ai < 2; ++ai)
#pragma unroll
            for (int m = 0; m < 4; ++m) { const size_t off = (size_t)(row0 + ai * 128 + m * 16) * D + col0;
#pragma unroll
                for (int bj = 0; bj < 2; ++bj)
#pragma unroll
                    for (int n = 0; n < 2; ++n) *(f32x4*)(base + off + bj * 128 + n * 16) = acc[ai][bj][m][n] * sc; }
    } };
struct ESwiglu8 { static constexpr bool PERM = true; unsigned char* act; int ld; float sc;
    DEV void operator()(AccRef acc, const Unit& u, int wr, int wc, int fr, int fq) const {
        const int row0 = u.pm * 256 + wr * 64 + fr, col0 = u.pn * 128 + wc * 32 + 8 * fq;
#pragma unroll
        for (int ai = 0; ai < 2; ++ai)
#pragma unroll
            for (int m = 0; m < 4; ++m) { const f32x4 g0 = acc[ai][0][m][0] * sc, g1 = acc[ai][0][m][1] * sc, u0 = acc[ai][1][m][0] * sc, u1 = acc[ai][1][m][1] * sc;
                u32x2 w; w.x = pk4_fp8(g0[0] * fsig(g0[0]) * u0[0], g0[1] * fsig(g0[1]) * u0[1], g0[2] * fsig(g0[2]) * u0[2], g0[3] * fsig(g0[3]) * u0[3]);
                w.y = pk4_fp8(g1[0] * fsig(g1[0]) * u1[0], g1[1] * fsig(g1[1]) * u1[1], g1[2] * fsig(g1[2]) * u1[2], g1[3] * fsig(g1[3]) * u1[3]);
                *(u32x2*)(act + (size_t)(row0 + ai * 128 + m * 16) * ld + col0) = w; }
    } };
struct ESwiglu { static constexpr bool PERM = true; bf16* act; int ld; const LAS float* R;
    DEV void operator()(AccRef acc, const Unit& u, int wr, int wc, int fr, int fq) const {
        const int row0 = u.pm * 256 + wr * 64 + fr, col0 = u.pn * 128 + wc * 32 + 8 * fq;
        float rsv[2][4];
#pragma unroll
        for (int ai = 0; ai < 2; ++ai)
#pragma unroll
            for (int m = 0; m < 4; ++m) rsv[ai][m] = R[u.aux * 256 + ai * 128 + wr * 64 + m * 16 + fr];
#pragma unroll
        for (int ai = 0; ai < 2; ++ai)
#pragma unroll
            for (int m = 0; m < 4; ++m) { const float rs = rsv[ai][m]; const f32x4 g0 = acc[ai][0][m][0] * rs, g1 = acc[ai][0][m][1] * rs, u0 = acc[ai][1][m][0] * rs, u1 = acc[ai][1][m][1] * rs;
                u32x4 w; w.x = cvt_pk_bf16(g0[0] * fsig(g0[0]) * u0[0], g0[1] * fsig(g0[1]) * u0[1]); w.y = cvt_pk_bf16(g0[2] * fsig(g0[2]) * u0[2], g0[3] * fsig(g0[3]) * u0[3]);
                w.z = cvt_pk_bf16(g1[0] * fsig(g1[0]) * u1[0], g1[1] * fsig(g1[1]) * u1[1]); w.w = cvt_pk_bf16(g1[2] * fsig(g1[2]) * u1[2], g1[3] * fsig(g1[3]) * u1[3]);
                *(u32x4*)(act + (size_t)(row0 + ai * 128 + m * 16) * ld + col0) = w; }
    } };

#define XB_TMO      128
#define XB_XCNT(j)  (256  + 64 * (j))
#define XB_XSUB(j)  (1280 + 64 * (j))
#define XB_XGEN(j)  (2304 + 64 * (j))
#define XB_TOP      3328
#define XB_TOPGEN   3392
#define XCD_BAR_WORDS 3456
#define XB_SPIN_CAP (1u << 18)
__device__ __forceinline__ unsigned xb_ld(unsigned* p)              { return __hip_atomic_load(p, __ATOMIC_RELAXED, __HIP_MEMORY_SCOPE_AGENT); }
__device__ __forceinline__ unsigned xb_add(unsigned* p, unsigned v) { return __hip_atomic_fetch_add(p, v, __ATOMIC_RELAXED, __HIP_MEMORY_SCOPE_AGENT); }
__device__ __forceinline__ unsigned xb_xcc_id() { return (unsigned)__builtin_amdgcn_s_getreg((3 << 11) | 20) & 0xFu; }
#define XB_SPIN(cond, bar) do { unsigned _sp = 0; while (cond) { __builtin_amdgcn_s_sleep(1); \
    if ((++_sp & 255u) == 0u) { if (xb_ld(&(bar)[XB_TMO])) break; if (_sp > XB_SPIN_CAP) { atomicAdd(&(bar)[XB_TMO], 1u); break; } } } } while (0)
struct XcdBarrier { unsigned* bar; unsigned x; volatile LAS unsigned* st; };
__device__ __forceinline__ XcdBarrier xcd_barrier_post(unsigned* bar, volatile LAS unsigned* st) {
    XcdBarrier b; b.bar = bar; b.x = xb_xcc_id(); b.st = st;
    if (threadIdx.x == 0) (void)xb_add(&bar[XB_XCNT(b.x)], 1u);
    return b;
}
__device__ __forceinline__ void xcd_barrier_complete(unsigned* bar, unsigned x, unsigned& nloc, unsigned& nx) {
    const unsigned G = gridDim.x * gridDim.y * gridDim.z;
    unsigned sum, cnt, mine, sp = 0u;
    for (;;) {
        sum = 0u; cnt = 0u; mine = 0u;
#pragma unroll
        for (unsigned j = 0; j < 16; ++j) { const unsigned c = xb_ld(&bar[XB_XCNT(j)]); sum += c; cnt += (c > 0u) ? 1u : 0u; mine = (j == x) ? c : mine; }
        if (sum == G) break;
        __builtin_amdgcn_s_sleep(1);
        if ((++sp & 255u) == 0u) { if (xb_ld(&bar[XB_TMO])) break; if (sp > XB_SPIN_CAP) { atomicAdd(&bar[XB_TMO], 1u); break; } }
    }
    nloc = mine > 0u ? mine : 1u; nx = cnt > 0u ? cnt : 1u;
}
__device__ __forceinline__ void xcd_barrier(const XcdBarrier& b) {
    asm volatile("s_waitcnt vmcnt(0)" ::: "memory");
    __syncthreads();
    if (threadIdx.x == 0) {
        unsigned* bar = b.bar;
        __builtin_amdgcn_s_waitcnt(0);
        unsigned nloc = b.st[0], nx = b.st[1];
        if (nloc == 0u) { xcd_barrier_complete(bar, b.x, nloc, nx); b.st[0] = nloc; b.st[1] = nx; }
        const unsigned old = xb_add(&bar[XB_XSUB(b.x)], 1u);
        const unsigned gen = old / nloc;
        if (old + 1u == (gen + 1u) * nloc) {
            __builtin_amdgcn_fence(__ATOMIC_RELEASE, "agent");
            asm volatile("s_waitcnt vmcnt(0)" ::: "memory");
            const unsigned og = xb_add(&bar[XB_TOP], 1u);
            const unsigned tg = og / nx;
            if (og + 1u == (tg + 1u) * nx) xb_add(&bar[XB_TOPGEN], 1u);
            else XB_SPIN(xb_ld(&bar[XB_TOPGEN]) == tg, bar);
            __builtin_amdgcn_fence(__ATOMIC_ACQUIRE, "agent");
            xb_add(&bar[XB_XGEN(b.x)], 1u);
            asm volatile("s_waitcnt vmcnt(0)" ::: "memory");
        } else {
            XB_SPIN(xb_ld(&bar[XB_XGEN(b.x)]) == gen, bar);
            __builtin_amdgcn_fence(__ATOMIC_ACQUIRE, "agent");
            asm volatile("s_waitcnt vmcnt(0)" ::: "memory");
        }
    }
    __syncthreads();
}

constexpr size_t WS_WIN = 20 * MiB;
constexpr size_t WS_WA = 40 * MiB;
constexpr size_t WS_WBR = 41 * MiB;
constexpr size_t WS_WOUT = 45 * MiB;
constexpr size_t WS_WFGU = 49 * MiB;
constexpr size_t WS_WFD = 60 * MiB;
constexpr size_t WS_WMGU = 66 * MiB;
constexpr size_t WS_WMD = 178 * MiB;
constexpr size_t WS_BAR = 4096;
constexpr int RING_BYTES = 131072, MISC_OFF = RING_BYTES + 320, PSTAT_OFF = RING_BYTES + 1024  , RSTD_OFF = RING_BYTES + 6144  , LDS_BYTES = 147456;

template <bool GAIN>
DEV void cvt_item_t(const float* W, int ldw, int k0, int n0, bf16* dst, int Kd, LAS float* scr, int lane, const float* gain) {
    const int c = lane & 7;
    f32x4 g0 = {1.f, 1.f, 1.f, 1.f}, g1 = g0;
    if (GAIN) { g0 = *(const f32x4*)(gain + k0 + 8 * c); g1 = *(const f32x4*)(gain + k0 + 8 * c + 4); }
#pragma unroll
    for (int i = 0; i < 32; ++i) { const int kk = 2 * i + (lane >> 5); scr[kk * 33 + (lane & 31)] = W[(size_t)(k0 + kk) * ldw + n0 + (lane & 31)]; }
    asm volatile("s_waitcnt lgkmcnt(0)" ::: "memory");
#pragma unroll
    for (int j = 0; j < 4; ++j) { const int n = (lane >> 3) + 8 * j; const LAS float* s = scr + (8 * c) * 33 + n;
        u32x4 o; o.x = pk2(s[0 * 33] * g0[0], s[1 * 33] * g0[1]); o.y = pk2(s[2 * 33] * g0[2], s[3 * 33] * g0[3]); o.z = pk2(s[4 * 33] * g1[0], s[5 * 33] * g1[1]); o.w = pk2(s[6 * 33] * g1[2], s[7 * 33] * g1[3]);
        *(u32x4*)(dst + (size_t)n * Kd + 8 * c) = o; }
    asm volatile("s_waitcnt lgkmcnt(0)" ::: "memory");
}
DEV void cvt_item(const float* W, int ldw, int k0, int n0, bf16* dst, int Kd, LAS float* scr, int lane) { cvt_item_t<false>(W, ldw, k0, n0, dst, Kd, scr, lane, nullptr); }
DEV void cvt_item_g(const float* W, int ldw, int k0, int n0, bf16* dst, int Kd, LAS float* scr, int lane, const float* gain) { cvt_item_t<true>(W, ldw, k0, n0, dst, Kd, scr, lane, gain); }


DEV float4 ldx4(const bf16* row, int idx) { const uint2 t = ((const uint2*)row)[idx]; return make_float4(__uint_as_float(t.x << 16), __uint_as_float(t.x & 0xffff0000u), __uint_as_float(t.y << 16), __uint_as_float(t.y & 0xffff0000u)); }
DEV int otid() { int t = threadIdx.x; asm volatile("" : "+v"(t)); return t; }
typedef float f32x16 __attribute__((ext_vector_type(16)));
typedef __bf16 bf16x2_t __attribute__((ext_vector_type(2)));
DEV unsigned pkbf(float lo, float hi) { const f32x2 v = {lo, hi}; return __builtin_bit_cast(unsigned, __builtin_convertvector(v, bf16x2_t)); }
#define MFMA32(a, b, c) __builtin_amdgcn_mfma_f32_32x32x16_bf16((a), (b), (c), 0, 0, 0)
DEV int crow(int reg, int h) { return (reg & 3) + 8 * (reg >> 2) + 4 * h; }
constexpr int VT_LD = 68;
constexpr size_t WS_DL = 2 * MiB;
constexpr size_t WS_SSQ = 2 * MiB + 262144;
constexpr size_t WS_BG = WS_LOGA;
constexpr size_t WS_SP = 458 * MiB;
constexpr size_t WS_WA2 = 40 * MiB + 131072;
#define PACK8(x, s) __builtin_bit_cast(bf16x8, (u32x4){pkbf((x)[8 * (s)], (x)[8 * (s) + 1]), pkbf((x)[8 * (s) + 2], (x)[8 * (s) + 3]), pkbf((x)[8 * (s) + 4], (x)[8 * (s) + 5]), pkbf((x)[8 * (s) + 6], (x)[8 * (s) + 7])})
DEV void stage_vt(const bf16* p, int m0, LAS bf16* vt, int tid) {
#pragma unroll
    for (int i = 0; i < 8; ++i) { const int idx = tid + 512 * i, t = idx & 63, c8 = idx >> 6;
        const u32x4 v = *(const u32x4*)(p + (size_t)(m0 + t) * PLD + P_V + c8 * 8);
        LAS bf16* dst = vt + (c8 * 8) * VT_LD + t;
        dst[0 * VT_LD] = (bf16)(v.x & 0xffffu); dst[1 * VT_LD] = (bf16)(v.x >> 16); dst[2 * VT_LD] = (bf16)(v.y & 0xffffu); dst[3 * VT_LD] = (bf16)(v.y >> 16);
        dst[4 * VT_LD] = (bf16)(v.z & 0xffffu); dst[5 * VT_LD] = (bf16)(v.z >> 16); dst[6 * VT_LD] = (bf16)(v.w & 0xffffu); dst[7 * VT_LD] = (bf16)(v.w >> 16); }
}
DEV bf16x8 vt_frag(const LAS bf16* vt, int vrow, int tbase, int hh) {
    const LAS bf16* s = vt + vrow * VT_LD + tbase + 4 * hh;
    const u32x2 lo = *(const LAS u32x2*)s, hi = *(const LAS u32x2*)(s + 8);
    return __builtin_bit_cast(bf16x8, (u32x4){lo.x, lo.y, hi.x, hi.y});
}
DEV void gla_pass1(LAS unsigned char* lds, const bf16* hb, const float* ssq, const bf16* p, const bf16* WaT, const bf16* Wa2T, const float* b_a, float* BG, float* U, float* DL, int item) {
    int tid_ = threadIdx.x; asm volatile("" : "+v"(tid_));
    const int tid = tid_, lane = tid & 63, w = __builtin_amdgcn_readfirstlane(tid >> 6), l31 = lane & 31, hh = lane >> 5, m0 = item * 64, h = w >> 1, kb = w & 1;
    LAS float* alowf = (LAS float*)lds;
    LAS bf16* alowb = (LAS bf16*)(lds + 8192);
    LAS bf16* vt = (LAS bf16*)(lds + 16384);
    const int j = 32 * w + l31;
    bf16x8 af[16], wf[16];
    {   const int tb4 = w & 3, kh = w >> 2, row = m0 + 16 * tb4 + (lane & 15), kofs = 512 * kh + 8 * (lane >> 4);
#pragma unroll
        for (int ks = 0; ks < 16; ++ks) { af[ks] = *(const bf16x8*)(hb + (size_t)row * D + kofs + 32 * ks); wf[ks] = *(const bf16x8*)(WaT + (size_t)(lane & 15) * D + kofs + 32 * ks); } }
    unsigned kraw[2][16];
#pragma unroll
    for (int tb = 0; tb < 2; ++tb)
#pragma unroll
        for (int r = 0; r < 16; ++r) kraw[tb][r] = p[(size_t)(m0 + 32 * tb + crow(r, hh)) * PLD + P_K + j];
    const bf16x8 wfrag = *(const bf16x8*)(Wa2T + j * 16 + 8 * hh);
    const float ba = b_a[j];
    {
        const int tb4 = w & 3, kh = w >> 2;
        f32x4 acc = {0.f, 0.f, 0.f, 0.f};
#pragma unroll
        for (int ks = 0; ks < 16; ++ks) acc = __builtin_amdgcn_mfma_f32_16x16x32_bf16(af[ks], wf[ks], acc, 0, 0, 0);
#pragma unroll
        for (int r = 0; r < 4; ++r) alowf[(kh * 64 + 16 * tb4 + 4 * (lane >> 4) + r) * 16 + (lane & 15)] = acc[r];
    }
    stage_vt(p, m0, vt, tid);
    __syncthreads();
    for (int i = tid; i < 1024; i += 512) alowb[i] = (bf16)f2bf((alowf[i] + alowf[1024 + i]) * row_rstd(ssq, m0 + (i >> 4)));
    __syncthreads();
    f32x16 bc[2]; float carry = 0.f;
#pragma unroll
    for (int tb = 0; tb < 2; ++tb) {
        const bf16x8 afrag = *(const LAS bf16x8*)(alowb + (32 * tb + l31) * 16 + 8 * hh);
        f32x16 z;
#pragma unroll
        for (int r = 0; r < 16; ++r) z[r] = 0.f;
        z = MFMA32(afrag, wfrag, z);
        float gs[4], other[4];
#pragma unroll
        for (int g = 0; g < 4; ++g) {
#pragma unroll
            for (int e = 0; e < 4; ++e) { const float zz = z[4 * g + e] + ba; const float la = (fminf(zz, 0.f) - __logf(1.0f + __expf(-fabsf(zz)))) * (1.0f / 16.0f); z[4 * g + e] = la + (e ? z[4 * g + e - 1] : 0.f); }
            gs[g] = z[4 * g + 3]; other[g] = __shfl_xor(gs[g], 32);
        }
        float run = carry;
#pragma unroll
        for (int g = 0; g < 4; ++g) { const float h0 = hh ? other[g] : gs[g], h1 = hh ? gs[g] : other[g]; const float off = run + (hh ? h0 : 0.f);
#pragma unroll
            for (int e = 0; e < 4; ++e) bc[tb][4 * g + e] = z[4 * g + e] + off;
            run += h0 + h1; }
        carry = run;
    }
    const float blast = carry;
#pragma unroll
    for (int tb = 0; tb < 2; ++tb)
#pragma unroll
        for (int r = 0; r < 16; ++r) BG[(size_t)(m0 + 32 * tb + crow(r, hh)) * KW + j] = bc[tb][r];
    if (hh == 0) DL[(size_t)(item * 4 + h) * 64 + 32 * kb + l31] = __expf(blast);
    f32x16 kh2[2];
#pragma unroll
    for (int tb = 0; tb < 2; ++tb)
#pragma unroll
        for (int r = 0; r < 16; ++r) kh2[tb][r] = bf2f(kraw[tb][r]) * __expf(blast - bc[tb][r]);
#pragma unroll
    for (int vb = 0; vb < 4; ++vb) {
        f32x16 acc;
#pragma unroll
        for (int r = 0; r < 16; ++r) acc[r] = 0.f;
        const int vrow = 128 * h + 32 * vb + l31;
#pragma unroll
        for (int tb = 0; tb < 2; ++tb) { acc = MFMA32(vt_frag(vt, vrow, 32 * tb, hh), PACK8(kh2[tb], 0), acc); acc = MFMA32(vt_frag(vt, vrow, 32 * tb + 16, hh), PACK8(kh2[tb], 1), acc); }
#pragma unroll
        for (int r = 0; r < 16; ++r) U[((size_t)(item * 4 + h) * 128 + 32 * vb + crow(r, hh)) * 64 + 32 * kb + l31] = acc[r];
    }
}
DEV void conv_item(bf16* p, const float* cw, int item) {
    int tid_ = threadIdx.x; asm volatile("" : "+v"(tid_));
    const int tid = tid_, c0 = (tid & 63) * 8, tr = tid >> 6, m0 = item * 64 + 8 * tr, ts0 = m0 % SEQ;
    u32x4 uv[10], bv[8];
#pragma unroll
    for (int i = 0; i < 10; ++i) { const bool ok = i >= 2 || ts0 > 0; const size_t r = (size_t)(ok ? m0 - 2 + i : m0) * PLD;
        uv[i] = *(const u32x4*)(p + r + P_U + c0); if (!ok) { uv[i] = (u32x4){0u, 0u, 0u, 0u}; } }
#pragma unroll
    for (int i = 0; i < 8; ++i) bv[i] = *(const u32x4*)(p + (size_t)(m0 + i) * PLD + P_GB + c0);
    float w0[8], w1[8], w2[8];
#pragma unroll
    for (int e = 0; e < 8; ++e) { w0[e] = cw[0 * CC + c0 + e]; w1[e] = cw[1 * CC + c0 + e]; w2[e] = cw[2 * CC + c0 + e]; }
    float u[10][8];
#pragma unroll
    for (int i = 0; i < 10; ++i) { u[i][0] = blo(uv[i].x); u[i][1] = bhi(uv[i].x); u[i][2] = blo(uv[i].y); u[i][3] = bhi(uv[i].y); u[i][4] = blo(uv[i].z); u[i][5] = bhi(uv[i].z); u[i][6] = blo(uv[i].w); u[i][7] = bhi(uv[i].w); }
#pragma unroll
    for (int tt = 0; tt < 8; ++tt) {
        const float gbv[8] = {blo(bv[tt].x), bhi(bv[tt].x), blo(bv[tt].y), bhi(bv[tt].y), blo(bv[tt].z), bhi(bv[tt].z), blo(bv[tt].w), bhi(bv[tt].w)};
        float y[8];
#pragma unroll
        for (int e = 0; e < 8; ++e) y[e] = gbv[e] * (w0[e] * u[tt][e] + w1[e] * u[tt + 1][e] + w2[e] * u[tt + 2][e]);
        u32x4 o; o.x = pkbf(y[0], y[1]); o.y = pkbf(y[2], y[3]); o.z = pkbf(y[4], y[5]); o.w = pkbf(y[6], y[7]);
        *(u32x4*)(p + (size_t)(m0 + tt) * PLD + P_GB + c0) = o;
    }
}
DEV void gla_scan(const float* U, const float* DL, bf16* Sp, int bx, int nthreads) {
    const int gtid = bx * 512 + otid();
    for (int idx = gtid; idx < BATCH * NH * 128 * 16; idx += nthreads) {
        const int bh = idx >> 11, v = (idx >> 4) & 127, k4 = idx & 15, b = bh >> 2, h = bh & 3;
        f32x4 S = {0.f, 0.f, 0.f, 0.f};
#pragma unroll 8
        for (int n = 0; n < SEQ / 64; ++n) { const int item = b * (SEQ / 64) + n; const size_t base = ((size_t)(item * 4 + h) * 128 + v) * 64 + k4 * 4;
            const f32x4 u = *(const f32x4*)(U + base), d = *(const f32x4*)(DL + (size_t)(item * 4 + h) * 64 + k4 * 4);
            u32x2 o; o.x = pkbf(S[0], S[1]); o.y = pkbf(S[2], S[3]); *(u32x2*)(Sp + base) = o;
            S = d * S + u; }
    }
}
DEV void gla_pass3(LAS unsigned char* lds, bf16* p, const float* BG, const bf16* Sp, const float* gn, int item, bf16* ydst, int yld) {
    int tid_ = threadIdx.x; asm volatile("" : "+v"(tid_));
    const int tid = tid_, lane = tid & 63, w = __builtin_amdgcn_readfirstlane(tid >> 6), l31 = lane & 31, hh = lane >> 5, m0 = item * 64, h = w >> 1, vh = w & 1;
    LAS float* ssb = (LAS float*)lds;
    LAS bf16* vt = (LAS bf16*)(lds + 16384);
    stage_vt(p, m0, vt, tid);
    bf16x8 qf[2][4], kf[2][4];
#pragma unroll
    for (int blk = 0; blk < 2; ++blk)
#pragma unroll
        for (int ks = 0; ks < 4; ++ks) { const size_t row = (size_t)(m0 + 32 * blk + l31); const int kk = 64 * h + 16 * ks + 8 * hh;
            const u32x4 qv = *(const u32x4*)(p + row * PLD + P_Q + kk), kv = *(const u32x4*)(p + row * PLD + P_K + kk);
            const f32x4 b0 = *(const f32x4*)(BG + row * KW + kk), b1 = *(const f32x4*)(BG + row * KW + kk + 4);
            float ep[8], em[8];
#pragma unroll
            for (int e = 0; e < 4; ++e) { ep[e] = 0.125f * __expf(b0[e]); ep[4 + e] = 0.125f * __expf(b1[e]); em[e] = __expf(-b0[e]); em[4 + e] = __expf(-b1[e]); }
            qf[blk][ks] = __builtin_bit_cast(bf16x8, (u32x4){pkbf(blo(qv.x) * ep[0], bhi(qv.x) * ep[1]), pkbf(blo(qv.y) * ep[2], bhi(qv.y) * ep[3]), pkbf(blo(qv.z) * ep[4], bhi(qv.z) * ep[5]), pkbf(blo(qv.w) * ep[6], bhi(qv.w) * ep[7])});
            kf[blk][ks] = __builtin_bit_cast(bf16x8, (u32x4){pkbf(blo(kv.x) * em[0], bhi(kv.x) * em[1]), pkbf(blo(kv.y) * em[2], bhi(kv.y) * em[3]), pkbf(blo(kv.z) * em[4], bhi(kv.z) * em[5]), pkbf(blo(kv.w) * em[6], bhi(kv.w) * em[7])}); }
    bf16x8 spf[2][4];
#pragma unroll
    for (int vb = 0; vb < 2; ++vb)
#pragma unroll
        for (int ks = 0; ks < 4; ++ks) spf[vb][ks] = *(const bf16x8*)(Sp + ((size_t)(item * 4 + h) * 128 + 64 * vh + 32 * vb + l31) * 64 + 16 * ks + 8 * hh);
    f32x16 X00, X01, X11;
#pragma unroll
    for (int r = 0; r < 16; ++r) { X00[r] = 0.f; X01[r] = 0.f; X11[r] = 0.f; }
#pragma unroll
    for (int ks = 0; ks < 4; ++ks) { X00 = MFMA32(kf[0][ks], qf[0][ks], X00); X01 = MFMA32(kf[0][ks], qf[1][ks], X01); X11 = MFMA32(kf[1][ks], qf[1][ks], X11); }
#pragma unroll
    for (int r = 0; r < 16; ++r) if (crow(r, hh) > l31) { X00[r] = 0.f; X11[r] = 0.f; }
    f32x4 gnv[2][4];
#pragma unroll
    for (int vb = 0; vb < 2; ++vb)
#pragma unroll
        for (int g = 0; g < 4; ++g) gnv[vb][g] = *(const f32x4*)(gn + 64 * vh + 32 * vb + 8 * g + 4 * hh);
    u32x2 gvv[2][2][4];
#pragma unroll
    for (int vb = 0; vb < 2; ++vb)
#pragma unroll
        for (int ib = 0; ib < 2; ++ib)
#pragma unroll
            for (int g = 0; g < 4; ++g) gvv[vb][ib][g] = *(const u32x2*)(p + (size_t)(m0 + 32 * ib + l31) * PLD + P_GO + 128 * h + 64 * vh + 32 * vb + 8 * g + 4 * hh);
    __syncthreads();
    f32x16 O[2][2];
#pragma unroll
    for (int vb = 0; vb < 2; ++vb) {
        f32x16 O0, O1;
#pragma unroll
        for (int r = 0; r < 16; ++r) { O0[r] = 0.f; O1[r] = 0.f; }
        const int vloc = 64 * vh + 32 * vb + l31, vrow = 128 * h + vloc;
#pragma unroll
        for (int ks = 0; ks < 4; ++ks) { const bf16x8 sf = spf[vb][ks]; O0 = MFMA32(sf, qf[0][ks], O0); O1 = MFMA32(sf, qf[1][ks], O1); }
        { const bf16x8 a0 = vt_frag(vt, vrow, 0, hh), a1 = vt_frag(vt, vrow, 16, hh), a2 = vt_frag(vt, vrow, 32, hh), a3 = vt_frag(vt, vrow, 48, hh);
          O0 = MFMA32(a0, PACK8(X00, 0), O0); O0 = MFMA32(a1, PACK8(X00, 1), O0);
          O1 = MFMA32(a0, PACK8(X01, 0), O1); O1 = MFMA32(a1, PACK8(X01, 1), O1);
          O1 = MFMA32(a2, PACK8(X11, 0), O1); O1 = MFMA32(a3, PACK8(X11, 1), O1); }
        O[vb][0] = O0; O[vb][1] = O1;
    }
    float ss0 = 0.f, ss1 = 0.f;
#pragma unroll
    for (int vb = 0; vb < 2; ++vb)
#pragma unroll
        for (int r = 0; r < 16; ++r) { ss0 += O[vb][0][r] * O[vb][0][r]; ss1 += O[vb][1][r] * O[vb][1][r]; }
    ss0 += __shfl_xor(ss0, 32); ss1 += __shfl_xor(ss1, 32);
    if (hh == 0) { ssb[w * 64 + l31] = ss0; ssb[w * 64 + 32 + l31] = ss1; }
    __syncthreads();
    float rstd[2];
#pragma unroll
    for (int ib = 0; ib < 2; ++ib) rstd[ib] = rsqrtf((ssb[(2 * h) * 64 + 32 * ib + l31] + ssb[(2 * h + 1) * 64 + 32 * ib + l31]) * (1.0f / 128.0f) + EPS);
#pragma unroll
    for (int vb = 0; vb < 2; ++vb)
#pragma unroll
        for (int ib = 0; ib < 2; ++ib)
#pragma unroll
            for (int g = 0; g < 4; ++g) { const int v0 = 64 * vh + 32 * vb + 8 * g + 4 * hh; bf16* dst = ydst + (size_t)(m0 + 32 * ib + l31) * yld + 128 * h + v0;
                const u32x2 gv = gvv[vb][ib][g]; const f32x4 gg = gnv[vb][g];
                const float g0 = blo(gv.x), g1 = bhi(gv.x), g2 = blo(gv.y), g3 = bhi(gv.y);
                u32x2 o; o.x = pkbf(O[vb][ib][4 * g] * rstd[ib] * gg[0] * g0 * fsig(g0), O[vb][ib][4 * g + 1] * rstd[ib] * gg[1] * g1 * fsig(g1));
                o.y = pkbf(O[vb][ib][4 * g + 2] * rstd[ib] * gg[2] * g2 * fsig(g2), O[vb][ib][4 * g + 3] * rstd[ib] * gg[3] * g3 * fsig(g3));
                *(u32x2*)dst = o; }
}

DEV void xb_rows(const float* x, bf16* xb, float* ssq, int gw, int ngw) {
    const int lane = otid() & 63;
    for (int m0 = gw; m0 < M; m0 += 2 * ngw) {
        const int m1 = m0 + ngw < M ? m0 + ngw : m0;
        const float4* xr0 = (const float4*)(x + (size_t)m0 * D); const float4* xr1 = (const float4*)(x + (size_t)m1 * D);
        float4 v0[4], v1[4];
#pragma unroll
        for (int j = 0; j < 4; ++j) { v0[j] = xr0[lane + 64 * j]; v1[j] = xr1[lane + 64 * j]; }
        uint2* o0 = (uint2*)(xb + (size_t)m0 * D); uint2* o1 = (uint2*)(xb + (size_t)m1 * D); float s0 = 0.f, s1 = 0.f;
#pragma unroll
        for (int j = 0; j < 4; ++j) { s0 += v0[j].x * v0[j].x + v0[j].y * v0[j].y + v0[j].z * v0[j].z + v0[j].w * v0[j].w; s1 += v1[j].x * v1[j].x + v1[j].y * v1[j].y + v1[j].z * v1[j].z + v1[j].w * v1[j].w;
            uint2 w; w.x = pk2(v0[j].x, v0[j].y); w.y = pk2(v0[j].z, v0[j].w); o0[lane + 64 * j] = w; w.x = pk2(v1[j].x, v1[j].y); w.y = pk2(v1[j].z, v1[j].w); o1[lane + 64 * j] = w; }
        s0 = wave_sum(s0); s1 = wave_sum(s1);
        if (lane < 4) { ssq[(size_t)lane * M + m0] = lane == 0 ? s0 : 0.f; ssq[(size_t)lane * M + m1] = lane == 0 ? s1 : 0.f; }
    }
}
DEV void rms_rows(const float* x, const float* g, bf16* hb, int gw, int ngw) {
    const int lane = otid() & 63;
    for (int m = gw; m < M; m += ngw) {
        const float4* xr = (const float4*)(x + (size_t)m * D); const float4* gr = (const float4*)g;
        float4 v[4]; float ss = 0.f;
#pragma unroll
        for (int j = 0; j < 4; ++j) { v[j] = xr[lane + 64 * j]; ss += v[j].x * v[j].x + v[j].y * v[j].y + v[j].z * v[j].z + v[j].w * v[j].w; }
        const float rstd = rsqrtf(wave_sum(ss) * (1.0f / D) + EPS);
        uint2* o = (uint2*)(hb + (size_t)m * D);
#pragma unroll
        for (int j = 0; j < 4; ++j) { const float4 gg = gr[lane + 64 * j]; uint2 w; w.x = pk2(v[j].x * rstd * gg.x, v[j].y * rstd * gg.y); w.y = pk2(v[j].z * rstd * gg.z, v[j].w * rstd * gg.w); o[lane + 64 * j] = w; }
    }
}
DEV void route1_stage(LAS float* wT, const float* g2, const float* wr) {
    const int tid = otid();
    for (int k = tid; k < D; k += 512) { const float g = g2[k]; const float4 w0 = *(const float4*)(wr + (size_t)k * 8), w1 = *(const float4*)(wr + (size_t)k * 8 + 4);
        wT[0 * D + k] = w0.x * g; wT[1 * D + k] = w0.y * g; wT[2 * D + k] = w0.z * g; wT[3 * D + k] = w0.w * g; wT[4 * D + k] = w1.x * g; wT[5 * D + k] = w1.y * g; wT[6 * D + k] = w1.z * g; wT[7 * D + k] = w1.w * g; }
    __syncthreads();
}
DEV void route1_grp(const LAS float* wT, LAS int* lcnt, const bf16* x, float* rstd_o, int* tok_e, float* tok_w, int* counts, int grp) {
    const int tid = otid(), lane = tid & 63, wave = tid >> 6;
    if (tid < 8) lcnt[tid] = 0;
    __syncthreads();
    const int hh = lane >> 5, b4 = (lane >> 4) & 1, b3 = (lane >> 3) & 1;
    uint2 xraw[8][4];
#pragma unroll
    for (int i = 0; i < 8; ++i)
#pragma unroll
        for (int j = 0; j < 4; ++j) xraw[i][j] = ((const uint2*)(x + (size_t)(grp * 64 + wave * 8 + i) * D))[lane + 64 * j];
#pragma unroll
    for (int i = 0; i < 8; ++i) {
        const int m = grp * 64 + wave * 8 + i;
        float4 v[4]; float ss = 0.f; float a[8];
#pragma unroll
        for (int e = 0; e < 8; ++e) a[e] = 0.f;
#pragma unroll
        for (int j = 0; j < 4; ++j) { const uint2 t = xraw[i][j]; v[j] = make_float4(blo(t.x), bhi(t.x), blo(t.y), bhi(t.y)); ss += v[j].x * v[j].x + v[j].y * v[j].y + v[j].z * v[j].z + v[j].w * v[j].w; }
#pragma unroll
        for (int j = 0; j < 4; ++j)
#pragma unroll
            for (int e = 0; e < 8; ++e) { const f32x4 w = *(const LAS f32x4*)(wT + e * D + 4 * (lane + 64 * j)); a[e] += v[j].x * w[0] + v[j].y * w[1] + v[j].z * w[2] + v[j].w * w[3]; }
        ss = wave_sum(ss);
        float c4[4], c2[2];
#pragma unroll
        for (int e = 0; e < 4; ++e) { const float keep = hh ? a[e + 4] : a[e], send = hh ? a[e] : a[e + 4]; c4[e] = keep + __shfl_xor(send, 32); }
#pragma unroll
        for (int e = 0; e < 2; ++e) { const float keep = b4 ? c4[e + 2] : c4[e], send = b4 ? c4[e] : c4[e + 2]; c2[e] = keep + __shfl_xor(send, 16); }
        float c1 = (b3 ? c2[1] : c2[0]) + __shfl_xor(b3 ? c2[0] : c2[1], 8);
        c1 += __shfl_xor(c1, 4); c1 += __shfl_xor(c1, 2); c1 += __shfl_xor(c1, 1);
        const float rstd = rsqrtf(ss * (1.0f / D) + EPS);
        float lg[8];
#pragma unroll
        for (int e = 0; e < 8; ++e) lg[e] = __uint_as_float(__builtin_amdgcn_readlane((int)__float_as_uint(c1), 32 * (e >> 2) + 16 * ((e >> 1) & 1) + 8 * (e & 1))) * rstd;
        int i1 = 0; float l1 = lg[0];
#pragma unroll
        for (int e = 1; e < 8; ++e) if (lg[e] > l1) { l1 = lg[e]; i1 = e; }
        int i2 = -1; float l2 = -3.0e38f;
#pragma unroll
        for (int e = 0; e < 8; ++e) if (e != i1 && lg[e] > l2) { l2 = lg[e]; i2 = e; }
        const float ex = expf(l2 - l1), w1v = 1.0f / (1.0f + ex), w2v = ex / (1.0f + ex);
        if (lane == 0) { rstd_o[m] = rstd; tok_e[m * 2] = i1; tok_e[m * 2 + 1] = i2; tok_w[m * 2] = w1v; tok_w[m * 2 + 1] = w2v;
            __hip_atomic_fetch_add(&lcnt[i1], 1, __ATOMIC_RELAXED, __HIP_MEMORY_SCOPE_WORKGROUP); __hip_atomic_fetch_add(&lcnt[i2], 1, __ATOMIC_RELAXED, __HIP_MEMORY_SCOPE_WORKGROUP); }
    }
    __syncthreads();
    if (tid < 8) counts[grp * 8 + tid] = lcnt[tid];
    __syncthreads();
}
DEV void route2_grp(LAS int* L, const bf16* x, const float* g2, const float* rstd_i, const int* counts, const int* tok_e, int* slot, unsigned char* hbp, int* tilet, int grp, int wgi, int nwg) {
    LAS int* ltot = L; LAS int* lpre = L + 8; LAS int* lseg = L + 16; LAS int* lslot = L + 32; LAS int* lte = L + 160;
    const int tid = otid(), lane = tid & 63, wave = tid >> 6;
    if (tid < 128) lte[tid] = tok_e[(grp * 64) * 2 + tid];
    { int tot = 0, pre = 0;
#pragma unroll
        for (int q = 0; q < 4; ++q) { const int w = lane + 64 * q; const int c = counts[w * 8 + wave]; tot += c; pre += (w < grp) ? c : 0; }
#pragma unroll
        for (int o = 1; o < 64; o <<= 1) { tot += __shfl_xor(tot, o); pre += __shfl_xor(pre, o); }
        if (lane == 0) { ltot[wave] = tot; lpre[wave] = pre; } }
    __syncthreads();
    if (tid == 0) { int off = 0; for (int e = 0; e < 8; ++e) { lseg[e] = off; off += ((ltot[e] + 255) / 256) * 256; } lseg[8] = off; }
    __syncthreads();
    { const int base = lseg[wave] + lpre[wave]; const bool m0 = lte[2 * lane] == wave, m1 = lte[2 * lane + 1] == wave;
        const unsigned long long b0 = __ballot(m0), b1 = __ballot(m1), lt = (1ull << lane) - 1ull;
        const int r0 = __popcll(b0 & lt) + __popcll(b1 & lt);
        if (m0) lslot[2 * lane] = base + r0;
        if (m1) lslot[2 * lane + 1] = base + r0 + (m0 ? 1 : 0); }
    __syncthreads();
    if (tid < 128) slot[(grp * 64) * 2 + tid] = lslot[tid];
    {   const float4* gr = (const float4*)g2; float4 gq[4];
#pragma unroll
        for (int j = 0; j < 4; ++j) gq[j] = gr[lane + 64 * j];
        uint2 xraw[8][4]; float rs[8];
#pragma unroll
        for (int q = 0; q < 8; ++q) { const int m = grp * 64 + wave + 8 * q; rs[q] = rstd_i[m];
#pragma unroll
            for (int j = 0; j < 4; ++j) xraw[q][j] = ((const uint2*)(x + (size_t)m * D))[lane + 64 * j]; }
#pragma unroll
        for (int q = 0; q < 8; ++q) { const int i = wave + 8 * q; const float rstd = rs[q];
            unsigned* o1 = (unsigned*)(hbp + (size_t)lslot[2 * i] * D); unsigned* o2 = (unsigned*)(hbp + (size_t)lslot[2 * i + 1] * D);
#pragma unroll
            for (int j = 0; j < 4; ++j) { const uint2 t = xraw[q][j]; const float4 gg = gq[j]; const unsigned w = pk4_fp8(blo(t.x) * rstd * gg.x, bhi(t.x) * rstd * gg.y, blo(t.y) * rstd * gg.z, bhi(t.y) * rstd * gg.w); o1[lane + 64 * j] = w; o2[lane + 64 * j] = w; } }
    }
    if (grp == 0) {
        if (tid < NTILE_MAX) { const int r = tid * 256; int e = -1; for (int q = 0; q < 8; ++q) if (r >= lseg[q] && r < lseg[q + 1]) e = q; tilet[tid] = e; }
        if (tid == 0) tilet[NTILE_MAX] = lseg[8] / 256;
    }
    if (grp == wgi) {
        for (int e = 0; e < 8; ++e) { const int r0 = lseg[e] + ltot[e], r1 = lseg[e + 1];
            for (int r = r0 + wgi; r < r1; r += nwg) if (tid < 256) ((unsigned*)(hbp + (size_t)r * D))[tid] = 0u; }
    }
    __syncthreads();
}
DEV float4 ld8x4(const unsigned char* row, int idx) { const int w = ((const int*)row)[idx]; const float k = 1.0f / OB_SCALE; return make_float4(__builtin_amdgcn_cvt_f32_fp8(w, 0) * k, __builtin_amdgcn_cvt_f32_fp8(w, 1) * k, __builtin_amdgcn_cvt_f32_fp8(w, 2) * k, __builtin_amdgcn_cvt_f32_fp8(w, 3) * k); }
DEV void combine_rows(const bf16* x, const unsigned char* obuf, const float* obx, const int* slot, const float* tok_w, const float* gf, float* out, int gw, int ngw) {
    const int lane = otid() & 63;
    const float4* gr = (const float4*)gf; float4 gq[4];
#pragma unroll
    for (int j = 0; j < 4; ++j) gq[j] = gr[lane + 64 * j];
    for (int m0 = gw; m0 < M; m0 += 2 * ngw) {
        const int mm[2] = {m0, m0 + ngw < M ? m0 + ngw : m0};
        int s1[2], s2[2]; float w1[2], w2[2];
#pragma unroll
        for (int q = 0; q < 2; ++q) { const int2 sl = *(const int2*)(slot + mm[q] * 2); const float2 tw = *(const float2*)(tok_w + mm[q] * 2); s1[q] = sl.x; s2[q] = sl.y; w1[q] = tw.x; w2[q] = tw.y; }
        float4 v[2][4], ea[2][4], ec[2][4];
        if (s1[0] < 128 * 256 && s2[0] < 128 * 256 && s1[1] < 128 * 256 && s2[1] < 128 * 256) {
            uint2 xa[2][4]; int oa[2][4], oc[2][4];
#pragma unroll
            for (int q = 0; q < 2; ++q)
#pragma unroll
                for (int j = 0; j < 4; ++j) { xa[q][j] = ((const uint2*)(x + (size_t)mm[q] * D))[lane + 64 * j]; oa[q][j] = ((const int*)(obuf + (size_t)s1[q] * D))[lane + 64 * j]; oc[q][j] = ((const int*)(obuf + (size_t)s2[q] * D))[lane + 64 * j]; }
            const float k8 = 1.0f / OB_SCALE;
#pragma unroll
            for (int q = 0; q < 2; ++q)
#pragma unroll
                for (int j = 0; j < 4; ++j) { v[q][j] = make_float4(blo(xa[q][j].x), bhi(xa[q][j].x), blo(xa[q][j].y), bhi(xa[q][j].y));
                    ea[q][j] = make_float4(__builtin_amdgcn_cvt_f32_fp8(oa[q][j], 0) * k8, __builtin_amdgcn_cvt_f32_fp8(oa[q][j], 1) * k8, __builtin_amdgcn_cvt_f32_fp8(oa[q][j], 2) * k8, __builtin_amdgcn_cvt_f32_fp8(oa[q][j], 3) * k8);
                    ec[q][j] = make_float4(__builtin_amdgcn_cvt_f32_fp8(oc[q][j], 0) * k8, __builtin_amdgcn_cvt_f32_fp8(oc[q][j], 1) * k8, __builtin_amdgcn_cvt_f32_fp8(oc[q][j], 2) * k8, __builtin_amdgcn_cvt_f32_fp8(oc[q][j], 3) * k8); }
        } else
#pragma unroll
        for (int q = 0; q < 2; ++q) {
            const bf16* xr = x + (size_t)mm[q] * D; const unsigned char* o1 = obuf + (size_t)s1[q] * D; const unsigned char* o2 = obuf + (size_t)s2[q] * D;
#pragma unroll
            for (int j = 0; j < 4; ++j) { v[q][j] = ldx4(xr, lane + 64 * j);
                if (s1[q] < 128 * 256) ea[q][j] = ld8x4(o1, lane + 64 * j);
                else { float4 e = make_float4(0.f, 0.f, 0.f, 0.f); for (int ks = 0; ks < KSPLIT; ++ks) { const float4 t = ((const float4*)(obx + ((size_t)ks * 2048 + (s1[q] - 128 * 256)) * D))[lane + 64 * j]; e.x += t.x; e.y += t.y; e.z += t.z; e.w += t.w; } ea[q][j] = e; }
                if (s2[q] < 128 * 256) ec[q][j] = ld8x4(o2, lane + 64 * j);
                else { float4 e = make_float4(0.f, 0.f, 0.f, 0.f); for (int ks = 0; ks < KSPLIT; ++ks) { const float4 t = ((const float4*)(obx + ((size_t)ks * 2048 + (s2[q] - 128 * 256)) * D))[lane + 64 * j]; e.x += t.x; e.y += t.y; e.z += t.z; e.w += t.w; } ec[q][j] = e; } }
        }
#pragma unroll
        for (int q = 0; q < 2; ++q) { float ss = 0.f;
#pragma unroll
            for (int j = 0; j < 4; ++j) { v[q][j].x += w1[q] * ea[q][j].x + w2[q] * ec[q][j].x; v[q][j].y += w1[q] * ea[q][j].y + w2[q] * ec[q][j].y; v[q][j].z += w1[q] * ea[q][j].z + w2[q] * ec[q][j].z; v[q][j].w += w1[q] * ea[q][j].w + w2[q] * ec[q][j].w;
                ss += v[q][j].x * v[q][j].x + v[q][j].y * v[q][j].y + v[q][j].z * v[q][j].z + v[q][j].w * v[q][j].w; }
            const float rstd = rsqrtf(wave_sum(ss) * (1.0f / D) + EPS);
            float4* orow = (float4*)(out + (size_t)mm[q] * D);
#pragma unroll
            for (int j = 0; j < 4; ++j) orow[lane + 64 * j] = make_float4(v[q][j].x * rstd * gq[j].x, v[q][j].y * rstd * gq[j].y, v[q][j].z * rstd * gq[j].z, v[q][j].w * rstd * gq[j].w); }
    }
}

DEV void cvt_item8(const float* W, int ldw, int k0, int n0, unsigned char* dst, int Kd, LAS float* scr, int lane) {
#pragma unroll
    for (int i = 0; i < 32; ++i) { const int kk = 2 * i + (lane >> 5); scr[kk * 33 + (lane & 31)] = W[(size_t)(k0 + kk) * ldw + n0 + (lane & 31)]; }
    asm volatile("s_waitcnt lgkmcnt(0)" ::: "memory");
    const int c = lane & 3;
#pragma unroll
    for (int j = 0; j < 2; ++j) { const int n = (lane >> 2) + 16 * j; const LAS float* sp = scr + (16 * c) * 33 + n;
        u32x4 o; o.x = pk4_fp8(sp[0 * 33] * W8_SCALE, sp[1 * 33] * W8_SCALE, sp[2 * 33] * W8_SCALE, sp[3 * 33] * W8_SCALE); o.y = pk4_fp8(sp[4 * 33] * W8_SCALE, sp[5 * 33] * W8_SCALE, sp[6 * 33] * W8_SCALE, sp[7 * 33] * W8_SCALE);
        o.z = pk4_fp8(sp[8 * 33] * W8_SCALE, sp[9 * 33] * W8_SCALE, sp[10 * 33] * W8_SCALE, sp[11 * 33] * W8_SCALE); o.w = pk4_fp8(sp[12 * 33] * W8_SCALE, sp[13 * 33] * W8_SCALE, sp[14 * 33] * W8_SCALE, sp[15 * 33] * W8_SCALE);
        *(u32x4*)(dst + (size_t)n * Kd + 16 * c) = o; }
    asm volatile("s_waitcnt lgkmcnt(0)" ::: "memory");
}
struct CvtD { const float* W; const float* gain; unsigned char* dst; int ldw, k0, n0, Kd, kind; };
DEV void cvt_load(const CvtD& d, int lane, float (&r)[32]) {
#pragma unroll
    for (int i = 0; i < 8; ++i) { const f32x4 t = *(const f32x4*)(d.W + (size_t)(d.k0 + 8 * i + (lane >> 3)) * d.ldw + d.n0 + 4 * (lane & 7)); r[4 * i] = t[0]; r[4 * i + 1] = t[1]; r[4 * i + 2] = t[2]; r[4 * i + 3] = t[3]; }
}
DEV void cvt_finish(const CvtD& d, const float (&r)[32], LAS float* scr, int lane) {
#pragma unroll
    for (int i = 0; i < 8; ++i)
#pragma unroll
        for (int e = 0; e < 4; ++e) scr[(8 * i + (lane >> 3)) * 33 + 4 * (lane & 7) + e] = r[4 * i + e];
    asm volatile("s_waitcnt lgkmcnt(0)" ::: "memory");
    if (d.kind == 2) {
        const int c = lane & 3;
#pragma unroll
        for (int j = 0; j < 2; ++j) { const int n = (lane >> 2) + 16 * j; const LAS float* sp = scr + (16 * c) * 33 + n;
            u32x4 o; o.x = pk4_fp8(sp[0 * 33] * W8_SCALE, sp[1 * 33] * W8_SCALE, sp[2 * 33] * W8_SCALE, sp[3 * 33] * W8_SCALE); o.y = pk4_fp8(sp[4 * 33] * W8_SCALE, sp[5 * 33] * W8_SCALE, sp[6 * 33] * W8_SCALE, sp[7 * 33] * W8_SCALE);
            o.z = pk4_fp8(sp[8 * 33] * W8_SCALE, sp[9 * 33] * W8_SCALE, sp[10 * 33] * W8_SCALE, sp[11 * 33] * W8_SCALE); o.w = pk4_fp8(sp[12 * 33] * W8_SCALE, sp[13 * 33] * W8_SCALE, sp[14 * 33] * W8_SCALE, sp[15 * 33] * W8_SCALE);
            *(u32x4*)(d.dst + (size_t)n * d.Kd + 16 * c) = o; }
    } else {
        const int c = lane & 7;
        f32x4 g0 = {1.f, 1.f, 1.f, 1.f}, g1 = g0;
        if (d.kind == 1) { g0 = *(const f32x4*)(d.gain + d.k0 + 8 * c); g1 = *(const f32x4*)(d.gain + d.k0 + 8 * c + 4); }
#pragma unroll
        for (int j = 0; j < 4; ++j) { const int n = (lane >> 3) + 8 * j; const LAS float* sp = scr + (8 * c) * 33 + n;
            u32x4 o; o.x = pk2(sp[0 * 33] * g0[0], sp[1 * 33] * g0[1]); o.y = pk2(sp[2 * 33] * g0[2], sp[3 * 33] * g0[3]); o.z = pk2(sp[4 * 33] * g1[0], sp[5 * 33] * g1[1]); o.w = pk2(sp[6 * 33] * g1[2], sp[7 * 33] * g1[3]);
            *(u32x4*)(d.dst + ((size_t)n * d.Kd + 8 * c) * 2) = o; }
    }
    asm volatile("s_waitcnt lgkmcnt(0)" ::: "memory");
}
struct Args { const float* in[18]; float* out; unsigned char* ws; int ph_lo, ph_hi; };
enum { PH_CVT = 0, PH_G1 = 1, PH_GLA1 = 2, PH_SCAN = 3, PH_GLA3 = 4, PH_G2 = 5, PH_G3 = 6, PH_RMS2 = 7, PH_UP = 8, PH_DOWN = 9, PH_RMS1 = 10, PH_LAYER = 16, PH_ROUTE1 = 23, PH_ROUTE2 = 24, PH_MUPA = 25, PH_MDOWNA = 26, PH_MUPB = 27, PH_MDOWNB = 28, PH_COMBINE = 29, PH_END = 30 };

__global__ void __launch_bounds__(512, 2) mega(Args args) {
    extern __shared__ __attribute__((aligned(16))) unsigned char lds_raw[];
    LAS unsigned char* lds = (LAS unsigned char*)lds_raw;
    const int wave = __builtin_amdgcn_readfirstlane((int)threadIdx.x >> 6);
    const int G = gridDim.x, bx = blockIdx.x;
    unsigned char* ws = args.ws;
    const int lo = args.ph_lo, hi = args.ph_hi;
#define IN(k) (lo <= (k) && (k) < hi)
#define SEAM(k) do { if ((k) + 1 < hi) { xcd_barrier(bar); if (DUP_PH == 99) xcd_barrier(bar); } } while (0)
    volatile LAS unsigned* MISC = (volatile LAS unsigned*)(lds + MISC_OFF);
    if (threadIdx.x < 16) MISC[threadIdx.x] = 0u;
    __syncthreads();
    XcdBarrier bar = xcd_barrier_post((unsigned*)(ws + WS_BAR), MISC + 8);
    const int gw = bx * 8 + wave, ngw = G * 8;
    if (IN(PH_CVT)) {
        const int tid = otid(), lane = tid & 63;
        LAS float* scr = (LAS float*)(lds + wave * 16384);
        const int NGW = ngw;
        constexpr int I_IN = 16 * 160, I_BR = 8 * 32, I_OUT = 16 * 32, I_FGU = 16 * 88, I_FD = 44 * 32, I_MGU = 16 * 112, I_MD = 56 * 32;
        constexpr int I_LAYER = I_IN + 2 * I_BR + I_OUT, I_FFN = 2 * I_FGU + I_FD, I_EXP = 2 * I_MGU + I_MD, NITEMS = 2 * I_LAYER + I_FFN + 8 * I_EXP;
        auto decode = [&](int it) -> CvtD {
            CvtD d; int r = it;
            if (r < 2 * I_LAYER) { const int l = r / I_LAYER; r -= l * I_LAYER;
                if (r < I_IN) { const int kb = r / 160, nb = r % 160, n0d = nb * 32, tpn = n0d >> 8, r0 = n0d & 255;
                    int n0s; if (tpn < 4) n0s = r0 < 128 ? 128 * tpn + r0 : 1024 + 128 * tpn + (r0 - 128); else if (tpn < 6) n0s = 512 + 256 * (tpn - 4) + r0; else { const int c = 1536 + 256 * (tpn - 6) + r0; n0s = c < 3072 ? c : c + 16; }
                    d.W = args.in[2] + (size_t)l * D * IN_COLS; d.ldw = IN_COLS; d.k0 = kb * 64; d.n0 = n0s; d.dst = ws + WS_WIN + (((size_t)l * NW1 + n0d) * D + kb * 64) * 2; d.Kd = D; d.gain = args.in[1] + l * D; d.kind = 1; return d; }
                r -= I_IN;
                if (r < 2 * I_BR) { const int br = r / I_BR; r -= br * I_BR; const int kb = r / 32, nb = r % 32;
                    d.W = args.in[7] + (size_t)(l * 2 + br) * CC * D; d.ldw = D; d.k0 = kb * 64; d.n0 = nb * 32; d.dst = ws + WS_WBR + (((size_t)(l * 2 + br) * D + nb * 32) * CC + kb * 64) * 2; d.Kd = CC; d.gain = nullptr; d.kind = 0; return d; }
                r -= 2 * I_BR;
                { const int kb = r / 32, nb = r % 32; d.W = args.in[8] + (size_t)l * D * D; d.ldw = D; d.k0 = kb * 64; d.n0 = nb * 32; d.dst = ws + WS_WOUT + (((size_t)l * D + nb * 32) * D + kb * 64) * 2; d.Kd = D; d.gain = nullptr; d.kind = 0; return d; }
            }
            r -= 2 * I_LAYER;
            if (r < I_FFN) {
                if (r < 2 * I_FGU) { const int up = r / I_FGU; r -= up * I_FGU; const int kb = r / 88, nb = r % 88, n0 = nb * 32, drow = (n0 >> 7) * 256 + up * 128 + (n0 & 127);
                    d.W = args.in[10 + up]; d.ldw = DFF; d.k0 = kb * 64; d.n0 = n0; d.dst = ws + WS_WFGU + ((size_t)drow * D + kb * 64) * 2; d.Kd = D; d.gain = args.in[9]; d.kind = 1; return d; }
                r -= 2 * I_FGU;
                { const int kb = r / 32, nb = r % 32; d.W = args.in[12]; d.ldw = D; d.k0 = kb * 64; d.n0 = nb * 32; d.dst = ws + WS_WFD + ((size_t)(nb * 32) * DFF + kb * 64) * 2; d.Kd = DFF; d.gain = nullptr; d.kind = 0; return d; }
            }
            r -= I_FFN;
            { const int e = r / I_EXP; r -= e * I_EXP;
                if (r < 2 * I_MGU) { const int up = r / I_MGU; r -= up * I_MGU; const int kb = r / 112, nb = r % 112, n0 = nb * 32, drow = (n0 >> 7) * 256 + up * 128 + (n0 & 127);
                    d.W = args.in[14 + up] + (size_t)e * D * DFE; d.ldw = DFE; d.k0 = kb * 64; d.n0 = n0; d.dst = ws + WS_WMGU + ((size_t)e * 2 * DFE + drow) * D + kb * 64; d.Kd = D; d.gain = nullptr; d.kind = 2; return d; }
                r -= 2 * I_MGU;
                { const int kb = r / 32, nb = r % 32; d.W = args.in[16] + (size_t)e * DFE * D; d.ldw = D; d.k0 = kb * 64; d.n0 = nb * 32; d.dst = ws + WS_WMD + ((size_t)e * D + nb * 32) * DFE + kb * 64; d.Kd = DFE; d.gain = nullptr; d.kind = 2; return d; } }
        };
        if (gw < NITEMS) {
            int it = gw; CvtD d = decode(it); float r[32]; cvt_load(d, lane, r);
            for (;;) {
                const int nx = it + NGW;
                if (nx < NITEMS) { const CvtD dn = decode(nx); float rn[32]; cvt_load(dn, lane, rn); cvt_finish(d, r, scr, lane); d = dn;
#pragma unroll
                    for (int i = 0; i < 32; ++i) r[i] = rn[i];
                    it = nx; }
                else { cvt_finish(d, r, scr, lane); break; }
            }
        }
        for (int i = bx * 512 + tid; i < 2 * RANK * D; i += G * 512) { const int l = i / (RANK * D), n = (i / D) % RANK, k = i % D; ((bf16*)(ws + WS_WA))[i] = (bf16)f2bf(args.in[2][(size_t)l * D * IN_COLS + (size_t)k * IN_COLS + 3072 + n] * args.in[1][l * D + k]); }
        for (int i = bx * 512 + tid; i < 2 * KW * RANK; i += G * 512) { const int l = i / (KW * RANK), j = (i / RANK) % KW, r = i % RANK; ((bf16*)(ws + WS_WA2))[i] = (bf16)f2bf(args.in[3][(size_t)l * RANK * KW + r * KW + j]); }
        xb_rows(args.in[0], (bf16*)(ws + WS_HB), (float*)(ws + WS_SSQ), gw, ngw);
        __syncthreads();
        SEAM(PH_CVT);
    }
    for (int l = 0; l < 2; ++l) {
        const int pb = l * PH_LAYER;
        bf16* p = (bf16*)(ws + WS_P); bf16* hb = (bf16*)(ws + WS_HB); bf16* merged = (bf16*)(ws + WS_U);
        if (IN(pb + PH_G1)) {
            SchedGrid S{(const char*)hb, (const char*)((bf16*)(ws + WS_WIN) + (size_t)l * NW1 * D), (size_t)256 * D * 2, (size_t)256 * D * 2, M / 256, NW1 / 256, G, bx};
            fill_rstd((LAS float*)(lds + RSTD_OFF), S, (const float*)(ws + WS_SSQ));
            for (int rep_ = 0; rep_ < NREP(pb + PH_G1); ++rep_) pg8::gemm_phase<EG1, SchedGrid, true, true>(lds, D, D, D, S, EG1{p, (const LAS float*)(lds + RSTD_OFF)});
            SEAM(pb + PH_G1);
        }
        if (IN(pb + PH_GLA1)) {
            for (int rep_ = 0; rep_ < NREP(pb + PH_GLA1); ++rep_)
            for (int item = bx; item < M / 64; item += G) {
                if (rep_ == NREP(pb + PH_GLA1) - 1) conv_item(p, args.in[5] + l * 3 * CC, item);
                gla_pass1(lds, hb, (const float*)(ws + WS_SSQ), p, (const bf16*)(ws + WS_WA) + (size_t)l * RANK * D, (const bf16*)(ws + WS_WA2) + (size_t)l * KW * RANK, args.in[4] + l * KW, (float*)(ws + WS_BG), (float*)(ws + WS_U), (float*)(ws + WS_DL), item);
                __syncthreads();
            }
            SEAM(pb + PH_GLA1);
        }
        if (IN(pb + PH_SCAN)) { for (int rep_ = 0; rep_ < NREP(pb + PH_SCAN); ++rep_) gla_scan((const float*)(ws + WS_U), (const float*)(ws + WS_DL), (bf16*)(ws + WS_SP), bx, G * 512); SEAM(pb + PH_SCAN); }
        if (IN(pb + PH_GLA3)) {
            for (int rep_ = 0; rep_ < NREP(pb + PH_GLA3); ++rep_)
            for (int item = bx; item < M / 64; item += G) { const bool lastrep = rep_ == NREP(pb + PH_GLA3) - 1;
                gla_pass3(lds, p, (const float*)(ws + WS_BG), (const bf16*)(ws + WS_SP), args.in[6] + l * DV, item, lastrep ? p + P_GO : (bf16*)(ws + WS_ACTP), lastrep ? PLD : VW); __syncthreads(); }
            SEAM(pb + PH_GLA3);
        }
        if (IN(pb + PH_G2)) {
            const bf16* wb = (const bf16*)(ws + WS_WBR) + (size_t)l * 2 * D * CC;
            SchedPair S{(const char*)(p + P_GB), (const char*)(p + P_GO), (const char*)wb, (const char*)(wb + (size_t)D * CC), (size_t)256 * PLD * 2, (size_t)256 * CC * 2, M / 256, D / 256, G, bx};
            for (int rep_ = 0; rep_ < NREP(pb + PH_G2); ++rep_) pg8::gemm_phase<EMerge, SchedPair, true, true>(lds, CC, PLD, CC, S, EMerge{merged, p});
            SEAM(pb + PH_G2);
        }
        if (IN(pb + PH_G3)) {
            SchedGrid S{(const char*)merged, (const char*)((bf16*)(ws + WS_WOUT) + (size_t)l * D * D), (size_t)256 * D * 2, (size_t)256 * D * 2, M / 256, D / 256, G, bx};
            if (l == 0) { for (int rep_ = 0; rep_ < NREP(pb + PH_G3); ++rep_) pg8::gemm_phase<ERes, SchedGrid, true, true>(lds, D, D, D, S, ERes{hb, (float*)(ws + WS_SSQ), (LAS float*)(lds + PSTAT_OFF)}); }
            else pg8::gemm_phase<EResT<false>, SchedGrid, true, true>(lds, D, D, D, S, EResT<false>{hb, nullptr, nullptr});
            SEAM(pb + PH_G3);
        }
        if (l == 0) {
            bf16* act = (bf16*)(ws + WS_P);
            if (IN(PH_UP)) {
                SchedGrid S{(const char*)hb, (const char*)(ws + WS_WFGU), (size_t)256 * D * 2, (size_t)256 * D * 2, M / 256, 2 * DFF / 256, G, bx};
                fill_rstd((LAS float*)(lds + RSTD_OFF), S, (const float*)(ws + WS_SSQ));
                for (int rep_ = 0; rep_ < NREP(PH_UP); ++rep_) pg8::gemm_phase<ESwiglu, SchedGrid, true, true>(lds, D, D, D, S, ESwiglu{act, DFF, (const LAS float*)(lds + RSTD_OFF)});
                SEAM(PH_UP);
            }
            if (IN(PH_DOWN)) {
                SchedGrid S{(const char*)act, (const char*)(ws + WS_WFD), (size_t)256 * DFF * 2, (size_t)256 * DFF * 2, M / 256, D / 256, G, bx};
                pg8::gemm_phase<ERes, SchedGrid, true, true>(lds, DFF, DFF, DFF, S, ERes{hb, (float*)(ws + WS_SSQ), (LAS float*)(lds + PSTAT_OFF)});
                SEAM(PH_DOWN);
            }
        } else {
            int* tilet = (int*)(ws + WS_TILE); unsigned char* hbp = ws + WS_HBP; unsigned char* actp = ws + WS_ACTP; unsigned char* obuf = ws + WS_OBUF;
            int* counts = (int*)(ws + WS_CNT); int* tok_e = (int*)(ws + WS_TOKE); float* tok_w = (float*)(ws + WS_TOKW); int* slot = (int*)(ws + WS_SLOT); float* rstd = (float*)(ws + WS_RSTD);
            if (IN(PH_ROUTE1)) { route1_stage((LAS float*)lds, args.in[9] + D, args.in[13]);
                for (int rep_ = 0; rep_ < NREP(PH_ROUTE1); ++rep_) for (int grp = bx; grp < M / 64; grp += G) route1_grp((const LAS float*)lds, (LAS int*)(lds + 32768), hb, rstd, tok_e, tok_w, counts, grp); SEAM(PH_ROUTE1); }
            if (IN(PH_ROUTE2)) { for (int rep_ = 0; rep_ < NREP(PH_ROUTE2); ++rep_) for (int grp = bx; grp < M / 64; grp += G) route2_grp((LAS int*)lds, hb, args.in[9] + D, rstd, counts, tok_e, slot, hbp, tilet, grp, bx, G); SEAM(PH_ROUTE2); }
            {
                int nT = 0; if (IN(PH_MUPA) || IN(PH_MDOWNA)) nT = tilet[NTILE_MAX];
                const int nFull = nT < 128 ? nT : 128, nL = nT > 128 ? nT - 128 : 0;
                if (IN(PH_MUPA)) {
                    SchedMoe S{(const char*)hbp, (const char*)(ws + WS_WMGU), tilet, (size_t)256 * D, (size_t)256 * D, (size_t)2 * DFE * D, 0, nT, 2 * DFE / 256, G, bx};
                    for (int rep_ = 0; rep_ < NREP(PH_MUPA); ++rep_) pg8::gemm_phase<ESwiglu8, SchedMoe, true, true, true>(lds, D / 2, D / 2, D / 2, S, ESwiglu8{actp, DFE, W8_INV});
                    SEAM(PH_MUPA);
                }
                if (IN(PH_MDOWNA)) {
                    SchedMoe S{(const char*)actp, (const char*)(ws + WS_WMD), tilet, (size_t)256 * DFE, (size_t)256 * DFE, (size_t)D * DFE, 0, nFull, D / 256, G, bx};
                    for (int rep_ = 0; rep_ < NREP(PH_MDOWNA); ++rep_) pg8::gemm_phase<EOut8, SchedMoe, true, true, true>(lds, DFE / 2, DFE / 2, DFE / 2, S, EOut8{obuf, W8_INV * OB_SCALE});
                    SchedMoeK SK{(const char*)actp, (const char*)(ws + WS_WMD), tilet, nL, G, bx};
                    pg8::gemm_phase<ESlab, SchedMoeK, true, true, true>(lds, KSLICE / 2, DFE / 2, DFE / 2, SK, ESlab{(float*)(ws + WS_OBX), W8_INV});
                    SEAM(PH_MDOWNA);
                }
            }
            if (IN(PH_COMBINE)) combine_rows(hb, obuf, (const float*)(ws + WS_OBX), slot, tok_w, args.in[17], args.out, gw, ngw);
        }
    }
#undef IN
}

extern "C" void kernel_launch(void* const* d_in, const int* in_sizes, int n_in, void* d_out, int out_size, void* d_ws, size_t ws_size, hipStream_t stream) {
    (void)in_sizes;
    if (n_in != 18 || out_size != M * D || ws_size < WS_END) { fprintf(stderr, "kernel_launch: unexpected arguments (n_in %d out %d ws %zu)\n", n_in, out_size, ws_size); return; }
    static int grid = 0;
    if (grid == 0) {
        int dev = 0, cus = 0;
        if (hipGetDevice(&dev) != hipSuccess || hipDeviceGetAttribute(&cus, hipDeviceAttributeMultiprocessorCount, dev) != hipSuccess) { fprintf(stderr, "kernel_launch: device query failed\n"); grid = -1; return; }
        if (hipFuncSetAttribute((const void*)mega, hipFuncAttributeMaxDynamicSharedMemorySize, LDS_BYTES) != hipSuccess) { fprintf(stderr, "kernel_launch: hipFuncSetAttribute failed\n"); grid = -1; return; }
        grid = cus;
    }
    if (grid < 0) return;
    Args a{};
    for (int i = 0; i < 18; ++i) a.in[i] = (const float*)d_in[i];
    a.out = (float*)d_out; a.ws = (unsigned char*)d_ws;
#define MEGA(lo_, hi_) do { a.ph_lo = (lo_); a.ph_hi = (hi_); hipLaunchKernelGGL(mega, dim3(grid), dim3(512), LDS_BYTES, stream, a); } while (0)
    if (hipMemsetAsync(d_ws, 0, 65536, stream) != hipSuccess) { fprintf(stderr, "kernel_launch: memset failed\n"); return; }
#if MK_SPLIT
    { const int ph[] = {0, 1, 2, 3, 4, 5, 6, 7, 8, 9, 10, 17, 18, 19, 20, 21, 22, 23, 24, 25, 26, 27, 28, 29}; for (int i = 0; i < 24; ++i) MEGA(ph[i], ph[i] + 1); }
#else
    MEGA(0, PH_END);
#endif
}
```

```cpp
#include <hip/hip_runtime.h>
#include <cstdio>
#include <cstdint>
#include <cstddef>
#ifndef MK_SPLIT
#define MK_SPLIT 0
#endif
#ifndef DUP_PH
#define DUP_PH -1
#endif
#define NREP(k) (((k) == (DUP_PH)) ? 2 : 1)

typedef unsigned short bf16;
#define DEV __device__ __forceinline__

constexpr int D = 1024, BATCH = 8, SEQ = 2048, M = BATCH * SEQ;
constexpr int CC = 512, KW = 256, VW = 512, RANK = 16, NH = 4, DK = 64, DV = 128;
constexpr int IN_COLS = 5136, NW1 = 5120  , PLD = 3584  ;
constexpr int P_U = 0, P_GB = 512, P_Q = 1024, P_K = 1280, P_V = 1536, P_GO = 2048, PB_GA = 5120, PB_GBB = 6144;
constexpr int DFF = 2816, NE = 8, DFE = 3584;
constexpr float EPS = 1e-6f;
constexpr int PERM_ROWS = 2 * M + NE * 256;
constexpr int NTILE_MAX = PERM_ROWS / 256;
constexpr int CHUNK_TILES = 64;
constexpr int KSPLIT = 7, KSLICE = DFE / KSPLIT;

constexpr size_t MiB = 1ull << 20;
constexpr size_t WS_CNT = 1 * MiB;
constexpr size_t WS_TILE = 1 * MiB + 16384;
constexpr size_t WS_TOKE = 1 * MiB + 65536;
constexpr size_t WS_TOKW = WS_TOKE + 131072;
constexpr size_t WS_SLOT = WS_TOKW + 131072;
constexpr size_t WS_RSTD = WS_SLOT + 131072;
constexpr size_t WS_ALOW = 3 * MiB;
constexpr size_t WS_LOGA = 4 * MiB;
constexpr size_t WS_HB = 234 * MiB;
constexpr size_t WS_P = 266 * MiB;
constexpr size_t WS_U = 426 * MiB;
constexpr size_t WS_ACTP = 266 * MiB;
constexpr size_t WS_HBP = 385 * MiB;
constexpr size_t WS_OBUF = 419 * MiB;
constexpr size_t WS_OBX = 4 * MiB;
constexpr size_t WS_END = 489 * MiB;

DEV float bf2f(unsigned v) { return __uint_as_float(v << 16); }
DEV unsigned f2bf(float f) { unsigned u = __float_as_uint(f); return (u + 0x7fffu + ((u >> 16) & 1u)) >> 16; }
DEV unsigned pk2(float lo, float hi) { return f2bf(lo) | (f2bf(hi) << 16); }
DEV float wave_sum(float v) {
#pragma unroll
    for (int o = 1; o < 64; o <<= 1) v += __shfl_xor(v, o);
    return v;
}

DEV float row_rstd(const float* ssq, int row) { return rsqrtf(((ssq[row] + ssq[M + row]) + (ssq[2 * M + row] + ssq[3 * M + row])) * (1.0f / D) + EPS); }
#define LAS __attribute__((address_space(3)))
typedef short bf16x8 __attribute__((ext_vector_type(8)));
typedef float f32x4 __attribute__((ext_vector_type(4)));
typedef float f32x2 __attribute__((ext_vector_type(2)));
typedef unsigned u32x4 __attribute__((ext_vector_type(4)));
typedef unsigned u32x2 __attribute__((ext_vector_type(2)));
DEV unsigned cvt_pk_bf16(float lo, float hi) { unsigned r; asm volatile("v_cvt_pk_bf16_f32 %0, %1, %2" : "=v"(r) : "v"(lo), "v"(hi)); return r; }
DEV float fsig(float x) { return __builtin_amdgcn_rcpf(1.0f + __builtin_amdgcn_exp2f(-1.44269504f * x)); }
DEV float blo(unsigned w) { return __uint_as_float(w << 16); }
DEV float bhi(unsigned w) { return __uint_as_float(w & 0xffff0000u); }

typedef int i32x4 __attribute__((ext_vector_type(4)));
typedef int i32x8 __attribute__((ext_vector_type(8)));
DEV i32x8 cat8(bf16x8 lo, bf16x8 hi) { return __builtin_shufflevector(__builtin_bit_cast(i32x4, lo), __builtin_bit_cast(i32x4, hi), 0, 1, 2, 3, 4, 5, 6, 7); }
DEV unsigned pk4_fp8(float a, float b, float c, float d) { int w = 0; w = __builtin_amdgcn_cvt_pk_fp8_f32(a, b, w, false); w = __builtin_amdgcn_cvt_pk_fp8_f32(c, d, w, true); return (unsigned)w; }
constexpr float W8_SCALE = 64.0f, W8_INV = 1.0f / 64.0f;
namespace pg8 {
constexpr int BM = 256, BK = 64, HALF = 128, HTB = HALF * BK * 2, STAGE_BYTES = 8 * HTB, NXCD = 8, WGM = 8;
__host__ __device__ __forceinline__ int lds_byte(int r, int c) { const int st = (r >> 4) * 2 + (c >> 5), rr = r & 15, cc = c & 31, ob = rr * 64 + cc * 2; return st * 1024 + (ob ^ (((ob >> 9) & 1) << 5)); }
__host__ __device__ __forceinline__ void stage_rc(int b, int& R, int& C) { const int st = b / 1024, sb = b % 1024, swz = sb ^ (((sb >> 9) & 1) << 5); R = (st >> 1) * 16 + swz / 64; C = (st & 1) * 32 + (swz % 64) / 2; }
__host__ __device__ __forceinline__ int perm32(int rho) { const int n = rho >> 4, i = rho & 15; return 8 * (i >> 2) + 4 * n + (i & 3); }

struct Unit { const char* A; const char* B; int pm, pn, aux; };
DEV bool tile_of(int L, int nM, int nN, int& pm, int& pn) {
    const int nwg = nM * nN; if (L >= nwg) return false;
    int wgid = L; { const int q = nwg / NXCD, r = nwg % NXCD, xcd = wgid % NXCD, off = wgid / NXCD; wgid = (xcd < r ? xcd * (q + 1) : r * (q + 1) + (xcd - r) * q) + off; }
    const int nig = WGM * nN, gid = wgid / nig, fm = gid * WGM, gsz = (nM - fm) < WGM ? (nM - fm) : WGM;
    pm = fm + ((wgid % nig) % gsz); pn = (wgid % nig) / gsz; return true;
}

template <class Epi, class Sched, bool ALIGN_EPI, bool SP2, bool FP8 = false>
DEV void gemm_phase(LAS unsigned char* lds, const int K, const int lda, const int ldb, const Sched& S, const Epi& E) {
    int tid_ = threadIdx.x; asm volatile("" : "+v"(tid_));
    const int tid = tid_, wid = __builtin_amdgcn_readfirstlane(tid >> 6), lane = tid & 63, wr = wid >> 2, wc = wid & 3, fr = lane & 15, fq = lane >> 4;
    const int nt = K / BK;
    unsigned voffA[2], voffB[2];
#pragma unroll
    for (int i = 0; i < 2; ++i) { int R, C; stage_rc(tid * 16 + i * 8192, R, C); const int Rb = Epi::PERM ? ((R & ~31) + perm32(R & 31)) : R;
        voffA[i] = (unsigned)(R * lda + C) * 2u; voffB[i] = (unsigned)(Rb * ldb + C) * 2u; }
    const size_t kstep = (size_t)(BK * 2);
    const size_t hstepA = (size_t)HALF * lda * 2, hstepB = (size_t)HALF * ldb * 2;
    const unsigned ldsw = (unsigned)wid * 1024u;
    const int aoff = FP8 ? lds_byte(wr * 64 + fr, fq * 16) : lds_byte(wr * 64 + fr, fq * 8), boff = FP8 ? lds_byte(wc * 32 + fr, fq * 16) : lds_byte(wc * 32 + fr, fq * 8);

#define PG8_SA(b, h) (((b) * 2 + (h)) * HTB)
#define PG8_SB(b, h) ((4 + (b) * 2 + (h)) * HTB)
#define PG8_STAGE(bufoff, gbase, voff) do { _Pragma("unroll") for (int _i = 0; _i < 2; ++_i) \
        __builtin_amdgcn_global_load_lds((const unsigned*)((const char*)(gbase) + (voff)[_i]), (LAS unsigned*)(lds + (bufoff) + ldsw + _i * 8192), 16, 0, 0); } while (0)
#define PG8_RD(off) (*(const LAS bf16x8*)(lds + (off)))
#define PG8_LDA(dst, b, h) do { if constexpr (FP8) { _Pragma("unroll") for (int m = 0; m < 4; ++m) dst##8[m] = cat8(PG8_RD(PG8_SA(b, h) + aoff + m * 2048), PG8_RD(PG8_SA(b, h) + aoff + m * 2048 + 16)); } \
        else { _Pragma("unroll") for (int m = 0; m < 4; ++m) _Pragma("unroll") for (int k = 0; k < 2; ++k) dst[m][k] = PG8_RD(PG8_SA(b, h) + aoff + m * 2048 + k * 1024); } } while (0)
#define PG8_LDB(dst, b, h) do { if constexpr (FP8) { _Pragma("unroll") for (int n = 0; n < 2; ++n) dst##8[n] = cat8(PG8_RD(PG8_SB(b, h) + boff + n * 2048), PG8_RD(PG8_SB(b, h) + boff + n * 2048 + 16)); } \
        else { _Pragma("unroll") for (int n = 0; n < 2; ++n) _Pragma("unroll") for (int k = 0; k < 2; ++k) dst[n][k] = PG8_RD(PG8_SB(b, h) + boff + n * 2048 + k * 1024); } } while (0)
#define PG8_MMA(ai, bj, At, Bt) do { __builtin_amdgcn_s_setprio(1); _Pragma("unroll") for (int m = 0; m < 4; ++m) _Pragma("unroll") for (int n = 0; n < 2; ++n) { \
        if constexpr (FP8) asm volatile("v_mfma_scale_f32_16x16x128_f8f6f4 %0, %1, %2, %0, %3, %3 op_sel_hi:[0,0,0]" : "+v"(acc[ai][bj][m][n]) : "v"(Bt##8[n]), "v"(At##8[m]), "v"(one8)); \
        else { _Pragma("unroll") for (int k = 0; k < 2; ++k) acc[ai][bj][m][n] = __builtin_amdgcn_mfma_f32_16x16x32_bf16(Bt[n][k], At[m][k], acc[ai][bj][m][n], 0, 0, 0); } } __builtin_amdgcn_s_setprio(0); } while (0)
#define PG8_WAIT_V(n) asm volatile("s_waitcnt vmcnt(" #n ")" ::: "memory")
#define PG8_WAIT_L(n) asm volatile("s_waitcnt lgkmcnt(" #n ")" ::: "memory")
#define PG8_BAR __builtin_amdgcn_s_barrier()
#define PG8_SCHED __builtin_amdgcn_sched_barrier(0)
    Unit cur, nxt; int ui = 0;
    if (!S.next(0, cur)) return;
    f32x4 acc[2][2][4][2];
#pragma unroll
    for (int a = 0; a < 2; ++a)
#pragma unroll
        for (int b = 0; b < 2; ++b)
#pragma unroll
            for (int m = 0; m < 4; ++m)
#pragma unroll
                for (int n = 0; n < 2; ++n) acc[a][b][m][n] = (f32x4){0.f, 0.f, 0.f, 0.f};
    const int one8 = 0x7F7F7F7F;
    bf16x8 At[4][2], B0[2][2], B1[2][2]; i32x8 At8[4], B08[2], B18[2];
    const char* cA = cur.A; const char* cB = cur.B;
    if constexpr (SP2) {
        PG8_STAGE(PG8_SB(0, 0), cB, voffB); PG8_STAGE(PG8_SB(0, 1), cB + hstepB, voffB); PG8_STAGE(PG8_SA(0, 0), cA, voffA); PG8_STAGE(PG8_SA(0, 1), cA + hstepA, voffA);
        if (wr == 1) PG8_BAR;
        PG8_WAIT_V(2); PG8_BAR;
        PG8_STAGE(PG8_SB(1, 0), cB + kstep, voffB); PG8_STAGE(PG8_SA(1, 0), cA + kstep, voffA); PG8_STAGE(PG8_SB(1, 1), cB + hstepB + kstep, voffB);
        PG8_WAIT_V(6); PG8_BAR;
    } else {
        PG8_STAGE(PG8_SB(0, 0), cB, voffB); PG8_STAGE(PG8_SA(0, 0), cA, voffA); PG8_STAGE(PG8_SB(0, 1), cB + hstepB, voffB); PG8_STAGE(PG8_SA(0, 1), cA + hstepA, voffA);
        if (wr == 1) PG8_BAR;
        PG8_WAIT_V(4); PG8_BAR;
        PG8_STAGE(PG8_SB(1, 0), cB + kstep, voffB); PG8_STAGE(PG8_SA(1, 0), cA + kstep, voffA); PG8_STAGE(PG8_SB(1, 1), cB + hstepB + kstep, voffB);
        PG8_WAIT_V(6); PG8_BAR;
    }
    for (;;) {
        const bool has_next = S.next(ui + 1, nxt);
        const char* nA = has_next ? nxt.A : cA; const char* nB = has_next ? nxt.B : cB;
#pragma nounroll
        for (int t = 0; t < nt; t += 2) {
            const bool last = (t == nt - 2);
            const char* a1 = cA + (size_t)(t + 1) * kstep;
            const char* a2 = last ? nA : cA + (size_t)(t + 2) * kstep; const char* b2 = last ? nB : cB + (size_t)(t + 2) * kstep;
            const char* a3 = a2 + kstep; const char* b3 = b2 + kstep;
            if constexpr (SP2) {
            PG8_LDB(B0, 0, 0); PG8_LDB(B1, 0, 1); PG8_SCHED; PG8_LDA(At, 0, 0); PG8_STAGE(PG8_SA(1, 1), a1 + hstepA, voffA);
            PG8_WAIT_V(8); PG8_WAIT_L(0); PG8_BAR; PG8_MMA(0, 0, At, B0); PG8_MMA(0, 1, At, B1); PG8_BAR; PG8_SCHED;
            PG8_LDA(At, 0, 1); PG8_STAGE(PG8_SB(0, 0), b2, voffB); PG8_STAGE(PG8_SB(0, 1), b2 + hstepB, voffB); PG8_STAGE(PG8_SA(0, 0), a2, voffA);
            PG8_WAIT_V(8); PG8_WAIT_L(0); PG8_BAR; PG8_MMA(1, 0, At, B0); PG8_MMA(1, 1, At, B1); PG8_BAR; PG8_SCHED;
            PG8_LDB(B0, 1, 0); PG8_LDB(B1, 1, 1); PG8_SCHED; PG8_LDA(At, 1, 0); PG8_STAGE(PG8_SA(0, 1), a2 + hstepA, voffA);
            PG8_WAIT_V(8); PG8_WAIT_L(0); PG8_BAR; PG8_MMA(0, 0, At, B0); PG8_MMA(0, 1, At, B1); PG8_BAR; PG8_SCHED;
            PG8_LDA(At, 1, 1); PG8_STAGE(PG8_SB(1, 0), b3, voffB); PG8_STAGE(PG8_SB(1, 1), b3 + hstepB, voffB); PG8_STAGE(PG8_SA(1, 0), a3, voffA);
            PG8_WAIT_V(8); PG8_WAIT_L(0); PG8_BAR; PG8_MMA(1, 0, At, B0); PG8_MMA(1, 1, At, B1); PG8_BAR; PG8_SCHED;
            } else {
            PG8_LDB(B0, 0, 0); PG8_SCHED; PG8_LDA(At, 0, 0); PG8_STAGE(PG8_SA(1, 1), a1 + hstepA, voffA);
            PG8_WAIT_L(8); PG8_BAR; PG8_WAIT_L(0); PG8_MMA(0, 0, At, B0); PG8_BAR; PG8_SCHED;
            PG8_LDB(B1, 0, 1); PG8_STAGE(PG8_SB(0, 0), b2, voffB);
            PG8_BAR; PG8_WAIT_L(0); PG8_MMA(0, 1, At, B1); PG8_BAR;
            PG8_LDA(At, 0, 1); PG8_STAGE(PG8_SA(0, 0), a2, voffA);
            PG8_BAR; PG8_WAIT_L(0); PG8_MMA(1, 0, At, B0); PG8_BAR; PG8_SCHED;
            PG8_STAGE(PG8_SB(0, 1), b2 + hstepB, voffB);
            PG8_WAIT_V(6); PG8_BAR; PG8_MMA(1, 1, At, B1); PG8_BAR;
            PG8_LDB(B0, 1, 0); PG8_SCHED; PG8_LDA(At, 1, 0); PG8_STAGE(PG8_SA(0, 1), a2 + hstepA, voffA);
            PG8_WAIT_L(8); PG8_BAR; PG8_WAIT_L(0); PG8_MMA(0, 0, At, B0); PG8_BAR; PG8_SCHED;
            PG8_LDB(B1, 1, 1); PG8_STAGE(PG8_SB(1, 0), b3, voffB);
            PG8_BAR; PG8_WAIT_L(0); PG8_MMA(0, 1, At, B1); PG8_BAR;
            PG8_LDA(At, 1, 1); PG8_STAGE(PG8_SA(1, 0), a3, voffA);
            PG8_BAR; PG8_WAIT_L(0); PG8_MMA(1, 0, At, B0); PG8_BAR; PG8_SCHED;
            PG8_STAGE(PG8_SB(1, 1), b3 + hstepB, voffB);
            PG8_WAIT_V(6); PG8_BAR; PG8_MMA(1, 1, At, B1); PG8_BAR;
            }
        }
        if constexpr (ALIGN_EPI) { if (wr == 0) PG8_BAR; }
        if constexpr (FP8) asm volatile("s_nop 15\n\ts_nop 15" ::: "memory");
        E(acc, cur, wr, wc, fr, fq);
        if (!has_next) break;
#pragma unroll
        for (int a = 0; a < 2; ++a)
#pragma unroll
            for (int b = 0; b < 2; ++b)
#pragma unroll
                for (int m = 0; m < 4; ++m)
#pragma unroll
                    for (int n = 0; n < 2; ++n) acc[a][b][m][n] = (f32x4){0.f, 0.f, 0.f, 0.f};
        cur = nxt; cA = nA; cB = nB; ++ui;
        if constexpr (ALIGN_EPI) { if (wr == 1) PG8_BAR; }
    }
    PG8_WAIT_V(0);
    if constexpr (!ALIGN_EPI) { if (wr == 0) PG8_BAR; }
    PG8_BAR;
#undef PG8_SA
#undef PG8_SB
#undef PG8_STAGE
#undef PG8_LDA
#undef PG8_RD
#undef PG8_LDB
#undef PG8_MMA
#undef PG8_WAIT_V
#undef PG8_WAIT_L
#undef PG8_BAR
#undef PG8_SCHED
}
}
using pg8::Unit;

struct SchedGrid { const char* A; const char* B; size_t astep, bstep; int nM, nN, G, c;
    DEV bool next(int i, Unit& u) const { int pm, pn; if (!pg8::tile_of(i * G + c, nM, nN, pm, pn)) return false; u.A = A + (size_t)pm * astep; u.B = B + (size_t)pn * bstep; u.pm = pm; u.pn = pn; u.aux = i; return true; } };
struct SchedPair { const char* A0; const char* A1; const char* B0; const char* B1; size_t astep, bstep; int nM, nN, G, c;
    DEV bool next(int i, Unit& u) const { int pm, pn; if (!pg8::tile_of((i >> 1) * G + c, nM, nN, pm, pn)) return false; const int br = i & 1; u.A = (br ? A1 : A0) + (size_t)pm * astep; u.B = (br ? B1 : B0) + (size_t)pn * bstep; u.pm = pm; u.pn = pn; u.aux = br; return true; } };
struct SchedMoe { const char* A; const char* B; const int* tile_e; size_t astep, bstep, estep; int t0, nM, nN, G, c;
    DEV bool next(int i, Unit& u) const { int pm, pn; if (!pg8::tile_of(i * G + c, nM, nN, pm, pn)) return false; const int e = tile_e[t0 + pm]; u.A = A + (size_t)pm * astep; u.B = B + (size_t)e * estep + (size_t)pn * bstep; u.pm = pm; u.pn = pn; u.aux = e; return true; } };

struct SchedMoeK { const char* A; const char* B; const int* tile_e; int nL, G, c;
    DEV bool next(int i, Unit& u) const { const int L = i * G + c; if (L >= nL * 4 * KSPLIT) return false; const int ks = L % KSPLIT, pn = (L / KSPLIT) & 3, lt = L / (4 * KSPLIT); const int e = tile_e[128 + lt];
        u.A = A + ((size_t)(128 + lt) * 256 * DFE + (size_t)ks * KSLICE); u.B = B + ((size_t)e * D * DFE + (size_t)pn * 256 * DFE + (size_t)ks * KSLICE);     u.pm = lt; u.pn = pn; u.aux = ks; return true; } };
template <class Sched> DEV void fill_rstd(LAS float* R, const Sched& S, const float* ssq) {
    int t = threadIdx.x; asm volatile("" : "+v"(t)); Unit u;
    for (int i = 0; i < 8 && S.next(i, u); ++i) if (t < 256) R[i * 256 + t] = row_rstd(ssq, u.pm * 256 + t);
    __syncthreads();
}
typedef const f32x4 (&AccRef)[2][2][4][2];
template <bool RS> struct EBf16T { static constexpr bool PERM = true; bf16* O; int ldc; float sc; const LAS float* R;
    DEV void operator()(AccRef acc, const Unit& u, int wr, int wc, int fr, int fq) const {
        const int row0 = u.pm * 256 + wr * 64 + fr, col0 = u.pn * 256 + wc * 32 + 8 * fq;
        float rsv[2][4];
#pragma unroll
        for (int ai = 0; ai < 2; ++ai)
#pragma unroll
            for (int m = 0; m < 4; ++m) rsv[ai][m] = RS ? sc * R[u.aux * 256 + ai * 128 + wr * 64 + m * 16 + fr] : sc;
#pragma unroll
        for (int ai = 0; ai < 2; ++ai)
#pragma unroll
            for (int m = 0; m < 4; ++m) { const int row = row0 + ai * 128 + m * 16; bf16* rowp = O + (size_t)row * ldc + col0; const float rs = rsv[ai][m];
#pragma unroll
                for (int bj = 0; bj < 2; ++bj) { const f32x4 v0 = acc[ai][bj][m][0] * rs, v1 = acc[ai][bj][m][1] * rs; u32x4 w; w.x = cvt_pk_bf16(v0[0], v0[1]); w.y = cvt_pk_bf16(v0[2], v0[3]); w.z = cvt_pk_bf16(v1[0], v1[1]); w.w = cvt_pk_bf16(v1[2], v1[3]);
                    *(u32x4*)(rowp + bj * 128) = w; } }
    } };
typedef EBf16T<false> EBf16;
constexpr float OB_SCALE = 8.0f;
struct EOut8 { static constexpr bool PERM = true; unsigned char* O; float sc;
    DEV void operator()(AccRef acc, const Unit& u, int wr, int wc, int fr, int fq) const {
        const int row0 = u.pm * 256 + wr * 64 + fr, col0 = u.pn * 256 + wc * 32 + 8 * fq;
#pragma unroll
        for (int ai = 0; ai < 2; ++ai)
#pragma unroll
            for (int m = 0; m < 4; ++m) { unsigned char* rowp = O + (size_t)(row0 + ai * 128 + m * 16) * D + col0;
#pragma unroll
                for (int bj = 0; bj < 2; ++bj) { const f32x4 v0 = acc[ai][bj][m][0] * sc, v1 = acc[ai][bj][m][1] * sc; u32x2 w; w.x = pk4_fp8(v0[0], v0[1], v0[2], v0[3]); w.y = pk4_fp8(v1[0], v1[1], v1[2], v1[3]);
                    *(u32x2*)(rowp + bj * 128) = w; } }
    } };
struct EG1 { static constexpr bool PERM = true; bf16* p; const LAS float* R;
    DEV void operator()(AccRef acc, const Unit& u, int wr, int wc, int fr, int fq) const {
        const int row0 = u.pm * 256 + wr * 64 + fr, c8 = wc * 32 + 8 * fq;
        float rsv[2][4];
#pragma unroll
        for (int ai = 0; ai < 2; ++ai)
#pragma unroll
            for (int m = 0; m < 4; ++m) rsv[ai][m] = R[u.aux * 256 + ai * 128 + wr * 64 + m * 16 + fr];
        if (u.pn < 4) {
#pragma unroll
            for (int ai = 0; ai < 2; ++ai)
#pragma unroll
                for (int m = 0; m < 4; ++m) { const float r2 = rsv[ai][m] * rsv[ai][m]; const f32x4 a0 = acc[ai][0][m][0], a1 = acc[ai][0][m][1], g0 = acc[ai][1][m][0] * r2, g1 = acc[ai][1][m][1] * r2;
                    u32x4 w; w.x = cvt_pk_bf16(a0[0] * g0[0], a0[1] * g0[1]); w.y = cvt_pk_bf16(a0[2] * g0[2], a0[3] * g0[3]); w.z = cvt_pk_bf16(a1[0] * g1[0], a1[1] * g1[1]); w.w = cvt_pk_bf16(a1[2] * g1[2], a1[3] * g1[3]);
                    *(u32x4*)(p + (size_t)(row0 + ai * 128 + m * 16) * PLD + P_U + 128 * u.pn + c8) = w; }
        } else if (u.pn < 12) {
            const int colt = P_GB + 256 * (u.pn - 4) + c8;
#pragma unroll
            for (int ai = 0; ai < 2; ++ai)
#pragma unroll
                for (int m = 0; m < 4; ++m) { const float rs = rsv[ai][m]; bf16* rowp = p + (size_t)(row0 + ai * 128 + m * 16) * PLD + colt;
#pragma unroll
                    for (int bj = 0; bj < 2; ++bj) { const f32x4 v0 = acc[ai][bj][m][0] * rs, v1 = acc[ai][bj][m][1] * rs; u32x4 w; w.x = cvt_pk_bf16(v0[0], v0[1]); w.y = cvt_pk_bf16(v0[2], v0[3]); w.z = cvt_pk_bf16(v1[0], v1[1]); w.w = cvt_pk_bf16(v1[2], v1[3]);
                        *(u32x4*)(rowp + bj * 128) = w; } }
        } else {
            const int bofs = PB_GA + 256 * (u.pn - 12) + c8;
#pragma unroll
            for (int ai = 0; ai < 2; ++ai)
#pragma unroll
                for (int m = 0; m < 4; ++m) { const float rs = rsv[ai][m]; unsigned char* rowb = (unsigned char*)(p + (size_t)(row0 + ai * 128 + m * 16) * PLD) + bofs;
#pragma unroll
                    for (int bj = 0; bj < 2; ++bj) { const f32x4 v0 = acc[ai][bj][m][0] * rs, v1 = acc[ai][bj][m][1] * rs;
                        unsigned q[8] = {(unsigned)(fsig(v0[0]) * 255.0f + 0.5f), (unsigned)(fsig(v0[1]) * 255.0f + 0.5f), (unsigned)(fsig(v0[2]) * 255.0f + 0.5f), (unsigned)(fsig(v0[3]) * 255.0f + 0.5f),
                                         (unsigned)(fsig(v1[0]) * 255.0f + 0.5f), (unsigned)(fsig(v1[1]) * 255.0f + 0.5f), (unsigned)(fsig(v1[2]) * 255.0f + 0.5f), (unsigned)(fsig(v1[3]) * 255.0f + 0.5f)};
                        u32x2 w; w.x = q[0] | (q[1] << 8) | (q[2] << 16) | (q[3] << 24); w.y = q[4] | (q[5] << 8) | (q[6] << 16) | (q[7] << 24);
                        *(u32x2*)(rowb + bj * 128) = w; } }
        }
    } };
struct EMerge { static constexpr bool PERM = true; bf16* mg; const bf16* p;
    DEV void operator()(AccRef acc, const Unit& u, int wr, int wc, int fr, int fq) const {
        const int row0 = u.pm * 256 + wr * 64 + fr, col0 = u.pn * 256 + wc * 32 + 8 * fq; const int gofs = u.aux ? PB_GBB : PB_GA;
#pragma unroll
        for (int ai = 0; ai < 2; ++ai) {
            u32x2 gt[4][2]; u32x4 od[4][2];
#pragma unroll
            for (int m = 0; m < 4; ++m)
#pragma unroll
                for (int bj = 0; bj < 2; ++bj) { const size_t row = (size_t)(row0 + ai * 128 + m * 16); const int col = col0 + bj * 128;
                    gt[m][bj] = *(const u32x2*)((const unsigned char*)(p + row * PLD) + gofs + col); od[m][bj] = u.aux ? *(const u32x4*)(mg + row * D + col) : (u32x4){0u, 0u, 0u, 0u}; }
#pragma unroll
            for (int m = 0; m < 4; ++m)
#pragma unroll
                for (int bj = 0; bj < 2; ++bj) { const size_t row = (size_t)(row0 + ai * 128 + m * 16); const int col = col0 + bj * 128; const u32x2 g = gt[m][bj]; const u32x4 o = od[m][bj];
                    const f32x4 v0 = acc[ai][bj][m][0] * (1.0f / 255.0f), v1 = acc[ai][bj][m][1] * (1.0f / 255.0f);
                    u32x4 w; w.x = cvt_pk_bf16((float)(g.x & 0xffu) * v0[0] + blo(o.x), (float)((g.x >> 8) & 0xffu) * v0[1] + bhi(o.x)); w.y = cvt_pk_bf16((float)((g.x >> 16) & 0xffu) * v0[2] + blo(o.y), (float)(g.x >> 24) * v0[3] + bhi(o.y));
                    w.z = cvt_pk_bf16((float)(g.y & 0xffu) * v1[0] + blo(o.z), (float)((g.y >> 8) & 0xffu) * v1[1] + bhi(o.z)); w.w = cvt_pk_bf16((float)((g.y >> 16) & 0xffu) * v1[2] + blo(o.w), (float)(g.y >> 24) * v1[3] + bhi(o.w));
                    *(u32x4*)(mg + row * D + col) = w; }
        }
    } };
template <bool STATS> struct EResT { static constexpr bool PERM = true; bf16* xb; float* ssq; LAS float* P;
    DEV void operator()(AccRef acc, const Unit& u, int wr, int wc, int fr, int fq) const {
        const int row0 = u.pm * 256 + wr * 64 + fr, col0 = u.pn * 256 + wc * 32 + 8 * fq;
#pragma unroll
        for (int ai = 0; ai < 2; ++ai) {
        u32x4 xo[4][2];
#pragma unroll
            for (int m = 0; m < 4; ++m)
#pragma unroll
                for (int bj = 0; bj < 2; ++bj) xo[m][bj] = *(const u32x4*)(xb + (size_t)(row0 + ai * 128 + m * 16) * D + col0 + bj * 128);
#pragma unroll
            for (int m = 0; m < 4; ++m) { bf16* rowp = xb + (size_t)(row0 + ai * 128 + m * 16) * D + col0; float sq = 0.f;
#pragma unroll
                for (int bj = 0; bj < 2; ++bj) { const u32x4 o = xo[m][bj]; const f32x4 a0 = acc[ai][bj][m][0], a1 = acc[ai][bj][m][1];
                    u32x4 w; w.x = cvt_pk_bf16(blo(o.x) + a0[0], bhi(o.x) + a0[1]); w.y = cvt_pk_bf16(blo(o.y) + a0[2], bhi(o.y) + a0[3]); w.z = cvt_pk_bf16(blo(o.z) + a1[0], bhi(o.z) + a1[1]); w.w = cvt_pk_bf16(blo(o.w) + a1[2], bhi(o.w) + a1[3]);
                    *(u32x4*)(rowp + bj * 128) = w;
                    if (STATS) sq += (blo(w.x) * blo(w.x) + bhi(w.x) * bhi(w.x)) + (blo(w.y) * blo(w.y) + bhi(w.y) * bhi(w.y)) + (blo(w.z) * blo(w.z) + bhi(w.z) * bhi(w.z)) + (blo(w.w) * blo(w.w) + bhi(w.w) * bhi(w.w)); }
                if (STATS) { sq += __shfl_xor(sq, 16); sq += __shfl_xor(sq, 32);
                    if (fq == 0) P[(ai * 128 + wr * 64 + m * 16 + fr) * 4 + wc] = sq; } } }
        if (!STATS) return;
        asm volatile("s_waitcnt lgkmcnt(0)" ::: "memory"); __builtin_amdgcn_s_barrier(); asm volatile("" ::: "memory");
        const int t = wr * 256 + wc * 64 + fq * 16 + fr;
        if (t < 256) ssq[(size_t)u.pn * M + u.pm * 256 + t] = (P[t * 4] + P[t * 4 + 1]) + (P[t * 4 + 2] + P[t * 4 + 3]);
    } };
typedef EResT<true> ERes;
struct ESlab { static constexpr bool PERM = false; float* obx; float sc;
    DEV void operator()(AccRef acc, const Unit& u, int wr, int wc, int fr, int fq) const {
        const int row0 = u.pm * 256 + wr * 64 + fr, col0 = u.pn * 256 + wc * 32 + 4 * fq; float* base = obx + (size_t)u.aux * 2048 * D;
#pragma unroll
        for (int ai = 0; ai < 2; ++ai)
#pragma unroll
            for (int m = 0; m < 4; ++m) { const size_t off = (size_t)(row0 + ai * 128 + m * 16) * D + col0;
#pragma unroll
                for (int bj = 0; bj < 2; ++bj)
#pragma unroll
                    for (int n = 0; n < 2; ++n) *(f32x4*)(base + off + bj * 128 + n * 16) = acc[ai][bj][m][n] * sc; }
    } };
struct ESwiglu8 { static constexpr bool PERM = true; unsigned char* act; int ld; float sc;
    DEV void operator()(AccRef acc, const Unit& u, int wr, int wc, int fr, int fq) const {
        const int row0 = u.pm * 256 + wr * 64 + fr, col0 = u.pn * 128 + wc * 32 + 8 * fq;
#pragma unroll
        for (int ai = 0; ai < 2; ++ai)
#pragma unroll
            for (int m = 0; m < 4; ++m) { const f32x4 g0 = acc[ai][0][m][0] * sc, g1 = acc[ai][0][m][1] * sc, u0 = acc[ai][1][m][0] * sc, u1 = acc[ai][1][m][1] * sc;
                u32x2 w; w.x = pk4_fp8(g0[0] * fsig(g0[0]) * u0[0], g0[1] * fsig(g0[1]) * u0[1], g0[2] * fsig(g0[2]) * u0[2], g0[3] * fsig(g0[3]) * u0[3]);
                w.y = pk4_fp8(g1[0] * fsig(g1[0]) * u1[0], g1[1] * fsig(g1[1]) * u1[1], g1[2] * fsig(g1[2]) * u1[2], g1[3] * fsig(g1[3]) * u1[3]);
                *(u32x2*)(act + (size_t)(row0 + ai * 128 + m * 16) * ld + col0) = w; }
    } };
struct ESwiglu { static constexpr bool PERM = true; bf16* act; int ld; const LAS float* R;
    DEV void operator()(AccRef acc, const Unit& u, int wr, int wc, int fr, int fq) const {
        const int row0 = u.pm * 256 + wr * 64 + fr, col0 = u.pn * 128 + wc * 32 + 8 * fq;
        float rsv[2][4];
#pragma unroll
        for (int ai = 0; ai < 2; ++ai)
#pragma unroll
            for (int m = 0; m < 4; ++m) rsv[ai][m] = R[u.aux * 256 + ai * 128 + wr * 64 + m * 16 + fr];
#pragma unroll
        for (int ai = 0; ai < 2; ++ai)
#pragma unroll
            for (int m = 0; m < 4; ++m) { const float rs = rsv[ai][m]; const f32x4 g0 = acc[ai][0][m][0] * rs, g1 = acc[ai][0][m][1] * rs, u0 = acc[ai][1][m][0] * rs, u1 = acc[ai][1][m][1] * rs;
                u32x4 w; w.x = cvt_pk_bf16(g0[0] * fsig(g0[0]) * u0[0], g0[1] * fsig(g0[1]) * u0[1]); w.y = cvt_pk_bf16(g0[2] * fsig(g0[2]) * u0[2], g0[3] * fsig(g0[3]) * u0[3]);
                w.z = cvt_pk_bf16(g1[0] * fsig(g1[0]) * u1[0], g1[1] * fsig(g1[1]) * u1[1]); w.w = cvt_pk_bf16(g1[2] * fsig(g1[2]) * u1[2], g1[3] * fsig(g1[3]) * u1[3]);
                *(u32x4*)(act + (size_t)(row0 + ai * 128 + m * 16) * ld + col0) = w; }
    } };

#define XB_TMO      128
#define XB_XCNT(j)  (256  + 64 * (j))
#define XB_XSUB(j)  (1280 + 64 * (j))
#define XB_XGEN(j)  (2304 + 64 * (j))
#define XB_TOP      3328
#define XB_TOPGEN   3392
#define XCD_BAR_WORDS 3456
#define XB_SPIN_CAP (1u << 18)
__device__ __forceinline__ unsigned xb_ld(unsigned* p)              { return __hip_atomic_load(p, __ATOMIC_RELAXED, __HIP_MEMORY_SCOPE_AGENT); }
__device__ __forceinline__ unsigned xb_add(unsigned* p, unsigned v) { return __hip_atomic_fetch_add(p, v, __ATOMIC_RELAXED, __HIP_MEMORY_SCOPE_AGENT); }
__device__ __forceinline__ unsigned xb_xcc_id() { return (unsigned)__builtin_amdgcn_s_getreg((3 << 11) | 20) & 0xFu; }
#define XB_SPIN(cond, bar) do { unsigned _sp = 0; while (cond) { __builtin_amdgcn_s_sleep(1); \
    if ((++_sp & 255u) == 0u) { if (xb_ld(&(bar)[XB_TMO])) break; if (_sp > XB_SPIN_CAP) { atomicAdd(&(bar)[XB_TMO], 1u); break; } } } } while (0)
struct XcdBarrier { unsigned* bar; unsigned x; volatile LAS unsigned* st; };
__device__ __forceinline__ XcdBarrier xcd_barrier_post(unsigned* bar, volatile LAS unsigned* st) {
    XcdBarrier b; b.bar = bar; b.x = xb_xcc_id(); b.st = st;
    if (threadIdx.x == 0) (void)xb_add(&bar[XB_XCNT(b.x)], 1u);
    return b;
}
__device__ __forceinline__ void xcd_barrier_complete(unsigned* bar, unsigned x, unsigned& nloc, unsigned& nx) {
    const unsigned G = gridDim.x * gridDim.y * gridDim.z;
    unsigned sum, cnt, mine, sp = 0u;
    for (;;) {
        sum = 0u; cnt = 0u; mine = 0u;
#pragma unroll
        for (unsigned j = 0; j < 16; ++j) { const unsigned c = xb_ld(&bar[XB_XCNT(j)]); sum += c; cnt += (c > 0u) ? 1u : 0u; mine = (j == x) ? c : mine; }
        if (sum == G) break;
        __builtin_amdgcn_s_sleep(1);
        if ((++sp & 255u) == 0u) { if (xb_ld(&bar[XB_TMO])) break; if (sp > XB_SPIN_CAP) { atomicAdd(&bar[XB_TMO], 1u); break; } }
    }
    nloc = mine > 0u ? mine : 1u; nx = cnt > 0u ? cnt : 1u;
}
__device__ __forceinline__ void xcd_barrier(const XcdBarrier& b) {
    asm volatile("s_waitcnt vmcnt(0)" ::: "memory");
    __syncthreads();
    if (threadIdx.x == 0) {
        unsigned* bar = b.bar;
        __builtin_amdgcn_s_waitcnt(0);
        unsigned nloc = b.st[0], nx = b.st[1];
        if (nloc == 0u) { xcd_barrier_complete(bar, b.x, nloc, nx); b.st[0] = nloc; b.st[1] = nx; }
        const unsigned old = xb_add(&bar[XB_XSUB(b.x)], 1u);
        const unsigned gen = old / nloc;
        if (old + 1u == (gen + 1u) * nloc) {
            __builtin_amdgcn_fence(__ATOMIC_RELEASE, "agent");
            asm volatile("s_waitcnt vmcnt(0)" ::: "memory");
            const unsigned og = xb_add(&bar[XB_TOP], 1u);
            const unsigned tg = og / nx;
            if (og + 1u == (tg + 1u) * nx) xb_add(&bar[XB_TOPGEN], 1u);
            else XB_SPIN(xb_ld(&bar[XB_TOPGEN]) == tg, bar);
            __builtin_amdgcn_fence(__ATOMIC_ACQUIRE, "agent");
            xb_add(&bar[XB_XGEN(b.x)], 1u);
            asm volatile("s_waitcnt vmcnt(0)" ::: "memory");
        } else {
            XB_SPIN(xb_ld(&bar[XB_XGEN(b.x)]) == gen, bar);
            __builtin_amdgcn_fence(__ATOMIC_ACQUIRE, "agent");
            asm volatile("s_waitcnt vmcnt(0)" ::: "memory");
        }
    }
    __syncthreads();
}

constexpr size_t WS_WIN = 20 * MiB;
constexpr size_t WS_WA = 40 * MiB;
constexpr size_t WS_WBR = 41 * MiB;
constexpr size_t WS_WOUT = 45 * MiB;
constexpr size_t WS_WFGU = 49 * MiB;
constexpr size_t WS_WFD = 60 * MiB;
constexpr size_t WS_WMGU = 66 * MiB;
constexpr size_t WS_WMD = 178 * MiB;
constexpr size_t WS_BAR = 4096;
constexpr int RING_BYTES = 131072, MISC_OFF = RING_BYTES + 320, PSTAT_OFF = RING_BYTES + 1024  , RSTD_OFF = RING_BYTES + 6144  , LDS_BYTES = 147456;

template <bool GAIN>
DEV void cvt_item_t(const float* W, int ldw, int k0, int n0, bf16* dst, int Kd, LAS float* scr, int lane, const float* gain) {
    const int c = lane & 7;
    f32x4 g0 = {1.f, 1.f, 1.f, 1.f}, g1 = g0;
    if (GAIN) { g0 = *(const f32x4*)(gain + k0 + 8 * c); g1 = *(const f32x4*)(gain + k0 + 8 * c + 4); }
#pragma unroll
    for (int i = 0; i < 32; ++i) { const int kk = 2 * i + (lane >> 5); scr[kk * 33 + (lane & 31)] = W[(size_t)(k0 + kk) * ldw + n0 + (lane & 31)]; }
    asm volatile("s_waitcnt lgkmcnt(0)" ::: "memory");
#pragma unroll
    for (int j = 0; j < 4; ++j) { const int n = (lane >> 3) + 8 * j; const LAS float* s = scr + (8 * c) * 33 + n;
        u32x4 o; o.x = pk2(s[0 * 33] * g0[0], s[1 * 33] * g0[1]); o.y = pk2(s[2 * 33] * g0[2], s[3 * 33] * g0[3]); o.z = pk2(s[4 * 33] * g1[0], s[5 * 33] * g1[1]); o.w = pk2(s[6 * 33] * g1[2], s[7 * 33] * g1[3]);
        *(u32x4*)(dst + (size_t)n * Kd + 8 * c) = o; }
    asm volatile("s_waitcnt lgkmcnt(0)" ::: "memory");
}
DEV void cvt_item(const float* W, int ldw, int k0, int n0, bf16* dst, int Kd, LAS float* scr, int lane) { cvt_item_t<false>(W, ldw, k0, n0, dst, Kd, scr, lane, nullptr); }
DEV void cvt_item_g(const float* W, int ldw, int k0, int n0, bf16* dst, int Kd, LAS float* scr, int lane, const float* gain) { cvt_item_t<true>(W, ldw, k0, n0, dst, Kd, scr, lane, gain); }


DEV float4 ldx4(const bf16* row, int idx) { const uint2 t = ((const uint2*)row)[idx]; return make_float4(__uint_as_float(t.x << 16), __uint_as_float(t.x & 0xffff0000u), __uint_as_float(t.y << 16), __uint_as_float(t.y & 0xffff0000u)); }
DEV int otid() { int t = threadIdx.x; asm volatile("" : "+v"(t)); return t; }
typedef float f32x16 __attribute__((ext_vector_type(16)));
typedef __bf16 bf16x2_t __attribute__((ext_vector_type(2)));
DEV unsigned pkbf(float lo, float hi) { const f32x2 v = {lo, hi}; return __builtin_bit_cast(unsigned, __builtin_convertvector(v, bf16x2_t)); }
#define MFMA32(a, b, c) __builtin_amdgcn_mfma_f32_32x32x16_bf16((a), (b), (c), 0, 0, 0)
DEV int crow(int reg, int h) { return (reg & 3) + 8 * (reg >> 2) + 4 * h; }
constexpr int VT_LD = 68;
constexpr size_t WS_DL = 2 * MiB;
constexpr size_t WS_SSQ = 2 * MiB + 262144;
constexpr size_t WS_BG = WS_LOGA;
constexpr size_t WS_SP = 458 * MiB;
constexpr size_t WS_WA2 = 40 * MiB + 131072;
#define PACK8(x, s) __builtin_bit_cast(bf16x8, (u32x4){pkbf((x)[8 * (s)], (x)[8 * (s) + 1]), pkbf((x)[8 * (s) + 2], (x)[8 * (s) + 3]), pkbf((x)[8 * (s) + 4], (x)[8 * (s) + 5]), pkbf((x)[8 * (s) + 6], (x)[8 * (s) + 7])})
DEV void stage_vt(const bf16* p, int m0, LAS bf16* vt, int tid) {
#pragma unroll
    for (int i = 0; i < 8; ++i) { const int idx = tid + 512 * i, t = idx & 63, c8 = idx >> 6;
        const u32x4 v = *(const u32x4*)(p + (size_t)(m0 + t) * PLD + P_V + c8 * 8);
        LAS bf16* dst = vt + (c8 * 8) * VT_LD + t;
        dst[0 * VT_LD] = (bf16)(v.x & 0xffffu); dst[1 * VT_LD] = (bf16)(v.x >> 16); dst[2 * VT_LD] = (bf16)(v.y & 0xffffu); dst[3 * VT_LD] = (bf16)(v.y >> 16);
        dst[4 * VT_LD] = (bf16)(v.z & 0xffffu); dst[5 * VT_LD] = (bf16)(v.z >> 16); dst[6 * VT_LD] = (bf16)(v.w & 0xffffu); dst[7 * VT_LD] = (bf16)(v.w >> 16); }
}
DEV bf16x8 vt_frag(const LAS bf16* vt, int vrow, int tbase, int hh) {
    const LAS bf16* s = vt + vrow * VT_LD + tbase + 4 * hh;
    const u32x2 lo = *(const LAS u32x2*)s, hi = *(const LAS u32x2*)(s + 8);
    return __builtin_bit_cast(bf16x8, (u32x4){lo.x, lo.y, hi.x, hi.y});
}
DEV void gla_pass1(LAS unsigned char* lds, const bf16* hb, const float* ssq, const bf16* p, const bf16* WaT, const bf16* Wa2T, const float* b_a, float* BG, bf16* U, float* DL, int item) {
    int tid_ = threadIdx.x; asm volatile("" : "+v"(tid_));
    const int tid = tid_, lane = tid & 63, w = __builtin_amdgcn_readfirstlane(tid >> 6), l31 = lane & 31, hh = lane >> 5, m0 = item * 64, h = w >> 1, kb = w & 1;
    LAS float* alowf = (LAS float*)lds;
    LAS bf16* alowb = (LAS bf16*)(lds + 8192);
    LAS bf16* vt = (LAS bf16*)(lds + 16384);
    const int j = 32 * w + l31;
    bf16x8 af[16], wf[16];
    {   const int tb4 = w & 3, kh = w >> 2, row = m0 + 16 * tb4 + (lane & 15), kofs = 512 * kh + 8 * (lane >> 4);
#pragma unroll
        for (int ks = 0; ks < 16; ++ks) { af[ks] = *(const bf16x8*)(hb + (size_t)row * D + kofs + 32 * ks); wf[ks] = *(const bf16x8*)(WaT + (size_t)(lane & 15) * D + kofs + 32 * ks); } }
    unsigned kraw[2][16];
#pragma unroll
    for (int tb = 0; tb < 2; ++tb)
#pragma unroll
        for (int r = 0; r < 16; ++r) kraw[tb][r] = p[(size_t)(m0 + 32 * tb + crow(r, hh)) * PLD + P_K + j];
    const bf16x8 wfrag = *(const bf16x8*)(Wa2T + j * 16 + 8 * hh);
    const float ba = b_a[j];
    {
        const int tb4 = w & 3, kh = w >> 2;
        f32x4 acc = {0.f, 0.f, 0.f, 0.f};
#pragma unroll
        for (int ks = 0; ks < 16; ++ks) acc = __builtin_amdgcn_mfma_f32_16x16x32_bf16(af[ks], wf[ks], acc, 0, 0, 0);
#pragma unroll
        for (int r = 0; r < 4; ++r) alowf[(kh * 64 + 16 * tb4 + 4 * (lane >> 4) + r) * 16 + (lane & 15)] = acc[r];
    }
    stage_vt(p, m0, vt, tid);
    __syncthreads();
    for (int i = tid; i < 1024; i += 512) alowb[i] = (bf16)f2bf((alowf[i] + alowf[1024 + i]) * row_rstd(ssq, m0 + (i >> 4)));
    __syncthreads();
    f32x16 bc[2]; float carry = 0.f;
#pragma unroll
    for (int tb = 0; tb < 2; ++tb) {
        const bf16x8 afrag = *(const LAS bf16x8*)(alowb + (32 * tb + l31) * 16 + 8 * hh);
        f32x16 z;
#pragma unroll
        for (int r = 0; r < 16; ++r) z[r] = 0.f;
        z = MFMA32(afrag, wfrag, z);
        float gs[4], other[4];
#pragma unroll
        for (int g = 0; g < 4; ++g) {
#pragma unroll
            for (int e = 0; e < 4; ++e) { const float zz = z[4 * g + e] + ba; const float la = (fminf(zz, 0.f) - __logf(1.0f + __expf(-fabsf(zz)))) * (1.0f / 16.0f); z[4 * g + e] = la + (e ? z[4 * g + e - 1] : 0.f); }
            gs[g] = z[4 * g + 3]; other[g] = __shfl_xor(gs[g], 32);
        }
        float run = carry;
#pragma unroll
        for (int g = 0; g < 4; ++g) { const float h0 = hh ? other[g] : gs[g], h1 = hh ? gs[g] : other[g]; const float off = run + (hh ? h0 : 0.f);
#pragma unroll
            for (int e = 0; e < 4; ++e) bc[tb][4 * g + e] = z[4 * g + e] + off;
            run += h0 + h1; }
        carry = run;
    }
    const float blast = carry;
#pragma unroll
    for (int tb = 0; tb < 2; ++tb)
#pragma unroll
        for (int r = 0; r < 16; ++r) BG[(size_t)(m0 + 32 * tb + crow(r, hh)) * KW + j] = bc[tb][r];
    if (hh == 0) DL[(size_t)(item * 4 + h) * 64 + 32 * kb + l31] = __expf(blast);
    f32x16 kh2[2];
#pragma unroll
    for (int tb = 0; tb < 2; ++tb)
#pragma unroll
        for (int r = 0; r < 16; ++r) kh2[tb][r] = bf2f(kraw[tb][r]) * __expf(blast - bc[tb][r]);
#pragma unroll
    for (int vb = 0; vb < 4; ++vb) {
        f32x16 acc;
#pragma unroll
        for (int r = 0; r < 16; ++r) acc[r] = 0.f;
        const int vrow = 128 * h + 32 * vb + l31;
#pragma unroll
        for (int tb = 0; tb < 2; ++tb) { acc = MFMA32(vt_frag(vt, vrow, 32 * tb, hh), PACK8(kh2[tb], 0), acc); acc = MFMA32(vt_frag(vt, vrow, 32 * tb + 16, hh), PACK8(kh2[tb], 1), acc); }
#pragma unroll
        for (int r = 0; r < 16; ++r) U[((size_t)(item * 4 + h) * 128 + 32 * vb + crow(r, hh)) * 64 + 32 * kb + l31] = (bf16)f2bf(acc[r]);
    }
}
DEV void conv_item(bf16* p, const float* cw, int item) {
    int tid_ = threadIdx.x; asm volatile("" : "+v"(tid_));
    const int tid = tid_, c0 = (tid & 63) * 8, tr = tid >> 6, m0 = item * 64 + 8 * tr, ts0 = m0 % SEQ;
    u32x4 uv[10], bv[8];
#pragma unroll
    for (int i = 0; i < 10; ++i) { const bool ok = i >= 2 || ts0 > 0; const size_t r = (size_t)(ok ? m0 - 2 + i : m0) * PLD;
        uv[i] = *(const u32x4*)(p + r + P_U + c0); if (!ok) { uv[i] = (u32x4){0u, 0u, 0u, 0u}; } }
#pragma unroll
    for (int i = 0; i < 8; ++i) bv[i] = *(const u32x4*)(p + (size_t)(m0 + i) * PLD + P_GB + c0);
    float w0[8], w1[8], w2[8];
#pragma unroll
    for (int e = 0; e < 8; ++e) { w0[e] = cw[0 * CC + c0 + e]; w1[e] = cw[1 * CC + c0 + e]; w2[e] = cw[2 * CC + c0 + e]; }
    float u[10][8];
#pragma unroll
    for (int i = 0; i < 10; ++i) { u[i][0] = blo(uv[i].x); u[i][1] = bhi(uv[i].x); u[i][2] = blo(uv[i].y); u[i][3] = bhi(uv[i].y); u[i][4] = blo(uv[i].z); u[i][5] = bhi(uv[i].z); u[i][6] = blo(uv[i].w); u[i][7] = bhi(uv[i].w); }
#pragma unroll
    for (int tt = 0; tt < 8; ++tt) {
        const float gbv[8] = {blo(bv[tt].x), bhi(bv[tt].x), blo(bv[tt].y), bhi(bv[tt].y), blo(bv[tt].z), bhi(bv[tt].z), blo(bv[tt].w), bhi(bv[tt].w)};
        float y[8];
#pragma unroll
        for (int e = 0; e < 8; ++e) y[e] = gbv[e] * (w0[e] * u[tt][e] + w1[e] * u[tt + 1][e] + w2[e] * u[tt + 2][e]);
        u32x4 o; o.x = pkbf(y[0], y[1]); o.y = pkbf(y[2], y[3]); o.z = pkbf(y[4], y[5]); o.w = pkbf(y[6], y[7]);
        *(u32x4*)(p + (size_t)(m0 + tt) * PLD + P_GB + c0) = o;
    }
}
DEV void gla_scan(const bf16* U, const float* DL, bf16* Sp, int bx, int nthreads) {
    const int gtid = bx * 512 + otid();
    for (int idx = gtid; idx < BATCH * NH * 128 * 16; idx += nthreads) {
        const int bh = idx >> 11, v = (idx >> 4) & 127, k4 = idx & 15, b = bh >> 2, h = bh & 3;
        f32x4 S = {0.f, 0.f, 0.f, 0.f};
#pragma unroll 8
        for (int n = 0; n < SEQ / 64; ++n) { const int item = b * (SEQ / 64) + n; const size_t base = ((size_t)(item * 4 + h) * 128 + v) * 64 + k4 * 4;
            const u32x2 uw = *(const u32x2*)(U + base); const f32x4 d = *(const f32x4*)(DL + (size_t)(item * 4 + h) * 64 + k4 * 4);
            u32x2 o; o.x = pkbf(S[0], S[1]); o.y = pkbf(S[2], S[3]); *(u32x2*)(Sp + base) = o;
            S = d * S + (f32x4){blo(uw.x), bhi(uw.x), blo(uw.y), bhi(uw.y)}; }
    }
}
DEV void gla_pass3(LAS unsigned char* lds, bf16* p, const float* BG, const bf16* Sp, const float* gn, int item, bf16* ydst, int yld) {
    int tid_ = threadIdx.x; asm volatile("" : "+v"(tid_));
    const int tid = tid_, lane = tid & 63, w = __builtin_amdgcn_readfirstlane(tid >> 6), l31 = lane & 31, hh = lane >> 5, m0 = item * 64, h = w >> 1, vh = w & 1;
    LAS float* ssb = (LAS float*)lds;
    LAS bf16* vt = (LAS bf16*)(lds + 16384);
    stage_vt(p, m0, vt, tid);
    bf16x8 qf[2][4], kf[2][4];
#pragma unroll
    for (int blk = 0; blk < 2; ++blk)
#pragma unroll
        for (int ks = 0; ks < 4; ++ks) { const size_t row = (size_t)(m0 + 32 * blk + l31); const int kk = 64 * h + 16 * ks + 8 * hh;
            const u32x4 qv = *(const u32x4*)(p + row * PLD + P_Q + kk), kv = *(const u32x4*)(p + row * PLD + P_K + kk);
            const f32x4 b0 = *(const f32x4*)(BG + row * KW + kk), b1 = *(const f32x4*)(BG + row * KW + kk + 4);
            float ep[8], em[8];
#pragma unroll
            for (int e = 0; e < 4; ++e) { ep[e] = 0.125f * __expf(b0[e]); ep[4 + e] = 0.125f * __expf(b1[e]); em[e] = __expf(-b0[e]); em[4 + e] = __expf(-b1[e]); }
            qf[blk][ks] = __builtin_bit_cast(bf16x8, (u32x4){pkbf(blo(qv.x) * ep[0], bhi(qv.x) * ep[1]), pkbf(blo(qv.y) * ep[2], bhi(qv.y) * ep[3]), pkbf(blo(qv.z) * ep[4], bhi(qv.z) * ep[5]), pkbf(blo(qv.w) * ep[6], bhi(qv.w) * ep[7])});
            kf[blk][ks] = __builtin_bit_cast(bf16x8, (u32x4){pkbf(blo(kv.x) * em[0], bhi(kv.x) * em[1]), pkbf(blo(kv.y) * em[2], bhi(kv.y) * em[3]), pkbf(blo(kv.z) * em[4], bhi(kv.z) * em[5]), pkbf(blo(kv.w) * em[6], bhi(kv.w) * em[7])}); }
    bf16x8 spf[2][4];
#pragma unroll
    for (int vb = 0; vb < 2; ++vb)
#pragma unroll
        for (int ks = 0; ks < 4; ++ks) spf[vb][ks] = *(const bf16x8*)(Sp + ((size_t)(item * 4 + h) * 128 + 64 * vh + 32 * vb + l31) * 64 + 16 * ks + 8 * hh);
    f32x16 X00, X01, X11;
#pragma unroll
    for (int r = 0; r < 16; ++r) { X00[r] = 0.f; X01[r] = 0.f; X11[r] = 0.f; }
#pragma unroll
    for (int ks = 0; ks < 4; ++ks) { X00 = MFMA32(kf[0][ks], qf[0][ks], X00); X01 = MFMA32(kf[0][ks], qf[1][ks], X01); X11 = MFMA32(kf[1][ks], qf[1][ks], X11); }
#pragma unroll
    for (int r = 0; r < 16; ++r) if (crow(r, hh) > l31) { X00[r] = 0.f; X11[r] = 0.f; }
    f32x4 gnv[2][4];
#pragma unroll
    for (int vb = 0; vb < 2; ++vb)
#pragma unroll
        for (int g = 0; g < 4; ++g) gnv[vb][g] = *(const f32x4*)(gn + 64 * vh + 32 * vb + 8 * g + 4 * hh);
    u32x2 gvv[2][2][4];
#pragma unroll
    for (int vb = 0; vb < 2; ++vb)
#pragma unroll
        for (int ib = 0; ib < 2; ++ib)
#pragma unroll
            for (int g = 0; g < 4; ++g) gvv[vb][ib][g] = *(const u32x2*)(p + (size_t)(m0 + 32 * ib + l31) * PLD + P_GO + 128 * h + 64 * vh + 32 * vb + 8 * g + 4 * hh);
    __syncthreads();
    f32x16 O[2][2];
#pragma unroll
    for (int vb = 0; vb < 2; ++vb) {
        f32x16 O0, O1;
#pragma unroll
        for (int r = 0; r < 16; ++r) { O0[r] = 0.f; O1[r] = 0.f; }
        const int vloc = 64 * vh + 32 * vb + l31, vrow = 128 * h + vloc;
#pragma unroll
        for (int ks = 0; ks < 4; ++ks) { const bf16x8 sf = spf[vb][ks]; O0 = MFMA32(sf, qf[0][ks], O0); O1 = MFMA32(sf, qf[1][ks], O1); }
        { const bf16x8 a0 = vt_frag(vt, vrow, 0, hh), a1 = vt_frag(vt, vrow, 16, hh), a2 = vt_frag(vt, vrow, 32, hh), a3 = vt_frag(vt, vrow, 48, hh);
          O0 = MFMA32(a0, PACK8(X00, 0), O0); O0 = MFMA32(a1, PACK8(X00, 1), O0);
          O1 = MFMA32(a0, PACK8(X01, 0), O1); O1 = MFMA32(a1, PACK8(X01, 1), O1);
          O1 = MFMA32(a2, PACK8(X11, 0), O1); O1 = MFMA32(a3, PACK8(X11, 1), O1); }
        O[vb][0] = O0; O[vb][1] = O1;
    }
    float ss0 = 0.f, ss1 = 0.f;
#pragma unroll
    for (int vb = 0; vb < 2; ++vb)
#pragma unroll
        for (int r = 0; r < 16; ++r) { ss0 += O[vb][0][r] * O[vb][0][r]; ss1 += O[vb][1][r] * O[vb][1][r]; }
    ss0 += __shfl_xor(ss0, 32); ss1 += __shfl_xor(ss1, 32);
    if (hh == 0) { ssb[w * 64 + l31] = ss0; ssb[w * 64 + 32 + l31] = ss1; }
    __syncthreads();
    float rstd[2];
#pragma unroll
    for (int ib = 0; ib < 2; ++ib) rstd[ib] = rsqrtf((ssb[(2 * h) * 64 + 32 * ib + l31] + ssb[(2 * h + 1) * 64 + 32 * ib + l31]) * (1.0f / 128.0f) + EPS);
#pragma unroll
    for (int vb = 0; vb < 2; ++vb)
#pragma unroll
        for (int ib = 0; ib < 2; ++ib)
#pragma unroll
            for (int g = 0; g < 4; ++g) { const int v0 = 64 * vh + 32 * vb + 8 * g + 4 * hh; bf16* dst = ydst + (size_t)(m0 + 32 * ib + l31) * yld + 128 * h + v0;
                const u32x2 gv = gvv[vb][ib][g]; const f32x4 gg = gnv[vb][g];
                const float g0 = blo(gv.x), g1 = bhi(gv.x), g2 = blo(gv.y), g3 = bhi(gv.y);
                u32x2 o; o.x = pkbf(O[vb][ib][4 * g] * rstd[ib] * gg[0] * g0 * fsig(g0), O[vb][ib][4 * g + 1] * rstd[ib] * gg[1] * g1 * fsig(g1));
                o.y = pkbf(O[vb][ib][4 * g + 2] * rstd[ib] * gg[2] * g2 * fsig(g2), O[vb][ib][4 * g + 3] * rstd[ib] * gg[3] * g3 * fsig(g3));
                *(u32x2*)dst = o; }
}

DEV void xb_rows(const float* x, bf16* xb, float* ssq, int gw, int ngw) {
    const int lane = otid() & 63;
    for (int m0 = gw; m0 < M; m0 += 2 * ngw) {
        const int m1 = m0 + ngw < M ? m0 + ngw : m0;
        const float4* xr0 = (const float4*)(x + (size_t)m0 * D); const float4* xr1 = (const float4*)(x + (size_t)m1 * D);
        float4 v0[4], v1[4];
#pragma unroll
        for (int j = 0; j < 4; ++j) { v0[j] = xr0[lane + 64 * j]; v1[j] = xr1[lane + 64 * j]; }
        uint2* o0 = (uint2*)(xb + (size_t)m0 * D); uint2* o1 = (uint2*)(xb + (size_t)m1 * D); float s0 = 0.f, s1 = 0.f;
#pragma unroll
        for (int j = 0; j < 4; ++j) { s0 += v0[j].x * v0[j].x + v0[j].y * v0[j].y + v0[j].z * v0[j].z + v0[j].w * v0[j].w; s1 += v1[j].x * v1[j].x + v1[j].y * v1[j].y + v1[j].z * v1[j].z + v1[j].w * v1[j].w;
            uint2 w; w.x = pk2(v0[j].x, v0[j].y); w.y = pk2(v0[j].z, v0[j].w); o0[lane + 64 * j] = w; w.x = pk2(v1[j].x, v1[j].y); w.y = pk2(v1[j].z, v1[j].w); o1[lane + 64 * j] = w; }
        s0 = wave_sum(s0); s1 = wave_sum(s1);
        if (lane < 4) { ssq[(size_t)lane * M + m0] = lane == 0 ? s0 : 0.f; ssq[(size_t)lane * M + m1] = lane == 0 ? s1 : 0.f; }
    }
}
DEV void rms_rows(const float* x, const float* g, bf16* hb, int gw, int ngw) {
    const int lane = otid() & 63;
    for (int m = gw; m < M; m += ngw) {
        const float4* xr = (const float4*)(x + (size_t)m * D); const float4* gr = (const float4*)g;
        float4 v[4]; float ss = 0.f;
#pragma unroll
        for (int j = 0; j < 4; ++j) { v[j] = xr[lane + 64 * j]; ss += v[j].x * v[j].x + v[j].y * v[j].y + v[j].z * v[j].z + v[j].w * v[j].w; }
        const float rstd = rsqrtf(wave_sum(ss) * (1.0f / D) + EPS);
        uint2* o = (uint2*)(hb + (size_t)m * D);
#pragma unroll
        for (int j = 0; j < 4; ++j) { const float4 gg = gr[lane + 64 * j]; uint2 w; w.x = pk2(v[j].x * rstd * gg.x, v[j].y * rstd * gg.y); w.y = pk2(v[j].z * rstd * gg.z, v[j].w * rstd * gg.w); o[lane + 64 * j] = w; }
    }
}
DEV void route1_stage(LAS float* wT, const float* g2, const float* wr) {
    const int tid = otid();
    for (int k = tid; k < D; k += 512) { const float g = g2[k]; const float4 w0 = *(const float4*)(wr + (size_t)k * 8), w1 = *(const float4*)(wr + (size_t)k * 8 + 4);
        wT[0 * D + k] = w0.x * g; wT[1 * D + k] = w0.y * g; wT[2 * D + k] = w0.z * g; wT[3 * D + k] = w0.w * g; wT[4 * D + k] = w1.x * g; wT[5 * D + k] = w1.y * g; wT[6 * D + k] = w1.z * g; wT[7 * D + k] = w1.w * g; }
    __syncthreads();
}
DEV void route1_grp(const LAS float* wT, LAS int* lcnt, const bf16* x, float* rstd_o, int* tok_e, float* tok_w, int* counts, int grp) {
    const int tid = otid(), lane = tid & 63, wave = tid >> 6;
    if (tid < 8) lcnt[tid] = 0;
    __syncthreads();
    const int hh = lane >> 5, b4 = (lane >> 4) & 1, b3 = (lane >> 3) & 1;
    uint2 xraw[8][4];
#pragma unroll
    for (int i = 0; i < 8; ++i)
#pragma unroll
        for (int j = 0; j < 4; ++j) xraw[i][j] = ((const uint2*)(x + (size_t)(grp * 64 + wave * 8 + i) * D))[lane + 64 * j];
#pragma unroll
    for (int i = 0; i < 8; ++i) {
        const int m = grp * 64 + wave * 8 + i;
        float4 v[4]; float ss = 0.f; float a[8];
#pragma unroll
        for (int e = 0; e < 8; ++e) a[e] = 0.f;
#pragma unroll
        for (int j = 0; j < 4; ++j) { const uint2 t = xraw[i][j]; v[j] = make_float4(blo(t.x), bhi(t.x), blo(t.y), bhi(t.y)); ss += v[j].x * v[j].x + v[j].y * v[j].y + v[j].z * v[j].z + v[j].w * v[j].w; }
#pragma unroll
        for (int j = 0; j < 4; ++j)
#pragma unroll
            for (int e = 0; e < 8; ++e) { const f32x4 w = *(const LAS f32x4*)(wT + e * D + 4 * (lane + 64 * j)); a[e] += v[j].x * w[0] + v[j].y * w[1] + v[j].z * w[2] + v[j].w * w[3]; }
        ss = wave_sum(ss);
        float c4[4], c2[2];
#pragma unroll
        for (int e = 0; e < 4; ++e) { const float keep = hh ? a[e + 4] : a[e], send = hh ? a[e] : a[e + 4]; c4[e] = keep + __shfl_xor(send, 32); }
#pragma unroll
        for (int e = 0; e < 2; ++e) { const float keep = b4 ? c4[e + 2] : c4[e], send = b4 ? c4[e] : c4[e + 2]; c2[e] = keep + __shfl_xor(send, 16); }
        float c1 = (b3 ? c2[1] : c2[0]) + __shfl_xor(b3 ? c2[0] : c2[1], 8);
        c1 += __shfl_xor(c1, 4); c1 += __shfl_xor(c1, 2); c1 += __shfl_xor(c1, 1);
        const float rstd = rsqrtf(ss * (1.0f / D) + EPS);
        float lg[8];
#pragma unroll
        for (int e = 0; e < 8; ++e) lg[e] = __uint_as_float(__builtin_amdgcn_readlane((int)__float_as_uint(c1), 32 * (e >> 2) + 16 * ((e >> 1) & 1) + 8 * (e & 1))) * rstd;
        int i1 = 0; float l1 = lg[0];
#pragma unroll
        for (int e = 1; e < 8; ++e) if (lg[e] > l1) { l1 = lg[e]; i1 = e; }
        int i2 = -1; float l2 = -3.0e38f;
#pragma unroll
        for (int e = 0; e < 8; ++e) if (e != i1 && lg[e] > l2) { l2 = lg[e]; i2 = e; }
        const float ex = expf(l2 - l1), w1v = 1.0f / (1.0f + ex), w2v = ex / (1.0f + ex);
        if (lane == 0) { rstd_o[m] = rstd; tok_e[m * 2] = i1; tok_e[m * 2 + 1] = i2; tok_w[m * 2] = w1v; tok_w[m * 2 + 1] = w2v;
            __hip_atomic_fetch_add(&lcnt[i1], 1, __ATOMIC_RELAXED, __HIP_MEMORY_SCOPE_WORKGROUP); __hip_atomic_fetch_add(&lcnt[i2], 1, __ATOMIC_RELAXED, __HIP_MEMORY_SCOPE_WORKGROUP); }
    }
    __syncthreads();
    if (tid < 8) counts[grp * 8 + tid] = lcnt[tid];
    __syncthreads();
}
DEV void route2_grp(LAS int* L, const bf16* x, const float* g2, const float* rstd_i, const int* counts, const int* tok_e, int* slot, unsigned char* hbp, int* tilet, int grp, int wgi, int nwg) {
    LAS int* ltot = L; LAS int* lpre = L + 8; LAS int* lseg = L + 16; LAS int* lslot = L + 32; LAS int* lte = L + 160;
    const int tid = otid(), lane = tid & 63, wave = tid >> 6;
    if (tid < 128) lte[tid] = tok_e[(grp * 64) * 2 + tid];
    { int tot = 0, pre = 0;
#pragma unroll
        for (int q = 0; q < 4; ++q) { const int w = lane + 64 * q; const int c = counts[w * 8 + wave]; tot += c; pre += (w < grp) ? c : 0; }
#pragma unroll
        for (int o = 1; o < 64; o <<= 1) { tot += __shfl_xor(tot, o); pre += __shfl_xor(pre, o); }
        if (lane == 0) { ltot[wave] = tot; lpre[wave] = pre; } }
    __syncthreads();
    if (tid == 0) { int off = 0; for (int e = 0; e < 8; ++e) { lseg[e] = off; off += ((ltot[e] + 255) / 256) * 256; } lseg[8] = off; }
    __syncthreads();
    { const int base = lseg[wave] + lpre[wave]; const bool m0 = lte[2 * lane] == wave, m1 = lte[2 * lane + 1] == wave;
        const unsigned long long b0 = __ballot(m0), b1 = __ballot(m1), lt = (1ull << lane) - 1ull;
        const int r0 = __popcll(b0 & lt) + __popcll(b1 & lt);
        if (m0) lslot[2 * lane] = base + r0;
        if (m1) lslot[2 * lane + 1] = base + r0 + (m0 ? 1 : 0); }
    __syncthreads();
    if (tid < 128) slot[(grp * 64) * 2 + tid] = lslot[tid];
    {   const float4* gr = (const float4*)g2; float4 gq[4];
#pragma unroll
        for (int j = 0; j < 4; ++j) gq[j] = gr[lane + 64 * j];
        uint2 xraw[8][4]; float rs[8];
#pragma unroll
        for (int q = 0; q < 8; ++q) { const int m = grp * 64 + wave + 8 * q; rs[q] = rstd_i[m];
#pragma unroll
            for (int j = 0; j < 4; ++j) xraw[q][j] = ((const uint2*)(x + (size_t)m * D))[lane + 64 * j]; }
#pragma unroll
        for (int q = 0; q < 8; ++q) { const int i = wave + 8 * q; const float rstd = rs[q];
            unsigned* o1 = (unsigned*)(hbp + (size_t)lslot[2 * i] * D); unsigned* o2 = (unsigned*)(hbp + (size_t)lslot[2 * i + 1] * D);
#pragma unroll
            for (int j = 0; j < 4; ++j) { const uint2 t = xraw[q][j]; const float4 gg = gq[j]; const unsigned w = pk4_fp8(blo(t.x) * rstd * gg.x, bhi(t.x) * rstd * gg.y, blo(t.y) * rstd * gg.z, bhi(t.y) * rstd * gg.w); o1[lane + 64 * j] = w; o2[lane + 64 * j] = w; } }
    }
    if (grp == 0) {
        if (tid < NTILE_MAX) { const int r = tid * 256; int e = -1; for (int q = 0; q < 8; ++q) if (r >= lseg[q] && r < lseg[q + 1]) e = q; tilet[tid] = e; }
        if (tid == 0) tilet[NTILE_MAX] = lseg[8] / 256;
    }
    if (grp == wgi) {
        for (int e = 0; e < 8; ++e) { const int r0 = lseg[e] + ltot[e], r1 = lseg[e + 1];
            for (int r = r0 + wgi; r < r1; r += nwg) if (tid < 256) ((unsigned*)(hbp + (size_t)r * D))[tid] = 0u; }
    }
    __syncthreads();
}
DEV float4 ld8x4(const unsigned char* row, int idx) { const int w = ((const int*)row)[idx]; const float k = 1.0f / OB_SCALE; return make_float4(__builtin_amdgcn_cvt_f32_fp8(w, 0) * k, __builtin_amdgcn_cvt_f32_fp8(w, 1) * k, __builtin_amdgcn_cvt_f32_fp8(w, 2) * k, __builtin_amdgcn_cvt_f32_fp8(w, 3) * k); }
DEV void combine_rows(const bf16* x, const unsigned char* obuf, const float* obx, const int* slot, const float* tok_w, const float* gf, float* out, int gw, int ngw) {
    const int lane = otid() & 63;
    const float4* gr = (const float4*)gf; float4 gq[4];
#pragma unroll
    for (int j = 0; j < 4; ++j) gq[j] = gr[lane + 64 * j];
    for (int m0 = gw; m0 < M; m0 += 2 * ngw) {
        const int mm[2] = {m0, m0 + ngw < M ? m0 + ngw : m0};
        int s1[2], s2[2]; float w1[2], w2[2];
#pragma unroll
        for (int q = 0; q < 2; ++q) { const int2 sl = *(const int2*)(slot + mm[q] * 2); const float2 tw = *(const float2*)(tok_w + mm[q] * 2); s1[q] = sl.x; s2[q] = sl.y; w1[q] = tw.x; w2[q] = tw.y; }
        float4 v[2][4], ea[2][4], ec[2][4];
        if (s1[0] < 128 * 256 && s2[0] < 128 * 256 && s1[1] < 128 * 256 && s2[1] < 128 * 256) {
            uint2 xa[2][4]; int oa[2][4], oc[2][4];
#pragma unroll
            for (int q = 0; q < 2; ++q)
#pragma unroll
                for (int j = 0; j < 4; ++j) { xa[q][j] = ((const uint2*)(x + (size_t)mm[q] * D))[lane + 64 * j]; oa[q][j] = ((const int*)(obuf + (size_t)s1[q] * D))[lane + 64 * j]; oc[q][j] = ((const int*)(obuf + (size_t)s2[q] * D))[lane + 64 * j]; }
            const float k8 = 1.0f / OB_SCALE;
#pragma unroll
            for (int q = 0; q < 2; ++q)
#pragma unroll
                for (int j = 0; j < 4; ++j) { v[q][j] = make_float4(blo(xa[q][j].x), bhi(xa[q][j].x), blo(xa[q][j].y), bhi(xa[q][j].y));
                    ea[q][j] = make_float4(__builtin_amdgcn_cvt_f32_fp8(oa[q][j], 0) * k8, __builtin_amdgcn_cvt_f32_fp8(oa[q][j], 1) * k8, __builtin_amdgcn_cvt_f32_fp8(oa[q][j], 2) * k8, __builtin_amdgcn_cvt_f32_fp8(oa[q][j], 3) * k8);
                    ec[q][j] = make_float4(__builtin_amdgcn_cvt_f32_fp8(oc[q][j], 0) * k8, __builtin_amdgcn_cvt_f32_fp8(oc[q][j], 1) * k8, __builtin_amdgcn_cvt_f32_fp8(oc[q][j], 2) * k8, __builtin_amdgcn_cvt_f32_fp8(oc[q][j], 3) * k8); }
        } else
#pragma unroll
        for (int q = 0; q < 2; ++q) {
            const bf16* xr = x + (size_t)mm[q] * D; const unsigned char* o1 = obuf + (size_t)s1[q] * D; const unsigned char* o2 = obuf + (size_t)s2[q] * D;
#pragma unroll
            for (int j = 0; j < 4; ++j) { v[q][j] = ldx4(xr, lane + 64 * j);
                if (s1[q] < 128 * 256) ea[q][j] = ld8x4(o1, lane + 64 * j);
                else { float4 e = make_float4(0.f, 0.f, 0.f, 0.f); for (int ks = 0; ks < KSPLIT; ++ks) { const float4 t = ((const float4*)(obx + ((size_t)ks * 2048 + (s1[q] - 128 * 256)) * D))[lane + 64 * j]; e.x += t.x; e.y += t.y; e.z += t.z; e.w += t.w; } ea[q][j] = e; }
                if (s2[q] < 128 * 256) ec[q][j] = ld8x4(o2, lane + 64 * j);
                else { float4 e = make_float4(0.f, 0.f, 0.f, 0.f); for (int ks = 0; ks < KSPLIT; ++ks) { const float4 t = ((const float4*)(obx + ((size_t)ks * 2048 + (s2[q] - 128 * 256)) * D))[lane + 64 * j]; e.x += t.x; e.y += t.y; e.z += t.z; e.w += t.w; } ec[q][j] = e; } }
        }
#pragma unroll
        for (int q = 0; q < 2; ++q) { float ss = 0.f;
#pragma unroll
            for (int j = 0; j < 4; ++j) { v[q][j].x += w1[q] * ea[q][j].x + w2[q] * ec[q][j].x; v[q][j].y += w1[q] * ea[q][j].y + w2[q] * ec[q][j].y; v[q][j].z += w1[q] * ea[q][j].z + w2[q] * ec[q][j].z; v[q][j].w += w1[q] * ea[q][j].w + w2[q] * ec[q][j].w;
                ss += v[q][j].x * v[q][j].x + v[q][j].y * v[q][j].y + v[q][j].z * v[q][j].z + v[q][j].w * v[q][j].w; }
            const float rstd = rsqrtf(wave_sum(ss) * (1.0f / D) + EPS);
            float4* orow = (float4*)(out + (size_t)mm[q] * D);
#pragma unroll
            for (int j = 0; j < 4; ++j) orow[lane + 64 * j] = make_float4(v[q][j].x * rstd * gq[j].x, v[q][j].y * rstd * gq[j].y, v[q][j].z * rstd * gq[j].z, v[q][j].w * rstd * gq[j].w); }
    }
}

DEV void cvt_item8(const float* W, int ldw, int k0, int n0, unsigned char* dst, int Kd, LAS float* scr, int lane) {
#pragma unroll
    for (int i = 0; i < 32; ++i) { const int kk = 2 * i + (lane >> 5); scr[kk * 33 + (lane & 31)] = W[(size_t)(k0 + kk) * ldw + n0 + (lane & 31)]; }
    asm volatile("s_waitcnt lgkmcnt(0)" ::: "memory");
    const int c = lane & 3;
#pragma unroll
    for (int j = 0; j < 2; ++j) { const int n = (lane >> 2) + 16 * j; const LAS float* sp = scr + (16 * c) * 33 + n;
        u32x4 o; o.x = pk4_fp8(sp[0 * 33] * W8_SCALE, sp[1 * 33] * W8_SCALE, sp[2 * 33] * W8_SCALE, sp[3 * 33] * W8_SCALE); o.y = pk4_fp8(sp[4 * 33] * W8_SCALE, sp[5 * 33] * W8_SCALE, sp[6 * 33] * W8_SCALE, sp[7 * 33] * W8_SCALE);
        o.z = pk4_fp8(sp[8 * 33] * W8_SCALE, sp[9 * 33] * W8_SCALE, sp[10 * 33] * W8_SCALE, sp[11 * 33] * W8_SCALE); o.w = pk4_fp8(sp[12 * 33] * W8_SCALE, sp[13 * 33] * W8_SCALE, sp[14 * 33] * W8_SCALE, sp[15 * 33] * W8_SCALE);
        *(u32x4*)(dst + (size_t)n * Kd + 16 * c) = o; }
    asm volatile("s_waitcnt lgkmcnt(0)" ::: "memory");
}
struct CvtD { const float* W; const float* gain; unsigned char* dst; int ldw, k0, n0, Kd, kind; };
DEV void cvt_load(const CvtD& d, int lane, float (&r)[32]) {
#pragma unroll
    for (int i = 0; i < 8; ++i) { const f32x4 t = *(const f32x4*)(d.W + (size_t)(d.k0 + 8 * i + (lane >> 3)) * d.ldw + d.n0 + 4 * (lane & 7)); r[4 * i] = t[0]; r[4 * i + 1] = t[1]; r[4 * i + 2] = t[2]; r[4 * i + 3] = t[3]; }
}
DEV void cvt_finish(const CvtD& d, const float (&r)[32], LAS float* scr, int lane) {
#pragma unroll
    for (int i = 0; i < 8; ++i)
#pragma unroll
        for (int e = 0; e < 4; ++e) scr[(8 * i + (lane >> 3)) * 33 + 4 * (lane & 7) + e] = r[4 * i + e];
    asm volatile("s_waitcnt lgkmcnt(0)" ::: "memory");
    if (d.kind == 2) {
        const int c = lane & 3;
#pragma unroll
        for (int j = 0; j < 2; ++j) { const int n = (lane >> 2) + 16 * j; const LAS float* sp = scr + (16 * c) * 33 + n;
            u32x4 o; o.x = pk4_fp8(sp[0 * 33] * W8_SCALE, sp[1 * 33] * W8_SCALE, sp[2 * 33] * W8_SCALE, sp[3 * 33] * W8_SCALE); o.y = pk4_fp8(sp[4 * 33] * W8_SCALE, sp[5 * 33] * W8_SCALE, sp[6 * 33] * W8_SCALE, sp[7 * 33] * W8_SCALE);
            o.z = pk4_fp8(sp[8 * 33] * W8_SCALE, sp[9 * 33] * W8_SCALE, sp[10 * 33] * W8_SCALE, sp[11 * 33] * W8_SCALE); o.w = pk4_fp8(sp[12 * 33] * W8_SCALE, sp[13 * 33] * W8_SCALE, sp[14 * 33] * W8_SCALE, sp[15 * 33] * W8_SCALE);
            *(u32x4*)(d.dst + (size_t)n * d.Kd + 16 * c) = o; }
    } else {
        const int c = lane & 7;
        f32x4 g0 = {1.f, 1.f, 1.f, 1.f}, g1 = g0;
        if (d.kind == 1) { g0 = *(const f32x4*)(d.gain + d.k0 + 8 * c); g1 = *(const f32x4*)(d.gain + d.k0 + 8 * c + 4); }
#pragma unroll
        for (int j = 0; j < 4; ++j) { const int n = (lane >> 3) + 8 * j; const LAS float* sp = scr + (8 * c) * 33 + n;
            u32x4 o; o.x = pk2(sp[0 * 33] * g0[0], sp[1 * 33] * g0[1]); o.y = pk2(sp[2 * 33] * g0[2], sp[3 * 33] * g0[3]); o.z = pk2(sp[4 * 33] * g1[0], sp[5 * 33] * g1[1]); o.w = pk2(sp[6 * 33] * g1[2], sp[7 * 33] * g1[3]);
            *(u32x4*)(d.dst + ((size_t)n * d.Kd + 8 * c) * 2) = o; }
    }
    asm volatile("s_waitcnt lgkmcnt(0)" ::: "memory");
}
struct Args { const float* in[18]; float* out; unsigned char* ws; int ph_lo, ph_hi; };
enum { PH_CVT = 0, PH_G1 = 1, PH_GLA1 = 2, PH_SCAN = 3, PH_GLA3 = 4, PH_G2 = 5, PH_G3 = 6, PH_RMS2 = 7, PH_UP = 8, PH_DOWN = 9, PH_RMS1 = 10, PH_LAYER = 16, PH_ROUTE1 = 23, PH_ROUTE2 = 24, PH_MUPA = 25, PH_MDOWNA = 26, PH_MUPB = 27, PH_MDOWNB = 28, PH_COMBINE = 29, PH_END = 30 };

__global__ void __launch_bounds__(512, 2) mega(Args args) {
    extern __shared__ __attribute__((aligned(16))) unsigned char lds_raw[];
    LAS unsigned char* lds = (LAS unsigned char*)lds_raw;
    const int wave = __builtin_amdgcn_readfirstlane((int)threadIdx.x >> 6);
    const int G = gridDim.x, bx = blockIdx.x;
    unsigned char* ws = args.ws;
    const int lo = args.ph_lo, hi = args.ph_hi;
#define IN(k) (lo <= (k) && (k) < hi)
#define SEAM(k) do { if ((k) + 1 < hi) { xcd_barrier(bar); if (DUP_PH == 99) xcd_barrier(bar); } } while (0)
    volatile LAS unsigned* MISC = (volatile LAS unsigned*)(lds + MISC_OFF);
    if (threadIdx.x < 16) MISC[threadIdx.x] = 0u;
    __syncthreads();
    XcdBarrier bar = xcd_barrier_post((unsigned*)(ws + WS_BAR), MISC + 8);
    const int gw = bx * 8 + wave, ngw = G * 8;
    if (IN(PH_CVT)) {
        const int tid = otid(), lane = tid & 63;
        LAS float* scr = (LAS float*)(lds + wave * 16384);
        const int NGW = ngw;
        constexpr int I_IN = 16 * 160, I_BR = 8 * 32, I_OUT = 16 * 32, I_FGU = 16 * 88, I_FD = 44 * 32, I_MGU = 16 * 112, I_MD = 56 * 32;
        constexpr int I_LAYER = I_IN + 2 * I_BR + I_OUT, I_FFN = 2 * I_FGU + I_FD, I_EXP = 2 * I_MGU + I_MD, NITEMS = 2 * I_LAYER + I_FFN + 8 * I_EXP;
        auto decode = [&](int it) -> CvtD {
            CvtD d; int r = it;
            if (r < 2 * I_LAYER) { const int l = r / I_LAYER; r -= l * I_LAYER;
                if (r < I_IN) { const int kb = r / 160, nb = r % 160, n0d = nb * 32, tpn = n0d >> 8, r0 = n0d & 255;
                    int n0s; if (tpn < 4) n0s = r0 < 128 ? 128 * tpn + r0 : 1024 + 128 * tpn + (r0 - 128); else if (tpn < 6) n0s = 512 + 256 * (tpn - 4) + r0; else { const int c = 1536 + 256 * (tpn - 6) + r0; n0s = c < 3072 ? c : c + 16; }
                    d.W = args.in[2] + (size_t)l * D * IN_COLS; d.ldw = IN_COLS; d.k0 = kb * 64; d.n0 = n0s; d.dst = ws + WS_WIN + (((size_t)l * NW1 + n0d) * D + kb * 64) * 2; d.Kd = D; d.gain = args.in[1] + l * D; d.kind = 1; return d; }
                r -= I_IN;
                if (r < 2 * I_BR) { const int br = r / I_BR; r -= br * I_BR; const int kb = r / 32, nb = r % 32;
                    d.W = args.in[7] + (size_t)(l * 2 + br) * CC * D; d.ldw = D; d.k0 = kb * 64; d.n0 = nb * 32; d.dst = ws + WS_WBR + (((size_t)(l * 2 + br) * D + nb * 32) * CC + kb * 64) * 2; d.Kd = CC; d.gain = nullptr; d.kind = 0; return d; }
                r -= 2 * I_BR;
                { const int kb = r / 32, nb = r % 32; d.W = args.in[8] + (size_t)l * D * D; d.ldw = D; d.k0 = kb * 64; d.n0 = nb * 32; d.dst = ws + WS_WOUT + (((size_t)l * D + nb * 32) * D + kb * 64) * 2; d.Kd = D; d.gain = nullptr; d.kind = 0; return d; }
            }
            r -= 2 * I_LAYER;
            if (r < I_FFN) {
                if (r < 2 * I_FGU) { const int up = r / I_FGU; r -= up * I_FGU; const int kb = r / 88, nb = r % 88, n0 = nb * 32, drow = (n0 >> 7) * 256 + up * 128 + (n0 & 127);
                    d.W = args.in[10 + up]; d.ldw = DFF; d.k0 = kb * 64; d.n0 = n0; d.dst = ws + WS_WFGU + ((size_t)drow * D + kb * 64) * 2; d.Kd = D; d.gain = args.in[9]; d.kind = 1; return d; }
                r -= 2 * I_FGU;
                { const int kb = r / 32, nb = r % 32; d.W = args.in[12]; d.ldw = D; d.k0 = kb * 64; d.n0 = nb * 32; d.dst = ws + WS_WFD + ((size_t)(nb * 32) * DFF + kb * 64) * 2; d.Kd = DFF; d.gain = nullptr; d.kind = 0; return d; }
            }
            r -= I_FFN;
            { const int e = r / I_EXP; r -= e * I_EXP;
                if (r < 2 * I_MGU) { const int up = r / I_MGU; r -= up * I_MGU; const int kb = r / 112, nb = r % 112, n0 = nb * 32, drow = (n0 >> 7) * 256 + up * 128 + (n0 & 127);
                    d.W = args.in[14 + up] + (size_t)e * D * DFE; d.ldw = DFE; d.k0 = kb * 64; d.n0 = n0; d.dst = ws + WS_WMGU + ((size_t)e * 2 * DFE + drow) * D + kb * 64; d.Kd = D; d.gain = nullptr; d.kind = 2; return d; }
                r -= 2 * I_MGU;
                { const int kb = r / 32, nb = r % 32; d.W = args.in[16] + (size_t)e * DFE * D; d.ldw = D; d.k0 = kb * 64; d.n0 = nb * 32; d.dst = ws + WS_WMD + ((size_t)e * D + nb * 32) * DFE + kb * 64; d.Kd = DFE; d.gain = nullptr; d.kind = 2; return d; } }
        };
        if (gw < NITEMS) {
            int it = gw; CvtD d = decode(it); float r[32]; cvt_load(d, lane, r);
            for (;;) {
                const int nx = it + NGW;
                if (nx < NITEMS) { const CvtD dn = decode(nx); float rn[32]; cvt_load(dn, lane, rn); cvt_finish(d, r, scr, lane); d = dn;
#pragma unroll
                    for (int i = 0; i < 32; ++i) r[i] = rn[i];
                    it = nx; }
                else { cvt_finish(d, r, scr, lane); break; }
            }
        }
        for (int i = bx * 512 + tid; i < 2 * RANK * D; i += G * 512) { const int l = i / (RANK * D), n = (i / D) % RANK, k = i % D; ((bf16*)(ws + WS_WA))[i] = (bf16)f2bf(args.in[2][(size_t)l * D * IN_COLS + (size_t)k * IN_COLS + 3072 + n] * args.in[1][l * D + k]); }
        for (int i = bx * 512 + tid; i < 2 * KW * RANK; i += G * 512) { const int l = i / (KW * RANK), j = (i / RANK) % KW, r = i % RANK; ((bf16*)(ws + WS_WA2))[i] = (bf16)f2bf(args.in[3][(size_t)l * RANK * KW + r * KW + j]); }
        xb_rows(args.in[0], (bf16*)(ws + WS_HB), (float*)(ws + WS_SSQ), gw, ngw);
        __syncthreads();
        SEAM(PH_CVT);
    }
    for (int l = 0; l < 2; ++l) {
        const int pb = l * PH_LAYER;
        bf16* p = (bf16*)(ws + WS_P); bf16* hb = (bf16*)(ws + WS_HB); bf16* merged = (bf16*)(ws + WS_U);
        if (IN(pb + PH_G1)) {
            SchedGrid S{(const char*)hb, (const char*)((bf16*)(ws + WS_WIN) + (size_t)l * NW1 * D), (size_t)256 * D * 2, (size_t)256 * D * 2, M / 256, NW1 / 256, G, bx};
            fill_rstd((LAS float*)(lds + RSTD_OFF), S, (const float*)(ws + WS_SSQ));
            for (int rep_ = 0; rep_ < NREP(pb + PH_G1); ++rep_) pg8::gemm_phase<EG1, SchedGrid, true, true>(lds, D, D, D, S, EG1{p, (const LAS float*)(lds + RSTD_OFF)});
            SEAM(pb + PH_G1);
        }
        if (IN(pb + PH_GLA1)) {
            for (int rep_ = 0; rep_ < NREP(pb + PH_GLA1); ++rep_)
            for (int item = bx; item < M / 64; item += G) {
                if (rep_ == NREP(pb + PH_GLA1) - 1) conv_item(p, args.in[5] + l * 3 * CC, item);
                gla_pass1(lds, hb, (const float*)(ws + WS_SSQ), p, (const bf16*)(ws + WS_WA) + (size_t)l * RANK * D, (const bf16*)(ws + WS_WA2) + (size_t)l * KW * RANK, args.in[4] + l * KW, (float*)(ws + WS_BG), (bf16*)(ws + WS_U), (float*)(ws + WS_DL), item);
                __syncthreads();
            }
            SEAM(pb + PH_GLA1);
        }
        if (IN(pb + PH_SCAN)) { for (int rep_ = 0; rep_ < NREP(pb + PH_SCAN); ++rep_) gla_scan((const bf16*)(ws + WS_U), (const float*)(ws + WS_DL), (bf16*)(ws + WS_SP), bx, G * 512); SEAM(pb + PH_SCAN); }
        if (IN(pb + PH_GLA3)) {
            for (int rep_ = 0; rep_ < NREP(pb + PH_GLA3); ++rep_)
            for (int item = bx; item < M / 64; item += G) { const bool lastrep = rep_ == NREP(pb + PH_GLA3) - 1;
                gla_pass3(lds, p, (const float*)(ws + WS_BG), (const bf16*)(ws + WS_SP), args.in[6] + l * DV, item, lastrep ? p + P_GO : (bf16*)(ws + WS_ACTP), lastrep ? PLD : VW); __syncthreads(); }
            SEAM(pb + PH_GLA3);
        }
        if (IN(pb + PH_G2)) {
            const bf16* wb = (const bf16*)(ws + WS_WBR) + (size_t)l * 2 * D * CC;
            SchedPair S{(const char*)(p + P_GB), (const char*)(p + P_GO), (const char*)wb, (const char*)(wb + (size_t)D * CC), (size_t)256 * PLD * 2, (size_t)256 * CC * 2, M / 256, D / 256, G, bx};
            for (int rep_ = 0; rep_ < NREP(pb + PH_G2); ++rep_) pg8::gemm_phase<EMerge, SchedPair, true, true>(lds, CC, PLD, CC, S, EMerge{merged, p});
            SEAM(pb + PH_G2);
        }
        if (IN(pb + PH_G3)) {
            SchedGrid S{(const char*)merged, (const char*)((bf16*)(ws + WS_WOUT) + (size_t)l * D * D), (size_t)256 * D * 2, (size_t)256 * D * 2, M / 256, D / 256, G, bx};
            if (l == 0) { for (int rep_ = 0; rep_ < NREP(pb + PH_G3); ++rep_) pg8::gemm_phase<ERes, SchedGrid, true, true>(lds, D, D, D, S, ERes{hb, (float*)(ws + WS_SSQ), (LAS float*)(lds + PSTAT_OFF)}); }
            else pg8::gemm_phase<EResT<false>, SchedGrid, true, true>(lds, D, D, D, S, EResT<false>{hb, nullptr, nullptr});
            SEAM(pb + PH_G3);
        }
        if (l == 0) {
            bf16* act = (bf16*)(ws + WS_P);
            if (IN(PH_UP)) {
                SchedGrid S{(const char*)hb, (const char*)(ws + WS_WFGU), (size_t)256 * D * 2, (size_t)256 * D * 2, M / 256, 2 * DFF / 256, G, bx};
                fill_rstd((LAS float*)(lds + RSTD_OFF), S, (const float*)(ws + WS_SSQ));
                for (int rep_ = 0; rep_ < NREP(PH_UP); ++rep_) pg8::gemm_phase<ESwiglu, SchedGrid, true, true>(lds, D, D, D, S, ESwiglu{act, DFF, (const LAS float*)(lds + RSTD_OFF)});
                SEAM(PH_UP);
            }
            if (IN(PH_DOWN)) {
                SchedGrid S{(const char*)act, (const char*)(ws + WS_WFD), (size_t)256 * DFF * 2, (size_t)256 * DFF * 2, M / 256, D / 256, G, bx};
                pg8::gemm_phase<ERes, SchedGrid, true, true>(lds, DFF, DFF, DFF, S, ERes{hb, (float*)(ws + WS_SSQ), (LAS float*)(lds + PSTAT_OFF)});
                SEAM(PH_DOWN);
            }
        } else {
            int* tilet = (int*)(ws + WS_TILE); unsigned char* hbp = ws + WS_HBP; unsigned char* actp = ws + WS_ACTP; unsigned char* obuf = ws + WS_OBUF;
            int* counts = (int*)(ws + WS_CNT); int* tok_e = (int*)(ws + WS_TOKE); float* tok_w = (float*)(ws + WS_TOKW); int* slot = (int*)(ws + WS_SLOT); float* rstd = (float*)(ws + WS_RSTD);
            if (IN(PH_ROUTE1)) { route1_stage((LAS float*)lds, args.in[9] + D, args.in[13]);
                for (int rep_ = 0; rep_ < NREP(PH_ROUTE1); ++rep_) for (int grp = bx; grp < M / 64; grp += G) route1_grp((const LAS float*)lds, (LAS int*)(lds + 32768), hb, rstd, tok_e, tok_w, counts, grp); SEAM(PH_ROUTE1); }
            if (IN(PH_ROUTE2)) { for (int rep_ = 0; rep_ < NREP(PH_ROUTE2); ++rep_) for (int grp = bx; grp < M / 64; grp += G) route2_grp((LAS int*)lds, hb, args.in[9] + D, rstd, counts, tok_e, slot, hbp, tilet, grp, bx, G); SEAM(PH_ROUTE2); }
            {
                int nT = 0; if (IN(PH_MUPA) || IN(PH_MDOWNA)) nT = tilet[NTILE_MAX];
                const int nFull = nT < 128 ? nT : 128, nL = nT > 128 ? nT - 128 : 0;
                if (IN(PH_MUPA)) {
                    SchedMoe S{(const char*)hbp, (const char*)(ws + WS_WMGU), tilet, (size_t)256 * D, (size_t)256 * D, (size_t)2 * DFE * D, 0, nT, 2 * DFE / 256, G, bx};
                    for (int rep_ = 0; rep_ < NREP(PH_MUPA); ++rep_) pg8::gemm_phase<ESwiglu8, SchedMoe, true, true, true>(lds, D / 2, D / 2, D / 2, S, ESwiglu8{actp, DFE, W8_INV});
                    SEAM(PH_MUPA);
                }
                if (IN(PH_MDOWNA)) {
                    SchedMoe S{(const char*)actp, (const char*)(ws + WS_WMD), tilet, (size_t)256 * DFE, (size_t)256 * DFE, (size_t)D * DFE, 0, nFull, D / 256, G, bx};
                    for (int rep_ = 0; rep_ < NREP(PH_MDOWNA); ++rep_) pg8::gemm_phase<EOut8, SchedMoe, true, true, true>(lds, DFE / 2, DFE / 2, DFE / 2, S, EOut8{obuf, W8_INV * OB_SCALE});
                    SchedMoeK SK{(const char*)actp, (const char*)(ws + WS_WMD), tilet, nL, G, bx};
                    pg8::gemm_phase<ESlab, SchedMoeK, true, true, true>(lds, KSLICE / 2, DFE / 2, DFE / 2, SK, ESlab{(float*)(ws + WS_OBX), W8_INV});
                    SEAM(PH_MDOWNA);
                }
            }
            if (IN(PH_COMBINE)) combine_rows(hb, obuf, (const float*)(ws + WS_OBX), slot, tok_w, args.in[17], args.out, gw, ngw);
        }
    }
#undef IN
}

extern "C" void kernel_launch(void* const* d_in, const int* in_sizes, int n_in, void* d_out, int out_size, void* d_ws, size_t ws_size, hipStream_t stream) {
    (void)in_sizes;
    if (n_in != 18 || out_size != M * D || ws_size < WS_END) { fprintf(stderr, "kernel_launch: unexpected arguments (n_in %d out %d ws %zu)\n", n_in, out_size, ws_size); return; }
    static int grid = 0;
    if (grid == 0) {
        int dev = 0, cus = 0;
        if (hipGetDevice(&dev) != hipSuccess || hipDeviceGetAttribute(&cus, hipDeviceAttributeMultiprocessorCount, dev) != hipSuccess) { fprintf(stderr, "kernel_launch: device query failed\n"); grid = -1; return; }
        if (hipFuncSetAttribute((const void*)mega, hipFuncAttributeMaxDynamicSharedMemorySize, LDS_BYTES) != hipSuccess) { fprintf(stderr, "kernel_launch: hipFuncSetAttribute failed\n"); grid = -1; return; }
        grid = cus;
    }
    if (grid < 0) return;
    Args a{};
    for (int i = 0; i < 18; ++i) a.in[i] = (const float*)d_in[i];
    a.out = (float*)d_out; a.ws = (unsigned char*)d_ws;
#define MEGA(lo_, hi_) do { a.ph_lo = (lo_); a.ph_hi = (hi_); hipLaunchKernelGGL(mega, dim3(grid), dim3(512), LDS_BYTES, stream, a); } while (0)
    if (hipMemsetAsync(d_ws, 0, 65536, stream) != hipSuccess) { fprintf(stderr, "kernel_launch: memset failed\n"); return; }
#if MK_SPLIT
    { const int ph[] = {0, 1, 2, 3, 4, 5, 6, 7, 8, 9, 10, 17, 18, 19, 20, 21, 22, 23, 24, 25, 26, 27, 28, 29}; for (int i = 0; i < 24; ++i) MEGA(ph[i], ph[i] + 1); }
#else
    MEGA(0, PH_END);
#endif
}
```

```cpp
#include <hip/hip_runtime.h>
#include <cstdio>
#include <cstdint>
#include <cstddef>
#ifndef MK_SPLIT
#define MK_SPLIT 0
#endif
#ifndef DUP_PH
#define DUP_PH -1
#endif
#define NREP(k) (((k) == (DUP_PH)) ? 2 : 1)

typedef unsigned short bf16;
#define DEV __device__ __forceinline__

constexpr int D = 1024, BATCH = 8, SEQ = 2048, M = BATCH * SEQ;
constexpr int CC = 512, KW = 256, VW = 512, RANK = 16, NH = 4, DK = 64, DV = 128;
constexpr int IN_COLS = 5136, NW1 = 5120  , PLD = 3584  ;
constexpr int P_U = 0, P_GB = 512, P_Q = 1024, P_K = 1280, P_V = 1536, P_GO = 2048, PB_GA = 5120, PB_GBB = 6144;
constexpr int DFF = 2816, NE = 8, DFE = 3584;
constexpr float EPS = 1e-6f;
constexpr int PERM_ROWS = 2 * M + NE * 256;
constexpr int NTILE_MAX = PERM_ROWS / 256;
constexpr int CHUNK_TILES = 64;
constexpr int KSPLIT = 7, KSLICE = DFE / KSPLIT;

constexpr size_t MiB = 1ull << 20;
constexpr size_t WS_CNT = 1 * MiB;
constexpr size_t WS_TILE = 1 * MiB + 16384;
constexpr size_t WS_TOKE = 1 * MiB + 65536;
constexpr size_t WS_TOKW = WS_TOKE + 131072;
constexpr size_t WS_SLOT = WS_TOKW + 131072;
constexpr size_t WS_RSTD = WS_SLOT + 131072;
constexpr size_t WS_ALOW = 3 * MiB;
constexpr size_t WS_LOGA = 4 * MiB;
constexpr size_t WS_HB = 234 * MiB;
constexpr size_t WS_P = 266 * MiB;
constexpr size_t WS_U = 426 * MiB;
constexpr size_t WS_ACTP = 266 * MiB;
constexpr size_t WS_HBP = 385 * MiB;
constexpr size_t WS_OBUF = 419 * MiB;
constexpr size_t WS_OBX = 4 * MiB;
constexpr size_t WS_END = 489 * MiB;

DEV float bf2f(unsigned v) { return __uint_as_float(v << 16); }
DEV unsigned f2bf(float f) { unsigned u = __float_as_uint(f); return (u + 0x7fffu + ((u >> 16) & 1u)) >> 16; }
DEV unsigned pk2(float lo, float hi) { return f2bf(lo) | (f2bf(hi) << 16); }
DEV float wave_sum(float v) {
#pragma unroll
    for (int o = 1; o < 64; o <<= 1) v += __shfl_xor(v, o);
    return v;
}

DEV float row_rstd(const float* ssq, int row) { return rsqrtf(((ssq[row] + ssq[M + row]) + (ssq[2 * M + row] + ssq[3 * M + row])) * (1.0f / D) + EPS); }
#define LAS __attribute__((address_space(3)))
typedef short bf16x8 __attribute__((ext_vector_type(8)));
typedef float f32x4 __attribute__((ext_vector_type(4)));
typedef float f32x2 __attribute__((ext_vector_type(2)));
typedef _Float16 f16x8 __attribute__((ext_vector_type(8)));
typedef unsigned u32x4 __attribute__((ext_vector_type(4)));
typedef unsigned u32x2 __attribute__((ext_vector_type(2)));
DEV unsigned cvt_pk_bf16(float lo, float hi) { unsigned r; asm volatile("v_cvt_pk_bf16_f32 %0, %1, %2" : "=v"(r) : "v"(lo), "v"(hi)); return r; }
DEV float fsig(float x) { return __builtin_amdgcn_rcpf(1.0f + __builtin_amdgcn_exp2f(-1.44269504f * x)); }
DEV float blo(unsigned w) { return __uint_as_float(w << 16); }
DEV float bhi(unsigned w) { return __uint_as_float(w & 0xffff0000u); }

typedef int i32x4 __attribute__((ext_vector_type(4)));
typedef int i32x8 __attribute__((ext_vector_type(8)));
DEV i32x8 cat8(bf16x8 lo, bf16x8 hi) { return __builtin_shufflevector(__builtin_bit_cast(i32x4, lo), __builtin_bit_cast(i32x4, hi), 0, 1, 2, 3, 4, 5, 6, 7); }
DEV unsigned pk4_fp8(float a, float b, float c, float d) { int w = 0; w = __builtin_amdgcn_cvt_pk_fp8_f32(a, b, w, false); w = __builtin_amdgcn_cvt_pk_fp8_f32(c, d, w, true); return (unsigned)w; }
constexpr float W8_SCALE = 64.0f, W8_INV = 1.0f / 64.0f;
namespace pg8 {
constexpr int BM = 256, BK = 64, HALF = 128, HTB = HALF * BK * 2, STAGE_BYTES = 8 * HTB, NXCD = 8, WGM = 8;
__host__ __device__ __forceinline__ int lds_byte(int r, int c) { const int st = (r >> 4) * 2 + (c >> 5), rr = r & 15, cc = c & 31, ob = rr * 64 + cc * 2; return st * 1024 + (ob ^ (((ob >> 9) & 1) << 5)); }
__host__ __device__ __forceinline__ void stage_rc(int b, int& R, int& C) { const int st = b / 1024, sb = b % 1024, swz = sb ^ (((sb >> 9) & 1) << 5); R = (st >> 1) * 16 + swz / 64; C = (st & 1) * 32 + (swz % 64) / 2; }
__host__ __device__ __forceinline__ int perm32(int rho) { const int n = rho >> 4, i = rho & 15; return 8 * (i >> 2) + 4 * n + (i & 3); }

struct Unit { const char* A; const char* B; int pm, pn, aux; };
DEV bool tile_of(int L, int nM, int nN, int& pm, int& pn) {
    const int nwg = nM * nN; if (L >= nwg) return false;
    int wgid = L; { const int q = nwg / NXCD, r = nwg % NXCD, xcd = wgid % NXCD, off = wgid / NXCD; wgid = (xcd < r ? xcd * (q + 1) : r * (q + 1) + (xcd - r) * q) + off; }
    const int nig = WGM * nN, gid = wgid / nig, fm = gid * WGM, gsz = (nM - fm) < WGM ? (nM - fm) : WGM;
    pm = fm + ((wgid % nig) % gsz); pn = (wgid % nig) / gsz; return true;
}

template <class Epi, class Sched, bool ALIGN_EPI, bool SP2, bool FP8 = false>
DEV void gemm_phase(LAS unsigned char* lds, const int K, const int lda, const int ldb, const Sched& S, const Epi& E) {
    int tid_ = threadIdx.x; asm volatile("" : "+v"(tid_));
    const int tid = tid_, wid = __builtin_amdgcn_readfirstlane(tid >> 6), lane = tid & 63, wr = wid >> 2, wc = wid & 3, fr = lane & 15, fq = lane >> 4;
    const int nt = K / BK;
    unsigned voffA[2], voffB[2];
#pragma unroll
    for (int i = 0; i < 2; ++i) { int R, C; stage_rc(tid * 16 + i * 8192, R, C); const int Rb = Epi::PERM ? ((R & ~31) + perm32(R & 31)) : R;
        voffA[i] = (unsigned)(R * lda + C) * 2u; voffB[i] = (unsigned)(Rb * ldb + C) * 2u; }
    const size_t kstep = (size_t)(BK * 2);
    const size_t hstepA = (size_t)HALF * lda * 2, hstepB = (size_t)HALF * ldb * 2;
    const unsigned ldsw = (unsigned)wid * 1024u;
    const int aoff = lds_byte(wr * 64 + fr, fq * 8), boff = lds_byte(wc * 32 + fr, fq * 8);

#define PG8_SA(b, h) (((b) * 2 + (h)) * HTB)
#define PG8_SB(b, h) ((4 + (b) * 2 + (h)) * HTB)
#define PG8_STAGE(bufoff, gbase, voff) do { _Pragma("unroll") for (int _i = 0; _i < 2; ++_i) \
        __builtin_amdgcn_global_load_lds((const unsigned*)((const char*)(gbase) + (voff)[_i]), (LAS unsigned*)(lds + (bufoff) + ldsw + _i * 8192), 16, 0, 0); } while (0)
#define PG8_RD(off) (*(const LAS bf16x8*)(lds + (off)))
#define PG8_LDA(dst, b, h) do { if constexpr (FP8) { _Pragma("unroll") for (int m = 0; m < 4; ++m) dst##8[m] = cat8(PG8_RD(PG8_SA(b, h) + aoff + m * 2048), PG8_RD(PG8_SA(b, h) + aoff + m * 2048 + 1024)); } \
        else { _Pragma("unroll") for (int m = 0; m < 4; ++m) _Pragma("unroll") for (int k = 0; k < 2; ++k) dst[m][k] = PG8_RD(PG8_SA(b, h) + aoff + m * 2048 + k * 1024); } } while (0)
#define PG8_LDB(dst, b, h) do { if constexpr (FP8) { _Pragma("unroll") for (int n = 0; n < 2; ++n) dst##8[n] = cat8(PG8_RD(PG8_SB(b, h) + boff + n * 2048), PG8_RD(PG8_SB(b, h) + boff + n * 2048 + 1024)); } \
        else { _Pragma("unroll") for (int n = 0; n < 2; ++n) _Pragma("unroll") for (int k = 0; k < 2; ++k) dst[n][k] = PG8_RD(PG8_SB(b, h) + boff + n * 2048 + k * 1024); } } while (0)
#define PG8_MMA(ai, bj, At, Bt) do { __builtin_amdgcn_s_setprio(1); _Pragma("unroll") for (int m = 0; m < 4; ++m) _Pragma("unroll") for (int n = 0; n < 2; ++n) { \
        if constexpr (FP8) asm volatile("v_mfma_scale_f32_16x16x128_f8f6f4 %0, %1, %2, %0, %3, %3 op_sel_hi:[0,0,0]" : "+v"(acc[ai][bj][m][n]) : "v"(Bt##8[n]), "v"(At##8[m]), "v"(one8)); \
        else { _Pragma("unroll") for (int k = 0; k < 2; ++k) acc[ai][bj][m][n] = __builtin_amdgcn_mfma_f32_16x16x32_bf16(Bt[n][k], At[m][k], acc[ai][bj][m][n], 0, 0, 0); } } __builtin_amdgcn_s_setprio(0); } while (0)
#define PG8_WAIT_V(n) asm volatile("s_waitcnt vmcnt(" #n ")" ::: "memory")
#define PG8_WAIT_L(n) asm volatile("s_waitcnt lgkmcnt(" #n ")" ::: "memory")
#define PG8_BAR __builtin_amdgcn_s_barrier()
#define PG8_SCHED __builtin_amdgcn_sched_barrier(0)
    Unit cur, nxt; int ui = 0;
    if (!S.next(0, cur)) return;
    f32x4 acc[2][2][4][2];
#pragma unroll
    for (int a = 0; a < 2; ++a)
#pragma unroll
        for (int b = 0; b < 2; ++b)
#pragma unroll
            for (int m = 0; m < 4; ++m)
#pragma unroll
                for (int n = 0; n < 2; ++n) acc[a][b][m][n] = (f32x4){0.f, 0.f, 0.f, 0.f};
    const int one8 = 0x7F7F7F7F;
    bf16x8 At[4][2], B0[2][2], B1[2][2]; i32x8 At8[4], B08[2], B18[2];
    const char* cA = cur.A; const char* cB = cur.B;
    if constexpr (SP2) {
        PG8_STAGE(PG8_SB(0, 0), cB, voffB); PG8_STAGE(PG8_SB(0, 1), cB + hstepB, voffB); PG8_STAGE(PG8_SA(0, 0), cA, voffA); PG8_STAGE(PG8_SA(0, 1), cA + hstepA, voffA);
        if (wr == 1) PG8_BAR;
        PG8_WAIT_V(2); PG8_BAR;
        PG8_STAGE(PG8_SB(1, 0), cB + kstep, voffB); PG8_STAGE(PG8_SA(1, 0), cA + kstep, voffA); PG8_STAGE(PG8_SB(1, 1), cB + hstepB + kstep, voffB);
        PG8_WAIT_V(6); PG8_BAR;
    } else {
        PG8_STAGE(PG8_SB(0, 0), cB, voffB); PG8_STAGE(PG8_SA(0, 0), cA, voffA); PG8_STAGE(PG8_SB(0, 1), cB + hstepB, voffB); PG8_STAGE(PG8_SA(0, 1), cA + hstepA, voffA);
        if (wr == 1) PG8_BAR;
        PG8_WAIT_V(4); PG8_BAR;
        PG8_STAGE(PG8_SB(1, 0), cB + kstep, voffB); PG8_STAGE(PG8_SA(1, 0), cA + kstep, voffA); PG8_STAGE(PG8_SB(1, 1), cB + hstepB + kstep, voffB);
        PG8_WAIT_V(6); PG8_BAR;
    }
    for (;;) {
        const bool has_next = S.next(ui + 1, nxt);
        const char* nA = has_next ? nxt.A : cA; const char* nB = has_next ? nxt.B : cB;
#pragma nounroll
        for (int t = 0; t < nt; t += 2) {
            const bool last = (t == nt - 2);
            const char* a1 = cA + (size_t)(t + 1) * kstep;
            const char* a2 = last ? nA : cA + (size_t)(t + 2) * kstep; const char* b2 = last ? nB : cB + (size_t)(t + 2) * kstep;
            const char* a3 = a2 + kstep; const char* b3 = b2 + kstep;
            if constexpr (SP2) {
            PG8_LDB(B0, 0, 0); PG8_LDB(B1, 0, 1); PG8_SCHED; PG8_LDA(At, 0, 0); PG8_STAGE(PG8_SA(1, 1), a1 + hstepA, voffA);
            PG8_WAIT_V(8); PG8_WAIT_L(0); PG8_BAR; PG8_MMA(0, 0, At, B0); PG8_MMA(0, 1, At, B1); PG8_BAR; PG8_SCHED;
            PG8_LDA(At, 0, 1); PG8_STAGE(PG8_SB(0, 0), b2, voffB); PG8_STAGE(PG8_SB(0, 1), b2 + hstepB, voffB); PG8_STAGE(PG8_SA(0, 0), a2, voffA);
            PG8_WAIT_V(8); PG8_WAIT_L(0); PG8_BAR; PG8_MMA(1, 0, At, B0); PG8_MMA(1, 1, At, B1); PG8_BAR; PG8_SCHED;
            PG8_LDB(B0, 1, 0); PG8_LDB(B1, 1, 1); PG8_SCHED; PG8_LDA(At, 1, 0); PG8_STAGE(PG8_SA(0, 1), a2 + hstepA, voffA);
            PG8_WAIT_V(8); PG8_WAIT_L(0); PG8_BAR; PG8_MMA(0, 0, At, B0); PG8_MMA(0, 1, At, B1); PG8_BAR; PG8_SCHED;
            PG8_LDA(At, 1, 1); PG8_STAGE(PG8_SB(1, 0), b3, voffB); PG8_STAGE(PG8_SB(1, 1), b3 + hstepB, voffB); PG8_STAGE(PG8_SA(1, 0), a3, voffA);
            PG8_WAIT_V(8); PG8_WAIT_L(0); PG8_BAR; PG8_MMA(1, 0, At, B0); PG8_MMA(1, 1, At, B1); PG8_BAR; PG8_SCHED;
            } else {
            PG8_LDB(B0, 0, 0); PG8_SCHED; PG8_LDA(At, 0, 0); PG8_STAGE(PG8_SA(1, 1), a1 + hstepA, voffA);
            PG8_WAIT_L(8); PG8_BAR; PG8_WAIT_L(0); PG8_MMA(0, 0, At, B0); PG8_BAR; PG8_SCHED;
            PG8_LDB(B1, 0, 1); PG8_STAGE(PG8_SB(0, 0), b2, voffB);
            PG8_BAR; PG8_WAIT_L(0); PG8_MMA(0, 1, At, B1); PG8_BAR;
            PG8_LDA(At, 0, 1); PG8_STAGE(PG8_SA(0, 0), a2, voffA);
            PG8_BAR; PG8_WAIT_L(0); PG8_MMA(1, 0, At, B0); PG8_BAR; PG8_SCHED;
            PG8_STAGE(PG8_SB(0, 1), b2 + hstepB, voffB);
            PG8_WAIT_V(6); PG8_BAR; PG8_MMA(1, 1, At, B1); PG8_BAR;
            PG8_LDB(B0, 1, 0); PG8_SCHED; PG8_LDA(At, 1, 0); PG8_STAGE(PG8_SA(0, 1), a2 + hstepA, voffA);
            PG8_WAIT_L(8); PG8_BAR; PG8_WAIT_L(0); PG8_MMA(0, 0, At, B0); PG8_BAR; PG8_SCHED;
            PG8_LDB(B1, 1, 1); PG8_STAGE(PG8_SB(1, 0), b3, voffB);
            PG8_BAR; PG8_WAIT_L(0); PG8_MMA(0, 1, At, B1); PG8_BAR;
            PG8_LDA(At, 1, 1); PG8_STAGE(PG8_SA(1, 0), a3, voffA);
            PG8_BAR; PG8_WAIT_L(0); PG8_MMA(1, 0, At, B0); PG8_BAR; PG8_SCHED;
            PG8_STAGE(PG8_SB(1, 1), b3 + hstepB, voffB);
            PG8_WAIT_V(6); PG8_BAR; PG8_MMA(1, 1, At, B1); PG8_BAR;
            }
        }
        if constexpr (ALIGN_EPI) { if (wr == 0) PG8_BAR; }
        if constexpr (FP8) { asm volatile("s_nop 15\n\ts_nop 15" ::: "memory"); PG8_SCHED; }
        E(acc, cur, wr, wc, fr, fq);
        if (!has_next) break;
#pragma unroll
        for (int a = 0; a < 2; ++a)
#pragma unroll
            for (int b = 0; b < 2; ++b)
#pragma unroll
                for (int m = 0; m < 4; ++m)
#pragma unroll
                    for (int n = 0; n < 2; ++n) acc[a][b][m][n] = (f32x4){0.f, 0.f, 0.f, 0.f};
        cur = nxt; cA = nA; cB = nB; ++ui;
        if constexpr (ALIGN_EPI) { if (wr == 1) PG8_BAR; }
    }
    PG8_WAIT_V(0);
    if constexpr (!ALIGN_EPI) { if (wr == 0) PG8_BAR; }
    PG8_BAR;
#undef PG8_SA
#undef PG8_SB
#undef PG8_STAGE
#undef PG8_LDA
#undef PG8_RD
#undef PG8_LDB
#undef PG8_MMA
#undef PG8_WAIT_V
#undef PG8_WAIT_L
#undef PG8_BAR
#undef PG8_SCHED
}
}
using pg8::Unit;

struct SchedGrid { const char* A; const char* B; size_t astep, bstep; int nM, nN, G, c;
    DEV bool next(int i, Unit& u) const { int pm, pn; if (!pg8::tile_of(i * G + c, nM, nN, pm, pn)) return false; u.A = A + (size_t)pm * astep; u.B = B + (size_t)pn * bstep; u.pm = pm; u.pn = pn; u.aux = i; return true; } };
struct SchedPair { const char* A0; const char* A1; const char* B0; const char* B1; size_t astep, bstep; int nM, nN, G, c;
    DEV bool next(int i, Unit& u) const { int pm, pn; if (!pg8::tile_of((i >> 1) * G + c, nM, nN, pm, pn)) return false; const int br = i & 1; u.A = (br ? A1 : A0) + (size_t)pm * astep; u.B = (br ? B1 : B0) + (size_t)pn * bstep; u.pm = pm; u.pn = pn; u.aux = br; return true; } };
struct SchedMoe { const char* A; const char* B; const int* tile_e; size_t astep, bstep, estep; int t0, nM, nN, G, c;
    DEV bool next(int i, Unit& u) const { int pm, pn; if (!pg8::tile_of(i * G + c, nM, nN, pm, pn)) return false; const int e = tile_e[t0 + pm]; u.A = A + (size_t)pm * astep; u.B = B + (size_t)e * estep + (size_t)pn * bstep; u.pm = pm; u.pn = pn; u.aux = e; return true; } };

struct SchedMoeK { const char* A; const char* B; const int* tile_e; int nL, G, c;
    DEV bool next(int i, Unit& u) const { const int L = i * G + c; if (L >= nL * 4 * KSPLIT) return false; const int ks = L % KSPLIT, pn = (L / KSPLIT) & 3, lt = L / (4 * KSPLIT); const int e = tile_e[128 + lt];
        u.A = A + ((size_t)(128 + lt) * 256 * DFE + (size_t)ks * KSLICE); u.B = B + ((size_t)e * D * DFE + (size_t)pn * 256 * DFE + (size_t)ks * KSLICE);     u.pm = lt; u.pn = pn; u.aux = ks; return true; } };
template <class Sched> DEV void fill_rstd(LAS float* R, const Sched& S, const float* ssq, int slot0 = 0, bool sync = true) {
    int t = threadIdx.x; asm volatile("" : "+v"(t)); Unit u;
    for (int i = 0; i + slot0 < 8 && S.next(i, u); ++i) if (t < 256) R[(i + slot0) * 256 + t] = row_rstd(ssq, u.pm * 256 + t);
    if (sync) __syncthreads();
}
typedef const f32x4 (&AccRef)[2][2][4][2];
template <bool RS> struct EBf16T { static constexpr bool PERM = true; bf16* O; int ldc; float sc; const LAS float* R;
    DEV void operator()(AccRef acc, const Unit& u, int wr, int wc, int fr, int fq) const {
        const int row0 = u.pm * 256 + wr * 64 + fr, col0 = u.pn * 256 + wc * 32 + 8 * fq;
        float rsv[2][4];
#pragma unroll
        for (int ai = 0; ai < 2; ++ai)
#pragma unroll
            for (int m = 0; m < 4; ++m) rsv[ai][m] = RS ? sc * R[u.aux * 256 + ai * 128 + wr * 64 + m * 16 + fr] : sc;
#pragma unroll
        for (int ai = 0; ai < 2; ++ai)
#pragma unroll
            for (int m = 0; m < 4; ++m) { const int row = row0 + ai * 128 + m * 16; bf16* rowp = O + (size_t)row * ldc + col0; const float rs = rsv[ai][m];
#pragma unroll
                for (int bj = 0; bj < 2; ++bj) { const f32x4 v0 = acc[ai][bj][m][0] * rs, v1 = acc[ai][bj][m][1] * rs; u32x4 w; w.x = cvt_pk_bf16(v0[0], v0[1]); w.y = cvt_pk_bf16(v0[2], v0[3]); w.z = cvt_pk_bf16(v1[0], v1[1]); w.w = cvt_pk_bf16(v1[2], v1[3]);
                    *(u32x4*)(rowp + bj * 128) = w; } }
    } };
typedef EBf16T<false> EBf16;
constexpr float OB_SCALE = 8.0f;
struct EOut8 { static constexpr bool PERM = true; unsigned char* O; float sc;
    DEV void operator()(AccRef acc, const Unit& u, int wr, int wc, int fr, int fq) const {
        const int row0 = u.pm * 256 + wr * 64 + fr, col0 = u.pn * 256 + wc * 32 + 8 * fq;
#pragma unroll
        for (int ai = 0; ai < 2; ++ai)
#pragma unroll
            for (int m = 0; m < 4; ++m) { unsigned char* rowp = O + (size_t)(row0 + ai * 128 + m * 16) * D + col0;
#pragma unroll
                for (int bj = 0; bj < 2; ++bj) { const f32x4 v0 = acc[ai][bj][m][0] * sc, v1 = acc[ai][bj][m][1] * sc; u32x2 w; w.x = pk4_fp8(v0[0], v0[1], v0[2], v0[3]); w.y = pk4_fp8(v1[0], v1[1], v1[2], v1[3]);
                    *(u32x2*)(rowp + bj * 128) = w; } }
    } };
struct EG1 { static constexpr bool PERM = true; bf16* p; const LAS float* R;
    DEV void operator()(AccRef acc, const Unit& u, int wr, int wc, int fr, int fq) const {
        const int row0 = u.pm * 256 + wr * 64 + fr, c8 = wc * 32 + 8 * fq;
        float rsv[2][4];
#pragma unroll
        for (int ai = 0; ai < 2; ++ai)
#pragma unroll
            for (int m = 0; m < 4; ++m) rsv[ai][m] = R[u.aux * 256 + ai * 128 + wr * 64 + m * 16 + fr];
        if (u.pn < 4) {
#pragma unroll
            for (int ai = 0; ai < 2; ++ai)
#pragma unroll
                for (int m = 0; m < 4; ++m) { const float r2 = rsv[ai][m] * rsv[ai][m]; const f32x4 a0 = acc[ai][0][m][0], a1 = acc[ai][0][m][1], g0 = acc[ai][1][m][0] * r2, g1 = acc[ai][1][m][1] * r2;
                    u32x4 w; w.x = cvt_pk_bf16(a0[0] * g0[0], a0[1] * g0[1]); w.y = cvt_pk_bf16(a0[2] * g0[2], a0[3] * g0[3]); w.z = cvt_pk_bf16(a1[0] * g1[0], a1[1] * g1[1]); w.w = cvt_pk_bf16(a1[2] * g1[2], a1[3] * g1[3]);
                    *(u32x4*)(p + (size_t)(row0 + ai * 128 + m * 16) * PLD + P_U + 128 * u.pn + c8) = w; }
        } else if (u.pn < 12) {
            const int colt = P_GB + 256 * (u.pn - 4) + c8;
#pragma unroll
            for (int ai = 0; ai < 2; ++ai)
#pragma unroll
                for (int m = 0; m < 4; ++m) { const float rs = rsv[ai][m]; bf16* rowp = p + (size_t)(row0 + ai * 128 + m * 16) * PLD + colt;
#pragma unroll
                    for (int bj = 0; bj < 2; ++bj) { const f32x4 v0 = acc[ai][bj][m][0] * rs, v1 = acc[ai][bj][m][1] * rs; u32x4 w; w.x = cvt_pk_bf16(v0[0], v0[1]); w.y = cvt_pk_bf16(v0[2], v0[3]); w.z = cvt_pk_bf16(v1[0], v1[1]); w.w = cvt_pk_bf16(v1[2], v1[3]);
                        *(u32x4*)(rowp + bj * 128) = w; } }
        }
    } };
DEV f32x4 sig255(f32x4 x, float k1) {
    f32x4 e = x * k1;
#pragma unroll
    for (int i = 0; i < 4; ++i) e[i] = __builtin_amdgcn_exp2f(e[i]);
    f32x4 d = e * (1.0f / 255.0f) + (1.0f / 255.0f);
#pragma unroll
    for (int i = 0; i < 4; ++i) d[i] = __builtin_amdgcn_rcpf(d[i]);
    return d + 0.5f;
}
struct EG1g { static constexpr bool PERM = true; bf16* p; const LAS float* R;
    DEV void operator()(AccRef acc, const Unit& u, int wr, int wc, int fr, int fq) const {
        const int row0 = u.pm * 256 + wr * 64 + fr, bofs = PB_GA + 256 * u.pn + wc * 32 + 8 * fq;
#pragma unroll
        for (int ai = 0; ai < 2; ++ai)
#pragma unroll
            for (int m = 0; m < 4; ++m) { const float rs = R[u.aux * 256 + ai * 128 + wr * 64 + m * 16 + fr] * W8_INV; unsigned char* rowb = (unsigned char*)(p + (size_t)(row0 + ai * 128 + m * 16) * PLD) + bofs;
#pragma unroll
                for (int bj = 0; bj < 2; ++bj) { const f32x4 v0 = sig255(acc[ai][bj][m][0], rs * -1.44269504f), v1 = sig255(acc[ai][bj][m][1], rs * -1.44269504f);
                    unsigned q[8] = {(unsigned)v0[0], (unsigned)v0[1], (unsigned)v0[2], (unsigned)v0[3], (unsigned)v1[0], (unsigned)v1[1], (unsigned)v1[2], (unsigned)v1[3]};
                    u32x2 w; w.x = q[0] | (q[1] << 8) | (q[2] << 16) | (q[3] << 24); w.y = q[4] | (q[5] << 8) | (q[6] << 16) | (q[7] << 24);
                    *(u32x2*)(rowb + bj * 128) = w; } }
    } };
struct EMerge { static constexpr bool PERM = true; bf16* mg; const bf16* p;
    DEV void operator()(AccRef acc, const Unit& u, int wr, int wc, int fr, int fq) const {
        const int row0 = u.pm * 256 + wr * 64 + fr, col0 = u.pn * 256 + wc * 32 + 8 * fq; const int gofs = u.aux ? PB_GBB : PB_GA;
        u32x2 gt[2][2][2]; u32x4 od[2][2][2];
#define EM_LOAD(q) do { _Pragma("unroll") for (int mm = 0; mm < 2; ++mm) _Pragma("unroll") for (int bj = 0; bj < 2; ++bj) { const size_t row = (size_t)(row0 + ((q) >> 1) * 128 + (2 * ((q) & 1) + mm) * 16); const int col = col0 + bj * 128; \
            gt[(q) & 1][mm][bj] = *(const u32x2*)((const unsigned char*)(p + row * PLD) + gofs + col); od[(q) & 1][mm][bj] = u.aux ? *(const u32x4*)(mg + row * D + col) : (u32x4){0u, 0u, 0u, 0u}; } } while (0)
        EM_LOAD(0); EM_LOAD(1);
#pragma unroll
        for (int q = 0; q < 4; ++q) { const int ai = q >> 1;
#pragma unroll
            for (int mm = 0; mm < 2; ++mm)
#pragma unroll
                for (int bj = 0; bj < 2; ++bj) { const int m = 2 * (q & 1) + mm; const size_t row = (size_t)(row0 + ai * 128 + m * 16); const int col = col0 + bj * 128; const u32x2 g = gt[q & 1][mm][bj]; const u32x4 o = od[q & 1][mm][bj];
                    const f32x4 v0 = acc[ai][bj][m][0] * (1.0f / 255.0f), v1 = acc[ai][bj][m][1] * (1.0f / 255.0f);
                    u32x4 w; w.x = cvt_pk_bf16((float)(g.x & 0xffu) * v0[0] + blo(o.x), (float)((g.x >> 8) & 0xffu) * v0[1] + bhi(o.x)); w.y = cvt_pk_bf16((float)((g.x >> 16) & 0xffu) * v0[2] + blo(o.y), (float)(g.x >> 24) * v0[3] + bhi(o.y));
                    w.z = cvt_pk_bf16((float)(g.y & 0xffu) * v1[0] + blo(o.z), (float)((g.y >> 8) & 0xffu) * v1[1] + bhi(o.z)); w.w = cvt_pk_bf16((float)((g.y >> 16) & 0xffu) * v1[2] + blo(o.w), (float)(g.y >> 24) * v1[3] + bhi(o.w));
                    *(u32x4*)(mg + row * D + col) = w; }
            if (q == 0) EM_LOAD(2);
            if (q == 1) EM_LOAD(3); }
#undef EM_LOAD
    } };
template <bool STATS, bool W8 = false> struct EResT { static constexpr bool PERM = true; bf16* xb; float* ssq; LAS float* P; unsigned char* xb8;
    DEV void operator()(AccRef acc, const Unit& u, int wr, int wc, int fr, int fq) const {
        const int row0 = u.pm * 256 + wr * 64 + fr, col0 = u.pn * 256 + wc * 32 + 8 * fq;
        u32x4 xo[2][2][2];
#define ERES_LOAD(q) do { _Pragma("unroll") for (int mm = 0; mm < 2; ++mm) _Pragma("unroll") for (int bj = 0; bj < 2; ++bj) \
            xo[(q) & 1][mm][bj] = *(const u32x4*)(xb + (size_t)(row0 + ((q) >> 1) * 128 + (2 * ((q) & 1) + mm) * 16) * D + col0 + bj * 128); } while (0)
        ERES_LOAD(0); ERES_LOAD(1);
#pragma unroll
        for (int q = 0; q < 4; ++q) { const int ai = q >> 1;
#pragma unroll
            for (int mm = 0; mm < 2; ++mm) { const int m = 2 * (q & 1) + mm; bf16* rowp = xb + (size_t)(row0 + ai * 128 + m * 16) * D + col0; float sq = 0.f;
#pragma unroll
                for (int bj = 0; bj < 2; ++bj) { const u32x4 o = xo[q & 1][mm][bj]; const f32x4 a0 = acc[ai][bj][m][0], a1 = acc[ai][bj][m][1];
                    u32x4 w; w.x = cvt_pk_bf16(blo(o.x) + a0[0], bhi(o.x) + a0[1]); w.y = cvt_pk_bf16(blo(o.y) + a0[2], bhi(o.y) + a0[3]); w.z = cvt_pk_bf16(blo(o.z) + a1[0], bhi(o.z) + a1[1]); w.w = cvt_pk_bf16(blo(o.w) + a1[2], bhi(o.w) + a1[3]);
                    *(u32x4*)(rowp + bj * 128) = w;
                    if (W8) { u32x2 w8; w8.x = pk4_fp8(blo(w.x), bhi(w.x), blo(w.y), bhi(w.y)); w8.y = pk4_fp8(blo(w.z), bhi(w.z), blo(w.w), bhi(w.w)); *(u32x2*)(xb8 + (size_t)(row0 + ai * 128 + m * 16) * D + col0 + bj * 128) = w8; }
                    if (STATS) sq += (blo(w.x) * blo(w.x) + bhi(w.x) * bhi(w.x)) + (blo(w.y) * blo(w.y) + bhi(w.y) * bhi(w.y)) + (blo(w.z) * blo(w.z) + bhi(w.z) * bhi(w.z)) + (blo(w.w) * blo(w.w) + bhi(w.w) * bhi(w.w)); }
                if (STATS) { sq += __shfl_xor(sq, 16); sq += __shfl_xor(sq, 32);
                    if (fq == 0) P[(ai * 128 + wr * 64 + m * 16 + fr) * 4 + wc] = sq; } }
            if (q == 0) ERES_LOAD(2);
            if (q == 1) ERES_LOAD(3); }
#undef ERES_LOAD
        if (!STATS) return;
        asm volatile("s_waitcnt lgkmcnt(0)" ::: "memory"); __builtin_amdgcn_s_barrier(); asm volatile("" ::: "memory");
        const int t = wr * 256 + wc * 64 + fq * 16 + fr;
        if (t < 256) ssq[(size_t)u.pn * M + u.pm * 256 + t] = (P[t * 4] + P[t * 4 + 1]) + (P[t * 4 + 2] + P[t * 4 + 3]);
    } };
typedef EResT<true, false> ERes; typedef EResT<true, true> ERes8;
struct ESlab { static constexpr bool PERM = false; float* obx; float sc;
    DEV void operator()(AccRef acc, const Unit& u, int wr, int wc, int fr, int fq) const {
        const int row0 = u.pm * 256 + wr * 64 + fr, col0 = u.pn * 256 + wc * 32 + 4 * fq; float* base = obx + (size_t)u.aux * 2048 * D;
#pragma unroll
        for (int ai = 0; ai < 2; ++ai)
#pragma unroll
            for (int m = 0; m < 4; ++m) { const size_t off = (size_t)(row0 + ai * 128 + m * 16) * D + col0;
#pragma unroll
                for (int bj = 0; bj < 2; ++bj)
#pragma unroll
                    for (int n = 0; n < 2; ++n) *(f32x4*)(base + off + bj * 128 + n * 16) = acc[ai][bj][m][n] * sc; }
    } };
DEV f32x4 swiglu4(f32x4 G, f32x4 U, float k1, float c0) {
    f32x4 e = G * k1;
#pragma unroll
    for (int i = 0; i < 4; ++i) e[i] = __builtin_amdgcn_exp2f(e[i]);
    f32x4 d = e * c0 + c0;
#pragma unroll
    for (int i = 0; i < 4; ++i) d[i] = __builtin_amdgcn_rcpf(d[i]);
    return (G * U) * d;
}
struct ESwiglu8 { static constexpr bool PERM = true; unsigned char* act; int ld; float sc;
    DEV void operator()(AccRef acc, const Unit& u, int wr, int wc, int fr, int fq) const {
        const int row0 = u.pm * 256 + wr * 64 + fr, col0 = u.pn * 128 + wc * 32 + 8 * fq;
        const float k1 = -1.44269504f * sc, c0 = 1.0f / (sc * sc);
#pragma unroll
        for (int ai = 0; ai < 2; ++ai)
#pragma unroll
            for (int m = 0; m < 4; ++m) { const f32x4 o0 = swiglu4(acc[ai][0][m][0], acc[ai][1][m][0], k1, c0), o1 = swiglu4(acc[ai][0][m][1], acc[ai][1][m][1], k1, c0);
                u32x2 w; w.x = pk4_fp8(o0[0], o0[1], o0[2], o0[3]); w.y = pk4_fp8(o1[0], o1[1], o1[2], o1[3]);
                *(u32x2*)(act + (size_t)(row0 + ai * 128 + m * 16) * ld + col0) = w; }
    } };
struct ESwiglu { static constexpr bool PERM = true; bf16* act; int ld; const LAS float* R;
    DEV void operator()(AccRef acc, const Unit& u, int wr, int wc, int fr, int fq) const {
        const int row0 = u.pm * 256 + wr * 64 + fr, col0 = u.pn * 128 + wc * 32 + 8 * fq;
        float rsv[2][4];
#pragma unroll
        for (int ai = 0; ai < 2; ++ai)
#pragma unroll
            for (int m = 0; m < 4; ++m) rsv[ai][m] = R[u.aux * 256 + ai * 128 + wr * 64 + m * 16 + fr];
#pragma unroll
        for (int ai = 0; ai < 2; ++ai)
#pragma unroll
            for (int m = 0; m < 4; ++m) { const float rs = rsv[ai][m], k1 = -1.44269504f * rs, c0 = __builtin_amdgcn_rcpf(rs * rs);
                const f32x4 o0 = swiglu4(acc[ai][0][m][0], acc[ai][1][m][0], k1, c0), o1 = swiglu4(acc[ai][0][m][1], acc[ai][1][m][1], k1, c0);
                u32x4 w; w.x = cvt_pk_bf16(o0[0], o0[1]); w.y = cvt_pk_bf16(o0[2], o0[3]); w.z = cvt_pk_bf16(o1[0], o1[1]); w.w = cvt_pk_bf16(o1[2], o1[3]);
                *(u32x4*)(act + (size_t)(row0 + ai * 128 + m * 16) * ld + col0) = w; }
    } };

#define XB_TMO      128
#define XB_XCNT(j)  (256  + 64 * (j))
#define XB_XSUB(j)  (1280 + 64 * (j))
#define XB_XGEN(j)  (2304 + 64 * (j))
#define XB_TOP      3328
#define XB_TOPGEN   3392
#define XCD_BAR_WORDS 3456
#define XB_SPIN_CAP (1u << 18)
__device__ __forceinline__ unsigned xb_ld(unsigned* p)              { return __hip_atomic_load(p, __ATOMIC_RELAXED, __HIP_MEMORY_SCOPE_AGENT); }
__device__ __forceinline__ unsigned xb_add(unsigned* p, unsigned v) { return __hip_atomic_fetch_add(p, v, __ATOMIC_RELAXED, __HIP_MEMORY_SCOPE_AGENT); }
__device__ __forceinline__ unsigned xb_xcc_id() { return (unsigned)__builtin_amdgcn_s_getreg((3 << 11) | 20) & 0xFu; }
#define XB_SPIN(cond, bar) do { unsigned _sp = 0; while (cond) { __builtin_amdgcn_s_sleep(1); \
    if ((++_sp & 255u) == 0u) { if (xb_ld(&(bar)[XB_TMO])) break; if (_sp > XB_SPIN_CAP) { atomicAdd(&(bar)[XB_TMO], 1u); break; } } } } while (0)
struct XcdBarrier { unsigned* bar; unsigned x; volatile LAS unsigned* st; };
__device__ __forceinline__ XcdBarrier xcd_barrier_post(unsigned* bar, volatile LAS unsigned* st) {
    XcdBarrier b; b.bar = bar; b.x = xb_xcc_id(); b.st = st;
    if (threadIdx.x == 0) (void)xb_add(&bar[XB_XCNT(b.x)], 1u);
    return b;
}
__device__ __forceinline__ void xcd_barrier_complete(unsigned* bar, unsigned x, unsigned& nloc, unsigned& nx) {
    const unsigned G = gridDim.x * gridDim.y * gridDim.z;
    unsigned sum, cnt, mine, sp = 0u;
    for (;;) {
        sum = 0u; cnt = 0u; mine = 0u;
#pragma unroll
        for (unsigned j = 0; j < 16; ++j) { const unsigned c = xb_ld(&bar[XB_XCNT(j)]); sum += c; cnt += (c > 0u) ? 1u : 0u; mine = (j == x) ? c : mine; }
        if (sum == G) break;
        __builtin_amdgcn_s_sleep(1);
        if ((++sp & 255u) == 0u) { if (xb_ld(&bar[XB_TMO])) break; if (sp > XB_SPIN_CAP) { atomicAdd(&bar[XB_TMO], 1u); break; } }
    }
    nloc = mine > 0u ? mine : 1u; nx = cnt > 0u ? cnt : 1u;
}
__device__ __forceinline__ void xcd_arrive(const XcdBarrier& b, unsigned& tick, unsigned& tick2) {
    asm volatile("s_waitcnt vmcnt(0)" ::: "memory");
    __syncthreads();
    if (threadIdx.x == 0) {
        unsigned* bar = b.bar;
        __builtin_amdgcn_s_waitcnt(0);
        unsigned nloc = b.st[0], nx = b.st[1];
        if (nloc == 0u) { xcd_barrier_complete(bar, b.x, nloc, nx); b.st[0] = nloc; b.st[1] = nx; }
        const unsigned old = xb_add(&bar[XB_XSUB(b.x)], 1u);
        const unsigned gen = old / nloc;
        tick = old; tick2 = 0u;
        if (old + 1u == (gen + 1u) * nloc) {
            __builtin_amdgcn_fence(__ATOMIC_RELEASE, "agent");
            asm volatile("s_waitcnt vmcnt(0)" ::: "memory");
            const unsigned og = xb_add(&bar[XB_TOP], 1u);
            const unsigned tg = og / nx;
            if (og + 1u == (tg + 1u) * nx) xb_add(&bar[XB_TOPGEN], 1u);
            tick2 = og;
        }
        asm volatile("s_waitcnt vmcnt(0)\n\tbuffer_inv sc1" ::: "memory");
    }
}
__device__ __forceinline__ void xcd_wait(const XcdBarrier& b, unsigned tick, unsigned tick2) {
    if (threadIdx.x == 0) {
        unsigned* bar = b.bar;
        const unsigned nloc = b.st[0], nx = b.st[1];
        const unsigned old = tick, gen = old / nloc;
        if (old + 1u == (gen + 1u) * nloc) {
            const unsigned og = tick2, tg = og / nx;
            if (og + 1u != (tg + 1u) * nx) XB_SPIN(xb_ld(&bar[XB_TOPGEN]) == tg, bar);
            xb_add(&bar[XB_XGEN(b.x)], 1u);
            asm volatile("s_waitcnt vmcnt(0)" ::: "memory");
        } else {
            XB_SPIN(xb_ld(&bar[XB_XGEN(b.x)]) == gen, bar);
            asm volatile("s_waitcnt vmcnt(0)" ::: "memory");
        }
    }
    __syncthreads();
}
__device__ __forceinline__ void xcd_barrier(const XcdBarrier& b) { unsigned tick = 0u, tick2 = 0u; xcd_arrive(b, tick, tick2); xcd_wait(b, tick, tick2); }
struct Bar2 { XcdBarrier g; unsigned* lcnt; bool loc; };
__device__ __forceinline__ void b_arrive(const Bar2& b, bool local, unsigned& tick, unsigned& tick2) {
    if (!(local && b.loc)) { xcd_arrive(b.g, tick, tick2); return; }
    asm volatile("s_waitcnt vmcnt(0)" ::: "memory");
    __syncthreads();
    if (threadIdx.x == 0) { tick = xb_add(b.lcnt, 1u); asm volatile("s_waitcnt vmcnt(0)\n\tbuffer_inv sc1" ::: "memory"); }
}
__device__ __forceinline__ void b_wait(const Bar2& b, bool local, unsigned tick, unsigned tick2) {
    if (!(local && b.loc)) { xcd_wait(b.g, tick, tick2); return; }
    if (threadIdx.x == 0) { const unsigned target = (tick / 32u + 1u) * 32u; if (tick + 1u != target) XB_SPIN(xb_ld(b.lcnt) < target, b.g.bar);
        asm volatile("s_waitcnt vmcnt(0)" ::: "memory"); }
    __syncthreads();
}

constexpr size_t WS_WIN = 20 * MiB;
constexpr size_t WS_WA = 40 * MiB;
constexpr size_t WS_WBR = 41 * MiB;
constexpr size_t WS_WOUT = 45 * MiB;
constexpr size_t WS_WFGU = 49 * MiB;
constexpr size_t WS_WFD = 60 * MiB;
constexpr size_t WS_WMGU = 66 * MiB;
constexpr size_t WS_WMD = 178 * MiB;
constexpr size_t WS_XB8 = 122 * MiB;
constexpr size_t WS_WIN8 = 140 * MiB;
constexpr size_t WS_BAR = 4096;
constexpr size_t WS_XCC = 32768;
constexpr size_t WS_LBAR = 40960;
constexpr size_t WS_READY = 49152;
constexpr int RING_BYTES = 131072, MISC_OFF = RING_BYTES + 320, PSTAT_OFF = RING_BYTES + 1024  , RSTD_OFF = RING_BYTES + 6144  , LDS_BYTES = 147456;

template <bool GAIN>
DEV void cvt_item_t(const float* W, int ldw, int k0, int n0, bf16* dst, int Kd, LAS float* scr, int lane, const float* gain) {
    const int c = lane & 7;
    f32x4 g0 = {1.f, 1.f, 1.f, 1.f}, g1 = g0;
    if (GAIN) { g0 = *(const f32x4*)(gain + k0 + 8 * c); g1 = *(const f32x4*)(gain + k0 + 8 * c + 4); }
#pragma unroll
    for (int i = 0; i < 32; ++i) { const int kk = 2 * i + (lane >> 5); scr[kk * 33 + (lane & 31)] = W[(size_t)(k0 + kk) * ldw + n0 + (lane & 31)]; }
    asm volatile("s_waitcnt lgkmcnt(0)" ::: "memory");
#pragma unroll
    for (int j = 0; j < 4; ++j) { const int n = (lane >> 3) + 8 * j; const LAS float* s = scr + (8 * c) * 33 + n;
        u32x4 o; o.x = pk2(s[0 * 33] * g0[0], s[1 * 33] * g0[1]); o.y = pk2(s[2 * 33] * g0[2], s[3 * 33] * g0[3]); o.z = pk2(s[4 * 33] * g1[0], s[5 * 33] * g1[1]); o.w = pk2(s[6 * 33] * g1[2], s[7 * 33] * g1[3]);
        *(u32x4*)(dst + (size_t)n * Kd + 8 * c) = o; }
    asm volatile("s_waitcnt lgkmcnt(0)" ::: "memory");
}
DEV void cvt_item(const float* W, int ldw, int k0, int n0, bf16* dst, int Kd, LAS float* scr, int lane) { cvt_item_t<false>(W, ldw, k0, n0, dst, Kd, scr, lane, nullptr); }
DEV void cvt_item_g(const float* W, int ldw, int k0, int n0, bf16* dst, int Kd, LAS float* scr, int lane, const float* gain) { cvt_item_t<true>(W, ldw, k0, n0, dst, Kd, scr, lane, gain); }


DEV float4 ldx4(const bf16* row, int idx) { const uint2 t = ((const uint2*)row)[idx]; return make_float4(__uint_as_float(t.x << 16), __uint_as_float(t.x & 0xffff0000u), __uint_as_float(t.y << 16), __uint_as_float(t.y & 0xffff0000u)); }
DEV int otid() { int t = threadIdx.x; asm volatile("" : "+v"(t)); return t; }
typedef float f32x16 __attribute__((ext_vector_type(16)));
typedef __bf16 bf16x2_t __attribute__((ext_vector_type(2)));
DEV unsigned pkbf(float lo, float hi) { const f32x2 v = {lo, hi}; return __builtin_bit_cast(unsigned, __builtin_convertvector(v, bf16x2_t)); }
#define MFMA32(a, b, c) __builtin_amdgcn_mfma_f32_32x32x16_bf16((a), (b), (c), 0, 0, 0)
DEV int crow(int reg, int h) { return (reg & 3) + 8 * (reg >> 2) + 4 * h; }
constexpr int VT_LD = 68;
constexpr size_t WS_DL = 2 * MiB;
constexpr size_t WS_SSQ = 2 * MiB + 262144;
constexpr size_t WS_BG = WS_LOGA;
constexpr size_t WS_SP = 458 * MiB;
constexpr size_t WS_WRT = 40 * MiB + 262144;
constexpr size_t WS_WA2 = 40 * MiB + 131072;
#define PACK8(x, s) __builtin_bit_cast(bf16x8, (u32x4){pkbf((x)[8 * (s)], (x)[8 * (s) + 1]), pkbf((x)[8 * (s) + 2], (x)[8 * (s) + 3]), pkbf((x)[8 * (s) + 4], (x)[8 * (s) + 5]), pkbf((x)[8 * (s) + 6], (x)[8 * (s) + 7])})
DEV void stage_vt(const bf16* p, int m0, LAS bf16* vt, int tid) {
#pragma unroll
    for (int i = 0; i < 8; ++i) { const int idx = tid + 512 * i, t = idx & 63, c8 = idx >> 6;
        const u32x4 v = *(const u32x4*)(p + (size_t)(m0 + t) * PLD + P_V + c8 * 8);
        LAS bf16* dst = vt + (c8 * 8) * VT_LD + t;
        dst[0 * VT_LD] = (bf16)(v.x & 0xffffu); dst[1 * VT_LD] = (bf16)(v.x >> 16); dst[2 * VT_LD] = (bf16)(v.y & 0xffffu); dst[3 * VT_LD] = (bf16)(v.y >> 16);
        dst[4 * VT_LD] = (bf16)(v.z & 0xffffu); dst[5 * VT_LD] = (bf16)(v.z >> 16); dst[6 * VT_LD] = (bf16)(v.w & 0xffffu); dst[7 * VT_LD] = (bf16)(v.w >> 16); }
}
DEV bf16x8 vt_frag(const LAS bf16* vt, int vrow, int tbase, int hh) {
    const LAS bf16* s = vt + vrow * VT_LD + tbase + 4 * hh;
    const u32x2 lo = *(const LAS u32x2*)s, hi = *(const LAS u32x2*)(s + 8);
    return __builtin_bit_cast(bf16x8, (u32x4){lo.x, lo.y, hi.x, hi.y});
}
DEV void gla_pass1a(LAS unsigned char* lds, const bf16* hb, const bf16* WaT, int item, bool dowait, const Bar2& bw, unsigned tick, unsigned tick2) {
    int tid_ = threadIdx.x; asm volatile("" : "+v"(tid_));
    const int tid = tid_, lane = tid & 63, w = __builtin_amdgcn_readfirstlane(tid >> 6), m0 = item * 64;
    LAS float* alowf = (LAS float*)lds;
    bf16x8 af[16], wf[16];
    const int tb4 = w & 3, kh = w >> 2, row = m0 + 16 * tb4 + (lane & 15), kofs = 512 * kh + 8 * (lane >> 4);
#pragma unroll
    for (int ks = 0; ks < 16; ++ks) { af[ks] = *(const bf16x8*)(hb + (size_t)row * D + kofs + 32 * ks); wf[ks] = *(const bf16x8*)(WaT + (size_t)(lane & 15) * D + kofs + 32 * ks); }
    if (dowait) b_wait(bw, true, tick, tick2);
    f32x4 acc = {0.f, 0.f, 0.f, 0.f};
#pragma unroll
    for (int ks = 0; ks < 16; ++ks) acc = __builtin_amdgcn_mfma_f32_16x16x32_bf16(af[ks], wf[ks], acc, 0, 0, 0);
#pragma unroll
    for (int r = 0; r < 4; ++r) alowf[(kh * 64 + 16 * tb4 + 4 * (lane >> 4) + r) * 16 + (lane & 15)] = acc[r];
}
struct P1Loads { unsigned kraw[2][16]; u32x4 vraw[8]; bf16x8 wfrag; float ba; };
DEV void gla_pass1_loads(const bf16* p, const bf16* Wa2T, const float* b_a, int item, P1Loads& L) {
    int tid_ = threadIdx.x; asm volatile("" : "+v"(tid_));
    const int tid = tid_, lane = tid & 63, w = __builtin_amdgcn_readfirstlane(tid >> 6), l31 = lane & 31, hh = lane >> 5, m0 = item * 64, j = 32 * w + l31;
#pragma unroll
    for (int tb = 0; tb < 2; ++tb)
#pragma unroll
        for (int r = 0; r < 16; ++r) L.kraw[tb][r] = p[(size_t)(m0 + 32 * tb + crow(r, hh)) * PLD + P_K + j];
    L.wfrag = *(const bf16x8*)(Wa2T + j * 16 + 8 * hh);
    L.ba = b_a[j];
#pragma unroll
    for (int i = 0; i < 8; ++i) { const int idx = tid + 512 * i, t = idx & 63, c8 = idx >> 6; L.vraw[i] = *(const u32x4*)(p + (size_t)(m0 + t) * PLD + P_V + c8 * 8); }
}
DEV void gla_pass1(LAS unsigned char* lds, const float* ssq, const P1Loads& L, _Float16* BG, bf16* U, float* DL, int item) {
    int tid_ = threadIdx.x; asm volatile("" : "+v"(tid_));
    const int tid = tid_, lane = tid & 63, w = __builtin_amdgcn_readfirstlane(tid >> 6), l31 = lane & 31, hh = lane >> 5, m0 = item * 64, h = w >> 1, kb = w & 1;
    LAS float* alowf = (LAS float*)lds;
    LAS bf16* alowb = (LAS bf16*)(lds + 8192);
    LAS bf16* vt = (LAS bf16*)(lds + 16384);
    const int j = 32 * w + l31;
    const bf16x8 wfrag = L.wfrag; const float ba = L.ba;
#pragma unroll
    for (int i = 0; i < 8; ++i) { const int idx = tid + 512 * i, t = idx & 63, c8 = idx >> 6; const u32x4 v = L.vraw[i];
        LAS bf16* dst = vt + (c8 * 8) * VT_LD + t;
        dst[0 * VT_LD] = (bf16)(v.x & 0xffffu); dst[1 * VT_LD] = (bf16)(v.x >> 16); dst[2 * VT_LD] = (bf16)(v.y & 0xffffu); dst[3 * VT_LD] = (bf16)(v.y >> 16);
        dst[4 * VT_LD] = (bf16)(v.z & 0xffffu); dst[5 * VT_LD] = (bf16)(v.z >> 16); dst[6 * VT_LD] = (bf16)(v.w & 0xffffu); dst[7 * VT_LD] = (bf16)(v.w >> 16); }
    __syncthreads();
    for (int i = tid; i < 1024; i += 512) alowb[i] = (bf16)f2bf((alowf[i] + alowf[1024 + i]) * row_rstd(ssq, m0 + (i >> 4)));
    __syncthreads();
    f32x16 bc[2]; float carry = 0.f;
#pragma unroll
    for (int tb = 0; tb < 2; ++tb) {
        const bf16x8 afrag = *(const LAS bf16x8*)(alowb + (32 * tb + l31) * 16 + 8 * hh);
        f32x16 z;
#pragma unroll
        for (int r = 0; r < 16; ++r) z[r] = 0.f;
        z = MFMA32(afrag, wfrag, z);
        float gs[4], other[4];
#pragma unroll
        for (int g = 0; g < 4; ++g) {
#pragma unroll
            for (int e = 0; e < 4; ++e) { const float zz = z[4 * g + e] + ba; const float la = (fminf(zz, 0.f) - __logf(1.0f + __expf(-fabsf(zz)))) * (1.0f / 16.0f); z[4 * g + e] = la + (e ? z[4 * g + e - 1] : 0.f); }
            gs[g] = z[4 * g + 3]; other[g] = __shfl_xor(gs[g], 32);
        }
        float run = carry;
#pragma unroll
        for (int g = 0; g < 4; ++g) { const float h0 = hh ? other[g] : gs[g], h1 = hh ? gs[g] : other[g]; const float off = run + (hh ? h0 : 0.f);
#pragma unroll
            for (int e = 0; e < 4; ++e) bc[tb][4 * g + e] = z[4 * g + e] + off;
            run += h0 + h1; }
        carry = run;
    }
    const float blast = carry;
#pragma unroll
    for (int tb = 0; tb < 2; ++tb)
#pragma unroll
        for (int i = 0; i < 8; ++i) {
            const bool odd = lane & 1; const float mine0 = bc[tb][2 * i], mine1 = bc[tb][2 * i + 1];
            const float got = __shfl_xor(odd ? mine0 : mine1, 1);
            const _Float16 lo = (_Float16)(odd ? got : mine0), hi = (_Float16)(odd ? mine1 : got);
            const int r = 2 * i + (odd ? 1 : 0);
            const unsigned w = (unsigned)__builtin_bit_cast(unsigned short, lo) | ((unsigned)__builtin_bit_cast(unsigned short, hi) << 16);
            *(unsigned*)(BG + (size_t)(m0 + 32 * tb + crow(r, hh)) * KW + (j & ~1)) = w; }
    if (hh == 0) DL[(size_t)(item * 4 + h) * 64 + 32 * kb + l31] = __expf(blast);
    f32x16 kh2[2];
#pragma unroll
    for (int tb = 0; tb < 2; ++tb)
#pragma unroll
        for (int r = 0; r < 16; ++r) kh2[tb][r] = bf2f(L.kraw[tb][r]) * __expf(blast - bc[tb][r]);
#pragma unroll
    for (int vb = 0; vb < 4; ++vb) {
        f32x16 acc;
#pragma unroll
        for (int r = 0; r < 16; ++r) acc[r] = 0.f;
        const int vrow = 128 * h + 32 * vb + l31;
#pragma unroll
        for (int tb = 0; tb < 2; ++tb) { acc = MFMA32(vt_frag(vt, vrow, 32 * tb, hh), PACK8(kh2[tb], 0), acc); acc = MFMA32(vt_frag(vt, vrow, 32 * tb + 16, hh), PACK8(kh2[tb], 1), acc); }
#pragma unroll
        for (int i = 0; i < 8; ++i) {
            const bool odd = lane & 1; const float mine0 = acc[2 * i], mine1 = acc[2 * i + 1];
            const float got = __shfl_xor(odd ? mine0 : mine1, 1);
            const unsigned w = pkbf(odd ? got : mine0, odd ? mine1 : got);
            const int r = 2 * i + (odd ? 1 : 0);
            *(unsigned*)(U + ((size_t)(item * 4 + h) * 128 + 32 * vb + crow(r, hh)) * 64 + 32 * kb + (l31 & ~1)) = w; }
    }
}
DEV void conv_item(bf16* p, const float* cw, int item) {
    int tid_ = threadIdx.x; asm volatile("" : "+v"(tid_));
    const int tid = tid_, c0 = (tid & 63) * 8, tr = tid >> 6, m0 = item * 64 + 8 * tr, ts0 = m0 % SEQ;
    u32x4 uv[10], bv[8];
#pragma unroll
    for (int i = 0; i < 10; ++i) { const bool ok = i >= 2 || ts0 > 0; const size_t r = (size_t)(ok ? m0 - 2 + i : m0) * PLD;
        uv[i] = *(const u32x4*)(p + r + P_U + c0); if (!ok) { uv[i] = (u32x4){0u, 0u, 0u, 0u}; } }
#pragma unroll
    for (int i = 0; i < 8; ++i) bv[i] = *(const u32x4*)(p + (size_t)(m0 + i) * PLD + P_GB + c0);
    float w0[8], w1[8], w2[8];
#pragma unroll
    for (int e = 0; e < 8; ++e) { w0[e] = cw[0 * CC + c0 + e]; w1[e] = cw[1 * CC + c0 + e]; w2[e] = cw[2 * CC + c0 + e]; }
    float u[10][8];
#pragma unroll
    for (int i = 0; i < 10; ++i) { u[i][0] = blo(uv[i].x); u[i][1] = bhi(uv[i].x); u[i][2] = blo(uv[i].y); u[i][3] = bhi(uv[i].y); u[i][4] = blo(uv[i].z); u[i][5] = bhi(uv[i].z); u[i][6] = blo(uv[i].w); u[i][7] = bhi(uv[i].w); }
#pragma unroll
    for (int tt = 0; tt < 8; ++tt) {
        const float gbv[8] = {blo(bv[tt].x), bhi(bv[tt].x), blo(bv[tt].y), bhi(bv[tt].y), blo(bv[tt].z), bhi(bv[tt].z), blo(bv[tt].w), bhi(bv[tt].w)};
        float y[8];
#pragma unroll
        for (int e = 0; e < 8; ++e) y[e] = gbv[e] * (w0[e] * u[tt][e] + w1[e] * u[tt + 1][e] + w2[e] * u[tt + 2][e]);
        u32x4 o; o.x = pkbf(y[0], y[1]); o.y = pkbf(y[2], y[3]); o.z = pkbf(y[4], y[5]); o.w = pkbf(y[6], y[7]);
        *(u32x4*)(p + (size_t)(m0 + tt) * PLD + P_GB + c0) = o;
    }
}
DEV void gla_scan(const bf16* __restrict__ U, const float* __restrict__ DL, bf16* __restrict__ Sp, int bx, int G) {
    const bool g256 = G == 256; const int tid = otid();
    const int first = g256 ? (bx & 7) * 8192 + (bx >> 3) * 512 + tid : bx * 512 + tid, end = g256 ? (bx & 7) * 8192 + 8192 : BATCH * NH * 128 * 16, stride = g256 ? 16384 : G * 512;
    for (int idx = first; idx < end; idx += stride) {
        const int bh = idx >> 11, v = (idx >> 4) & 127, k4 = idx & 15, b = bh >> 2, h = bh & 3;
        f32x4 S = {0.f, 0.f, 0.f, 0.f};
#pragma unroll 32
        for (int n = 0; n < SEQ / 64; ++n) { const int item = b * (SEQ / 64) + n; const size_t base = ((size_t)(item * 4 + h) * 128 + v) * 64 + k4 * 4;
            const u32x2 uw = *(const u32x2*)(U + base); const f32x4 d = *(const f32x4*)(DL + (size_t)(item * 4 + h) * 64 + k4 * 4);
            u32x2 o; o.x = pkbf(S[0], S[1]); o.y = pkbf(S[2], S[3]); *(u32x2*)(Sp + base) = o;
            S = d * S + (f32x4){blo(uw.x), bhi(uw.x), blo(uw.y), bhi(uw.y)}; }
    }
}
DEV void gla_pass3(LAS unsigned char* lds, bf16* p, const _Float16* BG, const bf16* Sp, const float* gn, int item, bf16* ydst, int yld, bool dowait, const Bar2& bw, unsigned tick, unsigned tick2) {
    int tid_ = threadIdx.x; asm volatile("" : "+v"(tid_));
    const int tid = tid_, lane = tid & 63, w = __builtin_amdgcn_readfirstlane(tid >> 6), l31 = lane & 31, hh = lane >> 5, m0 = item * 64, h = w >> 1, vh = w & 1;
    LAS float* ssb = (LAS float*)lds;
    LAS bf16* vt = (LAS bf16*)(lds + 16384);
    u32x4 vraw[8], qraw[2][4], kraw[2][4]; f16x8 braw[2][4];
#pragma unroll
    for (int i = 0; i < 8; ++i) { const int idx = tid + 512 * i, t = idx & 63, c8 = idx >> 6; vraw[i] = *(const u32x4*)(p + (size_t)(m0 + t) * PLD + P_V + c8 * 8); }
#pragma unroll
    for (int blk = 0; blk < 2; ++blk)
#pragma unroll
        for (int ks = 0; ks < 4; ++ks) { const size_t row = (size_t)(m0 + 32 * blk + l31); const int kk = 64 * h + 16 * ks + 8 * hh;
            qraw[blk][ks] = *(const u32x4*)(p + row * PLD + P_Q + kk); kraw[blk][ks] = *(const u32x4*)(p + row * PLD + P_K + kk);
            braw[blk][ks] = *(const f16x8*)(BG + row * KW + kk); }
    if (dowait) b_wait(bw, true, tick, tick2);
#pragma unroll
    for (int i = 0; i < 8; ++i) { const int idx = tid + 512 * i, t = idx & 63, c8 = idx >> 6; const u32x4 v = vraw[i];
        LAS bf16* dst = vt + (c8 * 8) * VT_LD + t;
        dst[0 * VT_LD] = (bf16)(v.x & 0xffffu); dst[1 * VT_LD] = (bf16)(v.x >> 16); dst[2 * VT_LD] = (bf16)(v.y & 0xffffu); dst[3 * VT_LD] = (bf16)(v.y >> 16);
        dst[4 * VT_LD] = (bf16)(v.z & 0xffffu); dst[5 * VT_LD] = (bf16)(v.z >> 16); dst[6 * VT_LD] = (bf16)(v.w & 0xffffu); dst[7 * VT_LD] = (bf16)(v.w >> 16); }
    bf16x8 qf[2][4], kf[2][4];
#pragma unroll
    for (int blk = 0; blk < 2; ++blk)
#pragma unroll
        for (int ks = 0; ks < 4; ++ks) { const size_t row = (size_t)(m0 + 32 * blk + l31);
            const u32x4 qv = qraw[blk][ks], kv = kraw[blk][ks];
            const f16x8 bh = braw[blk][ks]; const f32x4 b0 = {(float)bh[0], (float)bh[1], (float)bh[2], (float)bh[3]}, b1 = {(float)bh[4], (float)bh[5], (float)bh[6], (float)bh[7]};
            float ep[8], em[8];
#pragma unroll
            for (int e = 0; e < 4; ++e) { ep[e] = 0.125f * __expf(b0[e]); ep[4 + e] = 0.125f * __expf(b1[e]); em[e] = __expf(-b0[e]); em[4 + e] = __expf(-b1[e]); }
            qf[blk][ks] = __builtin_bit_cast(bf16x8, (u32x4){pkbf(blo(qv.x) * ep[0], bhi(qv.x) * ep[1]), pkbf(blo(qv.y) * ep[2], bhi(qv.y) * ep[3]), pkbf(blo(qv.z) * ep[4], bhi(qv.z) * ep[5]), pkbf(blo(qv.w) * ep[6], bhi(qv.w) * ep[7])});
            kf[blk][ks] = __builtin_bit_cast(bf16x8, (u32x4){pkbf(blo(kv.x) * em[0], bhi(kv.x) * em[1]), pkbf(blo(kv.y) * em[2], bhi(kv.y) * em[3]), pkbf(blo(kv.z) * em[4], bhi(kv.z) * em[5]), pkbf(blo(kv.w) * em[6], bhi(kv.w) * em[7])}); }
    bf16x8 spf[2][4];
#pragma unroll
    for (int vb = 0; vb < 2; ++vb)
#pragma unroll
        for (int ks = 0; ks < 4; ++ks) spf[vb][ks] = *(const bf16x8*)(Sp + ((size_t)(item * 4 + h) * 128 + 64 * vh + 32 * vb + l31) * 64 + 16 * ks + 8 * hh);
    f32x16 X00, X01, X11;
#pragma unroll
    for (int r = 0; r < 16; ++r) { X00[r] = 0.f; X01[r] = 0.f; X11[r] = 0.f; }
#pragma unroll
    for (int ks = 0; ks < 4; ++ks) { X00 = MFMA32(kf[0][ks], qf[0][ks], X00); X01 = MFMA32(kf[0][ks], qf[1][ks], X01); X11 = MFMA32(kf[1][ks], qf[1][ks], X11); }
#pragma unroll
    for (int r = 0; r < 16; ++r) if (crow(r, hh) > l31) { X00[r] = 0.f; X11[r] = 0.f; }
    f32x4 gnv[2][4];
#pragma unroll
    for (int vb = 0; vb < 2; ++vb)
#pragma unroll
        for (int g = 0; g < 4; ++g) gnv[vb][g] = *(const f32x4*)(gn + 64 * vh + 32 * vb + 8 * g + 4 * hh);
    u32x2 gvv[2][2][4];
#pragma unroll
    for (int vb = 0; vb < 2; ++vb)
#pragma unroll
        for (int ib = 0; ib < 2; ++ib)
#pragma unroll
            for (int g = 0; g < 4; ++g) gvv[vb][ib][g] = *(const u32x2*)(p + (size_t)(m0 + 32 * ib + l31) * PLD + P_GO + 128 * h + 64 * vh + 32 * vb + 8 * g + 4 * hh);
    __syncthreads();
    f32x16 O[2][2];
#pragma unroll
    for (int vb = 0; vb < 2; ++vb) {
        f32x16 O0, O1;
#pragma unroll
        for (int r = 0; r < 16; ++r) { O0[r] = 0.f; O1[r] = 0.f; }
        const int vloc = 64 * vh + 32 * vb + l31, vrow = 128 * h + vloc;
#pragma unroll
        for (int ks = 0; ks < 4; ++ks) { const bf16x8 sf = spf[vb][ks]; O0 = MFMA32(sf, qf[0][ks], O0); O1 = MFMA32(sf, qf[1][ks], O1); }
        { const bf16x8 a0 = vt_frag(vt, vrow, 0, hh), a1 = vt_frag(vt, vrow, 16, hh), a2 = vt_frag(vt, vrow, 32, hh), a3 = vt_frag(vt, vrow, 48, hh);
          O0 = MFMA32(a0, PACK8(X00, 0), O0); O0 = MFMA32(a1, PACK8(X00, 1), O0);
          O1 = MFMA32(a0, PACK8(X01, 0), O1); O1 = MFMA32(a1, PACK8(X01, 1), O1);
          O1 = MFMA32(a2, PACK8(X11, 0), O1); O1 = MFMA32(a3, PACK8(X11, 1), O1); }
        O[vb][0] = O0; O[vb][1] = O1;
    }
    float ss0 = 0.f, ss1 = 0.f;
#pragma unroll
    for (int vb = 0; vb < 2; ++vb)
#pragma unroll
        for (int r = 0; r < 16; ++r) { ss0 += O[vb][0][r] * O[vb][0][r]; ss1 += O[vb][1][r] * O[vb][1][r]; }
    ss0 += __shfl_xor(ss0, 32); ss1 += __shfl_xor(ss1, 32);
    if (hh == 0) { ssb[w * 64 + l31] = ss0; ssb[w * 64 + 32 + l31] = ss1; }
    __syncthreads();
    float rstd[2];
#pragma unroll
    for (int ib = 0; ib < 2; ++ib) rstd[ib] = rsqrtf((ssb[(2 * h) * 64 + 32 * ib + l31] + ssb[(2 * h + 1) * 64 + 32 * ib + l31]) * (1.0f / 128.0f) + EPS);
#pragma unroll
    for (int vb = 0; vb < 2; ++vb)
#pragma unroll
        for (int ib = 0; ib < 2; ++ib)
#pragma unroll
            for (int g = 0; g < 4; ++g) { const int v0 = 64 * vh + 32 * vb + 8 * g + 4 * hh; bf16* dst = ydst + (size_t)(m0 + 32 * ib + l31) * yld + 128 * h + v0;
                const u32x2 gv = gvv[vb][ib][g]; const f32x4 gg = gnv[vb][g];
                const float g0 = blo(gv.x), g1 = bhi(gv.x), g2 = blo(gv.y), g3 = bhi(gv.y);
                u32x2 o; o.x = pkbf(O[vb][ib][4 * g] * rstd[ib] * gg[0] * g0 * fsig(g0), O[vb][ib][4 * g + 1] * rstd[ib] * gg[1] * g1 * fsig(g1));
                o.y = pkbf(O[vb][ib][4 * g + 2] * rstd[ib] * gg[2] * g2 * fsig(g2), O[vb][ib][4 * g + 3] * rstd[ib] * gg[3] * g3 * fsig(g3));
                *(u32x2*)dst = o; }
}

DEV void xb_rows(const float* x, bf16* xb, unsigned char* xb8, float* ssq, int gw, int ngw, int sel = 0, int mbase = 0) {
    const int lane = otid() & 63;
    const int nrows = sel == 0 ? M : sel == 3 ? SEQ : M / 2;
    for (int r0 = gw; r0 < nrows; r0 += 4 * ngw) {
        int m[4]; f32x4 v[4][4];
#pragma unroll
        for (int q = 0; q < 4; ++q) { const int r = r0 + q * ngw < nrows ? r0 + q * ngw : r0;
            m[q] = sel == 0 ? r : sel == 3 ? mbase + r : ((r >> 11) << 12) + (r & (SEQ - 1)) + (sel == 2 ? SEQ : 0);
#pragma unroll
            for (int j = 0; j < 4; ++j) v[q][j] = __builtin_nontemporal_load((const f32x4*)(x + (size_t)m[q] * D) + lane + 64 * j); }
#pragma unroll
        for (int q = 0; q < 4; ++q) { float ss = 0.f;
#pragma unroll
            for (int j = 0; j < 4; ++j) { const f32x4 t = v[q][j]; ss += t[0] * t[0] + t[1] * t[1] + t[2] * t[2] + t[3] * t[3];
                uint2 w; w.x = pk2(t[0], t[1]); w.y = pk2(t[2], t[3]); ((uint2*)(xb + (size_t)m[q] * D))[lane + 64 * j] = w;
                ((unsigned*)(xb8 + (size_t)m[q] * D))[lane + 64 * j] = pk4_fp8(t[0], t[1], t[2], t[3]); }
            ss = wave_sum(ss);
            if (lane < 4) ssq[(size_t)lane * M + m[q]] = lane == 0 ? ss : 0.f; }
    }
}
DEV void rms_rows(const float* x, const float* g, bf16* hb, int gw, int ngw) {
    const int lane = otid() & 63;
    for (int m = gw; m < M; m += ngw) {
        const float4* xr = (const float4*)(x + (size_t)m * D); const float4* gr = (const float4*)g;
        float4 v[4]; float ss = 0.f;
#pragma unroll
        for (int j = 0; j < 4; ++j) { v[j] = xr[lane + 64 * j]; ss += v[j].x * v[j].x + v[j].y * v[j].y + v[j].z * v[j].z + v[j].w * v[j].w; }
        const float rstd = rsqrtf(wave_sum(ss) * (1.0f / D) + EPS);
        uint2* o = (uint2*)(hb + (size_t)m * D);
#pragma unroll
        for (int j = 0; j < 4; ++j) { const float4 gg = gr[lane + 64 * j]; uint2 w; w.x = pk2(v[j].x * rstd * gg.x, v[j].y * rstd * gg.y); w.y = pk2(v[j].z * rstd * gg.z, v[j].w * rstd * gg.w); o[lane + 64 * j] = w; }
    }
}
DEV void route1_grp(LAS float* PL, const bf16* x, const bf16* WrT, float* rstd_o, int* tok_e, float* tok_w, int* counts, int grp) {
    const int tid = otid(), lane = tid & 63, wave = tid >> 6;
    LAS float* SS = PL + 2048; LAS int* lcnt = (LAS int*)(PL + 2048 + 128);
    if (tid < 8) lcnt[tid] = 0;
    {   const int tb4 = wave & 3, kh = wave >> 2, row = grp * 64 + 16 * tb4 + (lane & 15), kofs = 512 * kh + 8 * (lane >> 4);
        bf16x8 af[16], wf[16];
#pragma unroll
        for (int ks = 0; ks < 16; ++ks) { af[ks] = *(const bf16x8*)(x + (size_t)row * D + kofs + 32 * ks); wf[ks] = *(const bf16x8*)(WrT + (size_t)(lane & 15) * D + kofs + 32 * ks); }
        f32x4 acc = {0.f, 0.f, 0.f, 0.f}; float ss = 0.f;
#pragma unroll
        for (int ks = 0; ks < 16; ++ks) { acc = __builtin_amdgcn_mfma_f32_16x16x32_bf16(af[ks], wf[ks], acc, 0, 0, 0);
            const u32x4 r = __builtin_bit_cast(u32x4, af[ks]); ss += (blo(r.x) * blo(r.x) + bhi(r.x) * bhi(r.x)) + (blo(r.y) * blo(r.y) + bhi(r.y) * bhi(r.y)) + (blo(r.z) * blo(r.z) + bhi(r.z) * bhi(r.z)) + (blo(r.w) * blo(r.w) + bhi(r.w) * bhi(r.w)); }
        ss += __shfl_xor(ss, 16); ss += __shfl_xor(ss, 32);
#pragma unroll
        for (int r = 0; r < 4; ++r) PL[(kh * 64 + 16 * tb4 + 4 * (lane >> 4) + r) * 16 + (lane & 15)] = acc[r];
        if (lane < 16) SS[kh * 64 + 16 * tb4 + lane] = ss;
    }
    __syncthreads();
    if (tid < 64) {
        const int m = grp * 64 + tid; const float rstd = rsqrtf((SS[tid] + SS[64 + tid]) * (1.0f / D) + EPS);
        float lg[8];
#pragma unroll
        for (int e = 0; e < 8; ++e) lg[e] = ((PL[tid * 16 + e] + PL[(64 + tid) * 16 + e]) + (PL[tid * 16 + 8 + e] + PL[(64 + tid) * 16 + 8 + e])) * rstd;
        int i1 = 0; float l1 = lg[0];
#pragma unroll
        for (int e = 1; e < 8; ++e) if (lg[e] > l1) { l1 = lg[e]; i1 = e; }
        int i2 = -1; float l2 = -3.0e38f;
#pragma unroll
        for (int e = 0; e < 8; ++e) if (e != i1 && lg[e] > l2) { l2 = lg[e]; i2 = e; }
        const float ex = expf(l2 - l1), w1v = 1.0f / (1.0f + ex), w2v = ex / (1.0f + ex);
        rstd_o[m] = rstd; tok_e[m * 2] = i1; tok_e[m * 2 + 1] = i2; tok_w[m * 2] = w1v; tok_w[m * 2 + 1] = w2v;
        __hip_atomic_fetch_add(&lcnt[i1], 1, __ATOMIC_RELAXED, __HIP_MEMORY_SCOPE_WORKGROUP); __hip_atomic_fetch_add(&lcnt[i2], 1, __ATOMIC_RELAXED, __HIP_MEMORY_SCOPE_WORKGROUP);
    }
    __syncthreads();
    if (tid < 8) counts[grp * 8 + tid] = lcnt[tid];
    __syncthreads();
}
DEV void route2_grp(LAS int* L, const bf16* x, const float* g2, const float* rstd_i, const int* counts, const int* tok_e, int* slot, unsigned char* hbp, int* tilet, int grp, int wgi, int nwg, bool first, bool dowait, const Bar2& bw, unsigned tick, unsigned tick2) {
    LAS int* ltot = L; LAS int* lpre = L + 8; LAS int* lseg = L + 16; LAS int* lslot = L + 32; LAS int* lte = L + 160;
    const int tid = otid(), lane = tid & 63, wave = tid >> 6;
    const float4* gr = (const float4*)g2; float4 gq[4];
#pragma unroll
    for (int j = 0; j < 4; ++j) gq[j] = gr[lane + 64 * j];
    uint2 xraw[8][4];
#pragma unroll
    for (int q = 0; q < 8; ++q) { const int m = grp * 64 + wave + 8 * q;
#pragma unroll
        for (int j = 0; j < 4; ++j) xraw[q][j] = ((const uint2*)(x + (size_t)m * D))[lane + 64 * j]; }
    if (dowait) b_wait(bw, false, tick, tick2);
    if (tid < 128) lte[tid] = tok_e[(grp * 64) * 2 + tid];
    { int tot = 0, pre = 0;
#pragma unroll
        for (int q = 0; q < 4; ++q) { const int w = lane + 64 * q; const int c = counts[w * 8 + wave]; tot += c; pre += (w < grp) ? c : 0; }
#pragma unroll
        for (int o = 1; o < 64; o <<= 1) { tot += __shfl_xor(tot, o); pre += __shfl_xor(pre, o); }
        if (lane == 0) { ltot[wave] = tot; lpre[wave] = pre; } }
    __syncthreads();
    if (tid == 0) { int off = 0; for (int e = 0; e < 8; ++e) { lseg[e] = off; off += ((ltot[e] + 255) / 256) * 256; } lseg[8] = off; }
    __syncthreads();
    { const int base = lseg[wave] + lpre[wave]; const bool m0 = lte[2 * lane] == wave, m1 = lte[2 * lane + 1] == wave;
        const unsigned long long b0 = __ballot(m0), b1 = __ballot(m1), lt = (1ull << lane) - 1ull;
        const int r0 = __popcll(b0 & lt) + __popcll(b1 & lt);
        if (m0) lslot[2 * lane] = base + r0;
        if (m1) lslot[2 * lane + 1] = base + r0 + (m0 ? 1 : 0); }
    __syncthreads();
    if (tid < 128) slot[(grp * 64) * 2 + tid] = lslot[tid];
    {   float rs[8];
#pragma unroll
        for (int q = 0; q < 8; ++q) rs[q] = rstd_i[grp * 64 + wave + 8 * q];
#pragma unroll
        for (int q = 0; q < 8; ++q) { const int i = wave + 8 * q; const float rstd = rs[q];
            unsigned* o1 = (unsigned*)(hbp + (size_t)lslot[2 * i] * D); unsigned* o2 = (unsigned*)(hbp + (size_t)lslot[2 * i + 1] * D);
#pragma unroll
            for (int j = 0; j < 4; ++j) { const uint2 t = xraw[q][j]; const float4 gg = gq[j]; const unsigned w = pk4_fp8(blo(t.x) * rstd * gg.x, bhi(t.x) * rstd * gg.y, blo(t.y) * rstd * gg.z, bhi(t.y) * rstd * gg.w); o1[lane + 64 * j] = w; o2[lane + 64 * j] = w; } }
    }
    if (grp == 0) {
        if (tid < NTILE_MAX) { const int r = tid * 256; int e = -1; for (int q = 0; q < 8; ++q) if (r >= lseg[q] && r < lseg[q + 1]) e = q; tilet[tid] = e; }
        if (tid == 0) tilet[NTILE_MAX] = lseg[8] / 256;
    }
    if (first) {
        for (int e = 0; e < 8; ++e) { const int r0 = lseg[e] + ltot[e], r1 = lseg[e + 1];
            for (int r = r0 + wgi; r < r1; r += nwg) if (tid < 256) ((unsigned*)(hbp + (size_t)r * D))[tid] = 0u; }
    }
    __syncthreads();
}
DEV float4 ld8x4(const unsigned char* row, int idx) { const int w = ((const int*)row)[idx]; const float k = 1.0f / OB_SCALE; return make_float4(__builtin_amdgcn_cvt_f32_fp8(w, 0) * k, __builtin_amdgcn_cvt_f32_fp8(w, 1) * k, __builtin_amdgcn_cvt_f32_fp8(w, 2) * k, __builtin_amdgcn_cvt_f32_fp8(w, 3) * k); }
DEV void combine_rows(const bf16* x, const unsigned char* obuf, const float* obx, const int* slot, const float* tok_w, const float* gf, float* out, int gw, int ngw, bool dowait, const XcdBarrier& bw, unsigned tick, unsigned tick2) {
    const int lane = otid() & 63;
    const float4* gr = (const float4*)gf; float4 gq[4];
#pragma unroll
    for (int j = 0; j < 4; ++j) gq[j] = gr[lane + 64 * j];
    const int f0 = gw, f1 = gw + ngw < M ? gw + ngw : gw;
    const int2 sl0a = *(const int2*)(slot + f0 * 2), sl0b = *(const int2*)(slot + f1 * 2); const float2 tw0a = *(const float2*)(tok_w + f0 * 2), tw0b = *(const float2*)(tok_w + f1 * 2);
    uint2 xa0[2][4];
#pragma unroll
    for (int j = 0; j < 4; ++j) { xa0[0][j] = ((const uint2*)(x + (size_t)f0 * D))[lane + 64 * j]; xa0[1][j] = ((const uint2*)(x + (size_t)f1 * D))[lane + 64 * j]; }
    if (M == 8 * ngw) {
        int2 sl[4][2]; float2 tw[4][2];
#pragma unroll
        for (int t = 0; t < 4; ++t)
#pragma unroll
            for (int q = 0; q < 2; ++q) { const int m = gw + (2 * t + q) * ngw; sl[t][q] = *(const int2*)(slot + m * 2); tw[t][q] = *(const float2*)(tok_w + m * 2); }
        uint2 xa[2][2][4]; int oa[2][2][4], oc[2][2][4];
#pragma unroll
        for (int q = 0; q < 2; ++q)
#pragma unroll
            for (int j = 0; j < 4; ++j) xa[0][q][j] = xa0[q][j];
        if (dowait) xcd_wait(bw, tick, tick2);
#pragma unroll
        for (int q = 0; q < 2; ++q)
#pragma unroll
            for (int j = 0; j < 4; ++j) { oa[0][q][j] = ((const int*)(obuf + (size_t)sl[0][q].x * D))[lane + 64 * j]; oc[0][q][j] = ((const int*)(obuf + (size_t)sl[0][q].y * D))[lane + 64 * j]; }
#pragma unroll
        for (int t = 0; t < 4; ++t) { const int cb = t & 1, nb = cb ^ 1;
            if (t < 3) {
#pragma unroll
                for (int q = 0; q < 2; ++q) { const int m = gw + (2 * (t + 1) + q) * ngw;
#pragma unroll
                    for (int j = 0; j < 4; ++j) { xa[nb][q][j] = ((const uint2*)(x + (size_t)m * D))[lane + 64 * j]; oa[nb][q][j] = ((const int*)(obuf + (size_t)sl[t + 1][q].x * D))[lane + 64 * j]; oc[nb][q][j] = ((const int*)(obuf + (size_t)sl[t + 1][q].y * D))[lane + 64 * j]; } }
            }
            const int mm[2] = {gw + 2 * t * ngw, gw + (2 * t + 1) * ngw};
            const int s1[2] = {sl[t][0].x, sl[t][1].x}, s2[2] = {sl[t][0].y, sl[t][1].y}; const float w1[2] = {tw[t][0].x, tw[t][1].x}, w2[2] = {tw[t][0].y, tw[t][1].y};
            float4 v[2][4], ea[2][4], ec[2][4];
            if (s1[0] < 128 * 256 && s2[0] < 128 * 256 && s1[1] < 128 * 256 && s2[1] < 128 * 256) {
                const float k8 = 1.0f / OB_SCALE;
#pragma unroll
                for (int q = 0; q < 2; ++q)
#pragma unroll
                    for (int j = 0; j < 4; ++j) { const uint2 xv = xa[cb][q][j]; const int a = oa[cb][q][j], c = oc[cb][q][j]; v[q][j] = make_float4(blo(xv.x), bhi(xv.x), blo(xv.y), bhi(xv.y));
                        ea[q][j] = make_float4(__builtin_amdgcn_cvt_f32_fp8(a, 0) * k8, __builtin_amdgcn_cvt_f32_fp8(a, 1) * k8, __builtin_amdgcn_cvt_f32_fp8(a, 2) * k8, __builtin_amdgcn_cvt_f32_fp8(a, 3) * k8);
                        ec[q][j] = make_float4(__builtin_amdgcn_cvt_f32_fp8(c, 0) * k8, __builtin_amdgcn_cvt_f32_fp8(c, 1) * k8, __builtin_amdgcn_cvt_f32_fp8(c, 2) * k8, __builtin_amdgcn_cvt_f32_fp8(c, 3) * k8); }
            } else
#pragma unroll
            for (int q = 0; q < 2; ++q) {
                const bf16* xr = x + (size_t)mm[q] * D; const unsigned char* o1 = obuf + (size_t)s1[q] * D; const unsigned char* o2 = obuf + (size_t)s2[q] * D;
#pragma unroll
                for (int j = 0; j < 4; ++j) { v[q][j] = ldx4(xr, lane + 64 * j);
                    if (s1[q] < 128 * 256) ea[q][j] = ld8x4(o1, lane + 64 * j);
                    else { float4 e = make_float4(0.f, 0.f, 0.f, 0.f); for (int ks = 0; ks < KSPLIT; ++ks) { const float4 tt = ((const float4*)(obx + ((size_t)ks * 2048 + (s1[q] - 128 * 256)) * D))[lane + 64 * j]; e.x += tt.x; e.y += tt.y; e.z += tt.z; e.w += tt.w; } ea[q][j] = e; }
                    if (s2[q] < 128 * 256) ec[q][j] = ld8x4(o2, lane + 64 * j);
                    else { float4 e = make_float4(0.f, 0.f, 0.f, 0.f); for (int ks = 0; ks < KSPLIT; ++ks) { const float4 tt = ((const float4*)(obx + ((size_t)ks * 2048 + (s2[q] - 128 * 256)) * D))[lane + 64 * j]; e.x += tt.x; e.y += tt.y; e.z += tt.z; e.w += tt.w; } ec[q][j] = e; } }
            }
#pragma unroll
            for (int q = 0; q < 2; ++q) { float ss = 0.f;
#pragma unroll
                for (int j = 0; j < 4; ++j) { v[q][j].x += w1[q] * ea[q][j].x + w2[q] * ec[q][j].x; v[q][j].y += w1[q] * ea[q][j].y + w2[q] * ec[q][j].y; v[q][j].z += w1[q] * ea[q][j].z + w2[q] * ec[q][j].z; v[q][j].w += w1[q] * ea[q][j].w + w2[q] * ec[q][j].w;
                    ss += v[q][j].x * v[q][j].x + v[q][j].y * v[q][j].y + v[q][j].z * v[q][j].z + v[q][j].w * v[q][j].w; }
                const float rstd = rsqrtf(wave_sum(ss) * (1.0f / D) + EPS);
                float4* orow = (float4*)(out + (size_t)mm[q] * D);
#pragma unroll
                for (int j = 0; j < 4; ++j) orow[lane + 64 * j] = make_float4(v[q][j].x * rstd * gq[j].x, v[q][j].y * rstd * gq[j].y, v[q][j].z * rstd * gq[j].z, v[q][j].w * rstd * gq[j].w); }
        }
        return;
    }
    if (dowait) xcd_wait(bw, tick, tick2);
    for (int m0 = gw; m0 < M; m0 += 2 * ngw) {
        const int mm[2] = {m0, m0 + ngw < M ? m0 + ngw : m0};
        const bool firsttrip = m0 == gw;
        int s1[2], s2[2]; float w1[2], w2[2];
        if (firsttrip) { s1[0] = sl0a.x; s2[0] = sl0a.y; w1[0] = tw0a.x; w2[0] = tw0a.y; s1[1] = sl0b.x; s2[1] = sl0b.y; w1[1] = tw0b.x; w2[1] = tw0b.y; }
        else {
#pragma unroll
        for (int q = 0; q < 2; ++q) { const int2 sl = *(const int2*)(slot + mm[q] * 2); const float2 tw = *(const float2*)(tok_w + mm[q] * 2); s1[q] = sl.x; s2[q] = sl.y; w1[q] = tw.x; w2[q] = tw.y; }
        }
        float4 v[2][4], ea[2][4], ec[2][4];
        if (s1[0] < 128 * 256 && s2[0] < 128 * 256 && s1[1] < 128 * 256 && s2[1] < 128 * 256) {
            uint2 xa[2][4]; int oa[2][4], oc[2][4];
#pragma unroll
            for (int q = 0; q < 2; ++q)
#pragma unroll
                for (int j = 0; j < 4; ++j) { if (firsttrip) xa[q][j] = xa0[q][j]; else xa[q][j] = ((const uint2*)(x + (size_t)mm[q] * D))[lane + 64 * j]; oa[q][j] = ((const int*)(obuf + (size_t)s1[q] * D))[lane + 64 * j]; oc[q][j] = ((const int*)(obuf + (size_t)s2[q] * D))[lane + 64 * j]; }
            const float k8 = 1.0f / OB_SCALE;
#pragma unroll
            for (int q = 0; q < 2; ++q)
#pragma unroll
                for (int j = 0; j < 4; ++j) { v[q][j] = make_float4(blo(xa[q][j].x), bhi(xa[q][j].x), blo(xa[q][j].y), bhi(xa[q][j].y));
                    ea[q][j] = make_float4(__builtin_amdgcn_cvt_f32_fp8(oa[q][j], 0) * k8, __builtin_amdgcn_cvt_f32_fp8(oa[q][j], 1) * k8, __builtin_amdgcn_cvt_f32_fp8(oa[q][j], 2) * k8, __builtin_amdgcn_cvt_f32_fp8(oa[q][j], 3) * k8);
                    ec[q][j] = make_float4(__builtin_amdgcn_cvt_f32_fp8(oc[q][j], 0) * k8, __builtin_amdgcn_cvt_f32_fp8(oc[q][j], 1) * k8, __builtin_amdgcn_cvt_f32_fp8(oc[q][j], 2) * k8, __builtin_amdgcn_cvt_f32_fp8(oc[q][j], 3) * k8); }
        } else
#pragma unroll
        for (int q = 0; q < 2; ++q) {
            const bf16* xr = x + (size_t)mm[q] * D; const unsigned char* o1 = obuf + (size_t)s1[q] * D; const unsigned char* o2 = obuf + (size_t)s2[q] * D;
#pragma unroll
            for (int j = 0; j < 4; ++j) { v[q][j] = ldx4(xr, lane + 64 * j);
                if (s1[q] < 128 * 256) ea[q][j] = ld8x4(o1, lane + 64 * j);
                else { float4 e = make_float4(0.f, 0.f, 0.f, 0.f); for (int ks = 0; ks < KSPLIT; ++ks) { const float4 t = ((const float4*)(obx + ((size_t)ks * 2048 + (s1[q] - 128 * 256)) * D))[lane + 64 * j]; e.x += t.x; e.y += t.y; e.z += t.z; e.w += t.w; } ea[q][j] = e; }
                if (s2[q] < 128 * 256) ec[q][j] = ld8x4(o2, lane + 64 * j);
                else { float4 e = make_float4(0.f, 0.f, 0.f, 0.f); for (int ks = 0; ks < KSPLIT; ++ks) { const float4 t = ((const float4*)(obx + ((size_t)ks * 2048 + (s2[q] - 128 * 256)) * D))[lane + 64 * j]; e.x += t.x; e.y += t.y; e.z += t.z; e.w += t.w; } ec[q][j] = e; } }
        }
#pragma unroll
        for (int q = 0; q < 2; ++q) { float ss = 0.f;
#pragma unroll
            for (int j = 0; j < 4; ++j) { v[q][j].x += w1[q] * ea[q][j].x + w2[q] * ec[q][j].x; v[q][j].y += w1[q] * ea[q][j].y + w2[q] * ec[q][j].y; v[q][j].z += w1[q] * ea[q][j].z + w2[q] * ec[q][j].z; v[q][j].w += w1[q] * ea[q][j].w + w2[q] * ec[q][j].w;
                ss += v[q][j].x * v[q][j].x + v[q][j].y * v[q][j].y + v[q][j].z * v[q][j].z + v[q][j].w * v[q][j].w; }
            const float rstd = rsqrtf(wave_sum(ss) * (1.0f / D) + EPS);
            float4* orow = (float4*)(out + (size_t)mm[q] * D);
#pragma unroll
            for (int j = 0; j < 4; ++j) orow[lane + 64 * j] = make_float4(v[q][j].x * rstd * gq[j].x, v[q][j].y * rstd * gq[j].y, v[q][j].z * rstd * gq[j].z, v[q][j].w * rstd * gq[j].w); }
    }
}

DEV void cvt_item8(const float* W, int ldw, int k0, int n0, unsigned char* dst, int Kd, LAS float* scr, int lane) {
#pragma unroll
    for (int i = 0; i < 32; ++i) { const int kk = 2 * i + (lane >> 5); scr[kk * 33 + (lane & 31)] = W[(size_t)(k0 + kk) * ldw + n0 + (lane & 31)]; }
    asm volatile("s_waitcnt lgkmcnt(0)" ::: "memory");
    const int c = lane & 3;
#pragma unroll
    for (int j = 0; j < 2; ++j) { const int n = (lane >> 2) + 16 * j; const LAS float* sp = scr + (16 * c) * 33 + n;
        u32x4 o; o.x = pk4_fp8(sp[0 * 33] * W8_SCALE, sp[1 * 33] * W8_SCALE, sp[2 * 33] * W8_SCALE, sp[3 * 33] * W8_SCALE); o.y = pk4_fp8(sp[4 * 33] * W8_SCALE, sp[5 * 33] * W8_SCALE, sp[6 * 33] * W8_SCALE, sp[7 * 33] * W8_SCALE);
        o.z = pk4_fp8(sp[8 * 33] * W8_SCALE, sp[9 * 33] * W8_SCALE, sp[10 * 33] * W8_SCALE, sp[11 * 33] * W8_SCALE); o.w = pk4_fp8(sp[12 * 33] * W8_SCALE, sp[13 * 33] * W8_SCALE, sp[14 * 33] * W8_SCALE, sp[15 * 33] * W8_SCALE);
        *(u32x4*)(dst + (size_t)n * Kd + 16 * c) = o; }
    asm volatile("s_waitcnt lgkmcnt(0)" ::: "memory");
}
struct CvtD { const float* W; const float* gain; unsigned char* dst; int ldw, k0, n0, Kd, kind; };
DEV void cvt_load(const CvtD& d, int lane, float (&r)[32]) {
#pragma unroll
    for (int i = 0; i < 8; ++i) { const f32x4 t = __builtin_nontemporal_load((const f32x4*)(d.W + (size_t)(d.k0 + 8 * i + (lane >> 3)) * d.ldw + d.n0 + 4 * (lane & 7))); r[4 * i] = t[0]; r[4 * i + 1] = t[1]; r[4 * i + 2] = t[2]; r[4 * i + 3] = t[3]; }
}
DEV void cvt_finish(const CvtD& d, const float (&r)[32], LAS float* scr, int lane) {
#pragma unroll
    for (int i = 0; i < 8; ++i)
#pragma unroll
        for (int e = 0; e < 4; ++e) scr[(8 * i + (lane >> 3)) * 33 + 4 * (lane & 7) + e] = r[4 * i + e];
    asm volatile("s_waitcnt lgkmcnt(0)" ::: "memory");
    if (d.kind == 2) {
        const int c = lane & 3;
        float gk[16];
#pragma unroll
        for (int z = 0; z < 16; ++z) gk[z] = W8_SCALE;
        if (d.gain) {
#pragma unroll
            for (int z = 0; z < 4; ++z) { const f32x4 g4 = *(const f32x4*)(d.gain + d.k0 + 16 * c + 4 * z); gk[4 * z] *= g4[0]; gk[4 * z + 1] *= g4[1]; gk[4 * z + 2] *= g4[2]; gk[4 * z + 3] *= g4[3]; } }
#pragma unroll
        for (int j = 0; j < 2; ++j) { const int n = (lane >> 2) + 16 * j; const LAS float* sp = scr + (16 * c) * 33 + n;
            u32x4 o; o.x = pk4_fp8(sp[0 * 33] * gk[0], sp[1 * 33] * gk[1], sp[2 * 33] * gk[2], sp[3 * 33] * gk[3]); o.y = pk4_fp8(sp[4 * 33] * gk[4], sp[5 * 33] * gk[5], sp[6 * 33] * gk[6], sp[7 * 33] * gk[7]);
            o.z = pk4_fp8(sp[8 * 33] * gk[8], sp[9 * 33] * gk[9], sp[10 * 33] * gk[10], sp[11 * 33] * gk[11]); o.w = pk4_fp8(sp[12 * 33] * gk[12], sp[13 * 33] * gk[13], sp[14 * 33] * gk[14], sp[15 * 33] * gk[15]);
            __builtin_nontemporal_store(o, (u32x4*)(d.dst + (size_t)n * d.Kd + 16 * c)); }
    } else {
        const int c = lane & 7;
        f32x4 g0 = {1.f, 1.f, 1.f, 1.f}, g1 = g0;
        if (d.kind == 1) { g0 = *(const f32x4*)(d.gain + d.k0 + 8 * c); g1 = *(const f32x4*)(d.gain + d.k0 + 8 * c + 4); }
#pragma unroll
        for (int j = 0; j < 4; ++j) { const int n = (lane >> 3) + 8 * j; const LAS float* sp = scr + (8 * c) * 33 + n;
            u32x4 o; o.x = pk2(sp[0 * 33] * g0[0], sp[1 * 33] * g0[1]); o.y = pk2(sp[2 * 33] * g0[2], sp[3 * 33] * g0[3]); o.z = pk2(sp[4 * 33] * g1[0], sp[5 * 33] * g1[1]); o.w = pk2(sp[6 * 33] * g1[2], sp[7 * 33] * g1[3]);
            __builtin_nontemporal_store(o, (u32x4*)(d.dst + ((size_t)n * d.Kd + 8 * c) * 2)); }
    }
    asm volatile("s_waitcnt lgkmcnt(0)" ::: "memory");
}
struct Args { const float* in[18]; float* out; unsigned char* ws; int ph_lo, ph_hi; };
constexpr int I_IN = 16 * 160, I_BR = 8 * 32, I_OUT = 16 * 32, I_FGU = 16 * 88, I_FD = 44 * 32, I_MGU = 16 * 112, I_MD = 56 * 32;
constexpr int I_LAYER = I_IN + 2 * I_BR + I_OUT, I_FFN = 2 * I_FGU + I_FD, I_EXP = 2 * I_MGU + I_MD, CVT_NITEMS = 2 * I_LAYER + I_FFN + 8 * I_EXP;
constexpr int CVT_NDEFER = 7168;
constexpr int CVT_NB = 2 * I_LAYER + I_FFN;
constexpr int CVT_END1 = CVT_NB + 16576;
DEV CvtD cvt_decode(const Args& args, unsigned char* ws, int it) {
    CvtD d; int r = it;
    if (r < 2 * I_LAYER) { const int l = r / I_LAYER; r -= l * I_LAYER;
        if (r < I_IN) { const int kb = r / 160, nb = r % 160, n0d = nb * 32, tpn = n0d >> 8, r0 = n0d & 255;
            int n0s; if (tpn < 4) n0s = r0 < 128 ? 128 * tpn + r0 : 1024 + 128 * tpn + (r0 - 128); else if (tpn < 6) n0s = 512 + 256 * (tpn - 4) + r0; else { const int c = 1536 + 256 * (tpn - 6) + r0; n0s = c < 3072 ? c : c + 16; }
            d.W = args.in[2] + (size_t)l * D * IN_COLS; d.ldw = IN_COLS; d.k0 = kb * 64; d.n0 = n0s; d.Kd = D; d.gain = args.in[1] + l * D;
            if (tpn < 12) { d.dst = ws + WS_WIN + (((size_t)l * NW1 + n0d) * D + kb * 64) * 2; d.kind = 1; } else { d.dst = ws + WS_WIN8 + ((size_t)l * 2048 + (n0d - 3072)) * D + kb * 64; d.kind = 2; }
            return d; }
        r -= I_IN;
        if (r < 2 * I_BR) { const int br = r / I_BR; r -= br * I_BR; const int kb = r / 32, nb = r % 32;
            d.W = args.in[7] + (size_t)(l * 2 + br) * CC * D; d.ldw = D; d.k0 = kb * 64; d.n0 = nb * 32; d.dst = ws + WS_WBR + (((size_t)(l * 2 + br) * D + nb * 32) * CC + kb * 64) * 2; d.Kd = CC; d.gain = nullptr; d.kind = 0; return d; }
        r -= 2 * I_BR;
        { const int kb = r / 32, nb = r % 32; d.W = args.in[8] + (size_t)l * D * D; d.ldw = D; d.k0 = kb * 64; d.n0 = nb * 32; d.dst = ws + WS_WOUT + (((size_t)l * D + nb * 32) * D + kb * 64) * 2; d.Kd = D; d.gain = nullptr; d.kind = 0; return d; }
    }
    r -= 2 * I_LAYER;
    if (r < I_FFN) {
        if (r < 2 * I_FGU) { const int up = r / I_FGU; r -= up * I_FGU; const int kb = r / 88, nb = r % 88, n0 = nb * 32, drow = (n0 >> 7) * 256 + up * 128 + (n0 & 127);
            d.W = args.in[10 + up]; d.ldw = DFF; d.k0 = kb * 64; d.n0 = n0; d.dst = ws + WS_WFGU + ((size_t)drow * D + kb * 64) * 2; d.Kd = D; d.gain = args.in[9]; d.kind = 1; return d; }
        r -= 2 * I_FGU;
        { const int kb = r / 32, nb = r % 32; d.W = args.in[12]; d.ldw = D; d.k0 = kb * 64; d.n0 = nb * 32; d.dst = ws + WS_WFD + ((size_t)(nb * 32) * DFF + kb * 64) * 2; d.Kd = DFF; d.gain = nullptr; d.kind = 0; return d; }
    }
    r -= I_FFN;
    { const int e = r / I_EXP; r -= e * I_EXP;
        if (r < 2 * I_MGU) { const int up = r / I_MGU; r -= up * I_MGU; const int kb = r / 112, nb = r % 112, n0 = nb * 32, drow = (n0 >> 7) * 256 + up * 128 + (n0 & 127);
            d.W = args.in[14 + up] + (size_t)e * D * DFE; d.ldw = DFE; d.k0 = kb * 64; d.n0 = n0; d.dst = ws + WS_WMGU + ((size_t)e * 2 * DFE + drow) * D + kb * 64; d.Kd = D; d.gain = nullptr; d.kind = 2; return d; }
        r -= 2 * I_MGU;
        { const int kb = r / 32, nb = r % 32; d.W = args.in[16] + (size_t)e * DFE * D; d.ldw = D; d.k0 = kb * 64; d.n0 = nb * 32; d.dst = ws + WS_WMD + ((size_t)e * D + nb * 32) * DFE + kb * 64; d.Kd = DFE; d.gain = nullptr; d.kind = 2; return d; } }
}
DEV void cvt_run(const Args& args, unsigned char* ws, LAS float* scr, int lane, int first, int last, int w, int nw) {
    int it = first + w; if (it >= last) return;
    CvtD d = cvt_decode(args, ws, it); float r[32]; cvt_load(d, lane, r);
    for (;;) {
        const int nx = it + nw;
        if (nx < last) { const CvtD dn = cvt_decode(args, ws, nx); float rn[32]; cvt_load(dn, lane, rn); cvt_finish(d, r, scr, lane); d = dn;
#pragma unroll
            for (int i = 0; i < 32; ++i) r[i] = rn[i];
            it = nx; }
        else { cvt_finish(d, r, scr, lane); break; }
    }
}
enum { PH_CVT = 0, PH_G1 = 1, PH_GLA1 = 2, PH_SCAN = 3, PH_GLA3 = 4, PH_G2 = 5, PH_G3 = 6, PH_RMS2 = 7, PH_UP = 8, PH_DOWN = 9, PH_RMS1 = 10, PH_LAYER = 16, PH_ROUTE1 = 23, PH_ROUTE2 = 24, PH_MUPA = 25, PH_MDOWNA = 26, PH_MUPB = 27, PH_MDOWNB = 28, PH_COMBINE = 29, PH_END = 30 };

__global__ void __launch_bounds__(512, 2) mega(Args args) {
    extern __shared__ __attribute__((aligned(16))) unsigned char lds_raw[];
    LAS unsigned char* lds = (LAS unsigned char*)lds_raw;
    const int wave = __builtin_amdgcn_readfirstlane((int)threadIdx.x >> 6);
    const int G = gridDim.x, bx = blockIdx.x;
    unsigned char* ws = args.ws;
    const int lo = args.ph_lo, hi = args.ph_hi;
#define IN(k) (lo <= (k) && (k) < hi)
#define SEAM(k) do { if ((k) + 1 < hi) { xcd_barrier(bar); if (DUP_PH == 99) xcd_barrier(bar); } } while (0)
#define SEAML(k) do { if ((k) + 1 < hi) { unsigned t_ = 0u, t2_ = 0u; b_arrive(B2, true, t_, t2_); b_wait(B2, true, t_, t2_); if (DUP_PH == 99) xcd_barrier(bar); } } while (0)
    volatile LAS unsigned* MISC = (volatile LAS unsigned*)(lds + MISC_OFF);
    if (threadIdx.x < 16) MISC[threadIdx.x] = 0u;
    __syncthreads();
    XcdBarrier bar = xcd_barrier_post((unsigned*)(ws + WS_BAR), MISC + 8);
    if (threadIdx.x == 0) __hip_atomic_store((unsigned*)(ws + WS_XCC) + bx, xb_xcc_id() + 1u, __ATOMIC_RELAXED, __HIP_MEMORY_SCOPE_AGENT);
    Bar2 B2; B2.g = bar; B2.lcnt = (unsigned*)(ws + WS_LBAR) + 64 * (bx & 7); B2.loc = false;
    const bool g256 = G == 256;
#define ITEM_OF(it) (g256 ? 32 * ((it) & 7) + ((it) >> 3) : (it))
    const int gw = bx * 8 + wave, ngw = G * 8;
    if (IN(PH_CVT)) {
        const int tid = otid(), lane = tid & 63;
        LAS float* scr = (LAS float*)(lds + wave * 16384);
        cvt_run(args, ws, scr, lane, 0, g256 ? I_IN : CVT_NITEMS, gw, ngw);
        for (int i = bx * 512 + tid; i < 2 * RANK * D; i += G * 512) { const int l = i / (RANK * D), n = (i / D) % RANK, k = i % D; ((bf16*)(ws + WS_WA))[i] = (bf16)f2bf(args.in[2][(size_t)l * D * IN_COLS + (size_t)k * IN_COLS + 3072 + n] * args.in[1][l * D + k]); }
        for (int i = bx * 512 + tid; i < 2 * KW * RANK; i += G * 512) { const int l = i / (KW * RANK), j = (i / RANK) % KW, r = i % RANK; ((bf16*)(ws + WS_WA2))[i] = (bf16)f2bf(args.in[3][(size_t)l * RANK * KW + r * KW + j]); }
        for (int i = bx * 512 + tid; i < 8 * D; i += G * 512) { const int e = i / D, k = i % D; const float w = args.in[13][(size_t)k * 8 + e] * args.in[9][D + k]; const unsigned hi = f2bf(w); ((bf16*)(ws + WS_WRT))[e * D + k] = (bf16)hi; ((bf16*)(ws + WS_WRT))[(8 + e) * D + k] = (bf16)f2bf(w - bf2f(hi)); }
        xb_rows(args.in[0], (bf16*)(ws + WS_HB), ws + WS_XB8, (float*)(ws + WS_SSQ), gw, ngw, g256 ? 1 : 0);
        __syncthreads();
        SEAM(PH_CVT);
        if (g256 && hi == PH_END && DUP_PH < 0) {
            const int t = otid();
            if (t < 256) { const unsigned v = xb_ld((unsigned*)(ws + WS_XCC) + t), r = xb_ld((unsigned*)(ws + WS_XCC) + (t & 7)); if (v == 0u || v != r) MISC[12] = 1u; }
            __syncthreads();
            B2.loc = __builtin_amdgcn_readfirstlane((int)MISC[12]) == 0;
        }
        if (g256) {
            if (B2.loc) {
                if (bx & 1) {
                    cvt_run(args, ws, scr, lane, I_IN, CVT_END1, ((bx & 7) >> 1) * 256 + (bx >> 3) * 8 + wave, 1024);
                    xb_rows(args.in[0], (bf16*)(ws + WS_HB), ws + WS_XB8, (float*)(ws + WS_SSQ), (bx >> 3) * 8 + wave, 256, 3, (bx & 7) * SEQ);
                    unsigned t_ = 0u, t2_ = 0u; b_arrive(B2, true, t_, t2_); b_wait(B2, true, t_, t2_);
                    if ((bx >> 3) == 0 && threadIdx.x == 0) { __builtin_amdgcn_fence(__ATOMIC_RELEASE, "agent"); asm volatile("s_waitcnt vmcnt(0)" ::: "memory"); xb_add((unsigned*)(ws + WS_READY), 1u); }
                }
            } else {
                cvt_run(args, ws, scr, lane, I_IN, CVT_NITEMS - CVT_NDEFER, gw, ngw);
                xb_rows(args.in[0], (bf16*)(ws + WS_HB), ws + WS_XB8, (float*)(ws + WS_SSQ), gw, ngw, 2);
                xcd_barrier(bar);
            }
        }
    }
    for (int l = 0; l < 2; ++l) {
        const int pb = l * PH_LAYER;
        bf16* p = (bf16*)(ws + WS_P); bf16* hb = (bf16*)(ws + WS_HB); bf16* merged = (bf16*)(ws + WS_HBP);
        if (IN(pb + PH_G1)) {
            SchedGrid S{(const char*)hb, (const char*)((bf16*)(ws + WS_WIN) + (size_t)l * NW1 * D), (size_t)256 * D * 2, (size_t)256 * D * 2, M / 256, 12, G, bx};
            SchedGrid S8{(const char*)(ws + WS_XB8), (const char*)(ws + WS_WIN8) + (size_t)l * 2048 * D, (size_t)256 * D, (size_t)256 * D, M / 256, 8, G, bx};
            fill_rstd((LAS float*)(lds + RSTD_OFF), S, (const float*)(ws + WS_SSQ), 0, false);
            fill_rstd((LAS float*)(lds + RSTD_OFF), S8, (const float*)(ws + WS_SSQ), 4, true);
            for (int rep_ = 0; rep_ < NREP(pb + PH_G1); ++rep_) pg8::gemm_phase<EG1, SchedGrid, true, true>(lds, D, D, D, S, EG1{p, (const LAS float*)(lds + RSTD_OFF)});
            pg8::gemm_phase<EG1g, SchedGrid, true, true, true>(lds, D / 2, D / 2, D / 2, S8, EG1g{p, (const LAS float*)(lds + RSTD_OFF) + 4 * 256});
        }
        const bool split1 = IN(pb + PH_G1) && IN(pb + PH_GLA1) && NREP(pb + PH_G1) == 1 && NREP(pb + PH_GLA1) == 1 && DUP_PH != 99;
        unsigned tk1 = 0u, tk1b = 0u;
        if (IN(pb + PH_G1)) { if (split1) b_arrive(B2, true, tk1, tk1b); else SEAML(pb + PH_G1); }
        if (IN(pb + PH_GLA1)) {
            if (split1 && bx >= M / 64) b_wait(B2, true, tk1, tk1b);
            for (int rep_ = 0; rep_ < NREP(pb + PH_GLA1); ++rep_)
            for (int it = bx; it < M / 64; it += G) { const int item = ITEM_OF(it);
                gla_pass1a(lds, hb, (const bf16*)(ws + WS_WA) + (size_t)l * RANK * D, item, split1 && it == bx, B2, tk1, tk1b);
                P1Loads L1; gla_pass1_loads(p, (const bf16*)(ws + WS_WA2) + (size_t)l * KW * RANK, args.in[4] + l * KW, item, L1);
                if (rep_ == NREP(pb + PH_GLA1) - 1) conv_item(p, args.in[5] + l * 3 * CC, item);
                gla_pass1(lds, (const float*)(ws + WS_SSQ), L1, (_Float16*)(ws + WS_BG), (bf16*)(ws + WS_U), (float*)(ws + WS_DL), item);
                __syncthreads();
            }
            SEAML(pb + PH_GLA1);
        }
        const bool split3 = IN(pb + PH_SCAN) && IN(pb + PH_GLA3) && NREP(pb + PH_SCAN) == 1 && NREP(pb + PH_GLA3) == 1 && DUP_PH != 99;
        unsigned tick = 0u, tick2 = 0u;
        if (IN(pb + PH_SCAN)) { for (int rep_ = 0; rep_ < NREP(pb + PH_SCAN); ++rep_) gla_scan((const bf16*)(ws + WS_U), (const float*)(ws + WS_DL), (bf16*)(ws + WS_SP), bx, G);
            if (split3) b_arrive(B2, true, tick, tick2); else SEAML(pb + PH_SCAN); }
        if (IN(pb + PH_GLA3)) {
            if (split3 && bx >= M / 64) b_wait(B2, true, tick, tick2);
            for (int rep_ = 0; rep_ < NREP(pb + PH_GLA3); ++rep_)
            for (int it = bx; it < M / 64; it += G) { const int item = ITEM_OF(it); const bool lastrep = rep_ == NREP(pb + PH_GLA3) - 1;
                gla_pass3(lds, p, (const _Float16*)(ws + WS_BG), (const bf16*)(ws + WS_SP), args.in[6] + l * DV, item, lastrep ? p + P_GO : (bf16*)(ws + WS_ACTP), lastrep ? PLD : VW, split3 && it == bx, B2, tick, tick2); __syncthreads(); }
            SEAML(pb + PH_GLA3);
        }
        if (l == 0 && B2.loc && IN(PH_G2)) {
            if (threadIdx.x == 0) { XB_SPIN(xb_ld((unsigned*)(ws + WS_READY)) < 4u, bar.bar); __builtin_amdgcn_fence(__ATOMIC_ACQUIRE, "agent"); asm volatile("s_waitcnt vmcnt(0)" ::: "memory"); }
            __syncthreads();
        }
        if (IN(pb + PH_G2)) {
            const bf16* wb = (const bf16*)(ws + WS_WBR) + (size_t)l * 2 * D * CC;
            SchedPair S{(const char*)(p + P_GB), (const char*)(p + P_GO), (const char*)wb, (const char*)(wb + (size_t)D * CC), (size_t)256 * PLD * 2, (size_t)256 * CC * 2, M / 256, D / 256, G, bx};
            for (int rep_ = 0; rep_ < NREP(pb + PH_G2); ++rep_) pg8::gemm_phase<EMerge, SchedPair, true, true>(lds, CC, PLD, CC, S, EMerge{merged, p});
            SEAML(pb + PH_G2);
        }
        if (IN(pb + PH_G3)) {
            SchedGrid S{(const char*)merged, (const char*)((bf16*)(ws + WS_WOUT) + (size_t)l * D * D), (size_t)256 * D * 2, (size_t)256 * D * 2, M / 256, D / 256, G, bx};
            if (l == 0) { for (int rep_ = 0; rep_ < NREP(pb + PH_G3); ++rep_) pg8::gemm_phase<ERes, SchedGrid, true, true>(lds, D, D, D, S, ERes{hb, (float*)(ws + WS_SSQ), (LAS float*)(lds + PSTAT_OFF), nullptr}); }
            else pg8::gemm_phase<EResT<false>, SchedGrid, true, true>(lds, D, D, D, S, EResT<false>{hb, nullptr, nullptr, nullptr});
            SEAML(pb + PH_G3);
        }
        if (l == 0) {
            bf16* act = (bf16*)(ws + WS_P);
            if (IN(PH_UP)) {
                SchedGrid S{(const char*)hb, (const char*)(ws + WS_WFGU), (size_t)256 * D * 2, (size_t)256 * D * 2, M / 256, 2 * DFF / 256, G, bx};
                fill_rstd((LAS float*)(lds + RSTD_OFF), S, (const float*)(ws + WS_SSQ));
                for (int rep_ = 0; rep_ < NREP(PH_UP); ++rep_) pg8::gemm_phase<ESwiglu, SchedGrid, true, true>(lds, D, D, D, S, ESwiglu{act, PLD, (const LAS float*)(lds + RSTD_OFF)});
                if (bx >= (M / 256) * (2 * DFF / 256) - 5 * G && G == 256) {
                    const int tid = otid(), lane = tid & 63;
                    cvt_run(args, ws, (LAS float*)(lds + wave * 16384), lane, CVT_NITEMS - CVT_NDEFER, CVT_NITEMS, (bx - 128) * 8 + wave, 128 * 8);
                }
                SEAML(PH_UP);
            }
            if (IN(PH_DOWN)) {
                SchedGrid S{(const char*)act, (const char*)(ws + WS_WFD), (size_t)256 * PLD * 2, (size_t)256 * DFF * 2, M / 256, D / 256, G, bx};
                pg8::gemm_phase<ERes8, SchedGrid, true, true>(lds, DFF, PLD, DFF, S, ERes8{hb, (float*)(ws + WS_SSQ), (LAS float*)(lds + PSTAT_OFF), ws + WS_XB8});
                SEAML(PH_DOWN);
            }
        } else {
            int* tilet = (int*)(ws + WS_TILE); unsigned char* hbp = ws + WS_HBP; unsigned char* actp = ws + WS_ACTP; unsigned char* obuf = ws + WS_OBUF;
            int* counts = (int*)(ws + WS_CNT); int* tok_e = (int*)(ws + WS_TOKE); float* tok_w = (float*)(ws + WS_TOKW); int* slot = (int*)(ws + WS_SLOT); float* rstd = (float*)(ws + WS_RSTD);
            const bool splitr = IN(PH_ROUTE1) && IN(PH_ROUTE2) && NREP(PH_ROUTE1) == 1 && NREP(PH_ROUTE2) == 1 && DUP_PH != 99;
            unsigned tkr = 0u, tkrb = 0u;
            if (IN(PH_ROUTE1)) { for (int rep_ = 0; rep_ < NREP(PH_ROUTE1); ++rep_) for (int it = bx; it < M / 64; it += G) route1_grp((LAS float*)lds, hb, (const bf16*)(ws + WS_WRT), rstd, tok_e, tok_w, counts, ITEM_OF(it));
                if (g256 && B2.loc && !(bx & 1) && lo == 0) { const int tidc = otid(); cvt_run(args, ws, (LAS float*)(lds + wave * 16384), tidc & 63, CVT_END1, CVT_NITEMS - CVT_NDEFER, ((bx & 7) >> 1) * 256 + (bx >> 3) * 8 + wave, 1024); }
                if (splitr) b_arrive(B2, false, tkr, tkrb); else SEAM(PH_ROUTE1); }
            if (IN(PH_ROUTE2)) { if (splitr && bx >= M / 64) b_wait(B2, false, tkr, tkrb);
                for (int rep_ = 0; rep_ < NREP(PH_ROUTE2); ++rep_) for (int it = bx; it < M / 64; it += G) route2_grp((LAS int*)lds, hb, args.in[9] + D, rstd, counts, tok_e, slot, hbp, tilet, ITEM_OF(it), bx, G, it == bx, splitr && it == bx, B2, tkr, tkrb); SEAM(PH_ROUTE2); }
            const bool splitc = IN(PH_MDOWNA) && IN(PH_COMBINE) && NREP(PH_MDOWNA) == 1 && DUP_PH != 99;
            unsigned tkc = 0u, tkcb = 0u;
            {
                int nT = 0; if (IN(PH_MUPA) || IN(PH_MDOWNA)) nT = tilet[NTILE_MAX];
                const int nFull = nT < 128 ? nT : 128, nL = nT > 128 ? nT - 128 : 0;
                if (IN(PH_MUPA)) {
                    SchedMoe S{(const char*)hbp, (const char*)(ws + WS_WMGU), tilet, (size_t)256 * D, (size_t)256 * D, (size_t)2 * DFE * D, 0, nT, 2 * DFE / 256, G, bx};
                    for (int rep_ = 0; rep_ < NREP(PH_MUPA); ++rep_) pg8::gemm_phase<ESwiglu8, SchedMoe, true, true, true>(lds, D / 2, D / 2, D / 2, S, ESwiglu8{actp, DFE, W8_INV});
                    SEAM(PH_MUPA);
                }
                if (IN(PH_MDOWNA)) {
                    SchedMoe S{(const char*)actp, (const char*)(ws + WS_WMD), tilet, (size_t)256 * DFE, (size_t)256 * DFE, (size_t)D * DFE, 0, nFull, D / 256, G, bx};
                    for (int rep_ = 0; rep_ < NREP(PH_MDOWNA); ++rep_) pg8::gemm_phase<EOut8, SchedMoe, true, true, true>(lds, DFE / 2, DFE / 2, DFE / 2, S, EOut8{obuf, W8_INV * OB_SCALE});
                    SchedMoeK SK{(const char*)actp, (const char*)(ws + WS_WMD), tilet, nL, G, bx};
                    pg8::gemm_phase<ESlab, SchedMoeK, true, true, true>(lds, KSLICE / 2, DFE / 2, DFE / 2, SK, ESlab{(float*)(ws + WS_OBX), W8_INV});
                    if (splitc) xcd_arrive(bar, tkc, tkcb); else SEAM(PH_MDOWNA);
                }
            }
            if (IN(PH_COMBINE)) combine_rows(hb, obuf, (const float*)(ws + WS_OBX), slot, tok_w, args.in[17], args.out, gw, ngw, splitc, bar, tkc, tkcb);
        }
    }
#undef IN
}

extern "C" void kernel_launch(void* const* d_in, const int* in_sizes, int n_in, void* d_out, int out_size, void* d_ws, size_t ws_size, hipStream_t stream) {
    (void)in_sizes;
    if (n_in != 18 || out_size != M * D || ws_size < WS_END) { fprintf(stderr, "kernel_launch: unexpected arguments (n_in %d out %d ws %zu)\n", n_in, out_size, ws_size); return; }
    static int grid = 0;
    if (grid == 0) {
        int dev = 0, cus = 0;
        if (hipGetDevice(&dev) != hipSuccess || hipDeviceGetAttribute(&cus, hipDeviceAttributeMultiprocessorCount, dev) != hipSuccess) { fprintf(stderr, "kernel_launch: device query failed\n"); grid = -1; return; }
        if (hipFuncSetAttribute((const void*)mega, hipFuncAttributeMaxDynamicSharedMemorySize, LDS_BYTES) != hipSuccess) { fprintf(stderr, "kernel_launch: hipFuncSetAttribute failed\n"); grid = -1; return; }
        grid = cus;
    }
    if (grid < 0) return;
    Args a{};
    for (int i = 0; i < 18; ++i) a.in[i] = (const float*)d_in[i];
    a.out = (float*)d_out; a.ws = (unsigned char*)d_ws;
#define MEGA(lo_, hi_) do { a.ph_lo = (lo_); a.ph_hi = (hi_); hipLaunchKernelGGL(mega, dim3(grid), dim3(512), LDS_BYTES, stream, a); } while (0)
    if (hipMemsetAsync(d_ws, 0, 65536, stream) != hipSuccess) { fprintf(stderr, "kernel_launch: memset failed\n"); return; }
#if MK_SPLIT
    { const int ph[] = {0, 1, 2, 3, 4, 5, 6, 7, 8, 9, 10, 17, 18, 19, 20, 21, 22, 23, 24, 25, 26, 27, 28, 29}; for (int i = 0; i < 24; ++i) MEGA(ph[i], ph[i] + 1); }
#else
    MEGA(0, PH_END);
#endif
}
```
